# Optimizing an MI355X kernel written in HIP

```python
import jax, jax.numpy as jnp
from jax import lax
import numpy as np

D_MODEL = 1024
BATCH = 8
SEQ = 4096
DEPTH = 4

N_EVEN = (DEPTH + 1) // 2
N_ODD = DEPTH // 2
EPS = 1e-6
ROPE_THETA = 10000.0
ROPE_DIM = 64
Q_BLOCK = 128

MLA_HEADS = 8
MLA_Q_LORA = 384
MLA_KV_LORA = 256
MLA_NOPE = 128
MLA_ROPE = ROPE_DIM
MLA_V = 128

SWA_Q_HEADS = 16
SWA_KV_HEADS = 2
SWA_HEAD_DIM = ROPE_DIM
SWA_RADIUS = 128

DIL_PATTERN = ((128, 1), (512, 4), (2048, 16))
DIL_GROUPS = len(DIL_PATTERN)
DIL_HEADS = 16
DIL_HEAD_DIM = ROPE_DIM

N_EXPERTS = 32
TOP_K = 4
D_FF = D_MODEL
SWIGLU_LIMIT = 7.0
SWIGLU_ALPHA = 1.702
MOE_BLOCK = 256

AB_SPLITS = (MLA_Q_LORA, MLA_KV_LORA, MLA_ROPE, SWA_Q_HEADS * SWA_HEAD_DIM,
             SWA_KV_HEADS * SWA_HEAD_DIM, SWA_KV_HEADS * SWA_HEAD_DIM)
AB_IN = sum(AB_SPLITS)
AB_MIX = MLA_HEADS * MLA_V + SWA_Q_HEADS * SWA_HEAD_DIM
C_IN = DIL_GROUPS * 3 * DIL_HEADS * DIL_HEAD_DIM
C_MIX = DIL_HEADS * DIL_HEAD_DIM

kernel_name = "hybrid_mla_swa_dilated_moe_encoder"


def rmsnorm(x, gain):
    xf = x.astype(jnp.float32)
    y = xf * lax.rsqrt(jnp.mean(xf * xf, axis=-1, keepdims=True) + EPS)
    return (y * gain.astype(jnp.float32)).astype(x.dtype)


def ada_norm(x, gain, shift, scale):
    h = rmsnorm(x, gain).astype(jnp.float32)
    return (h * (1.0 + scale[:, None, :]) + shift[:, None, :]).astype(x.dtype)


def rope_tables(positions):
    inv = ROPE_THETA ** (-jnp.arange(0, ROPE_DIM, 2, dtype=jnp.float32) / ROPE_DIM)
    ang = positions.astype(jnp.float32)[..., None] * inv
    return jnp.cos(ang), jnp.sin(ang)


def apply_rope(x, cos, sin):
    xf = x.astype(jnp.float32)
    x1, x2 = jnp.split(xf, 2, axis=-1)
    c = cos[:, :, None, :]
    s = sin[:, :, None, :]
    return jnp.concatenate([x1 * c - x2 * s, x2 * c + x1 * s], axis=-1).astype(x.dtype)


def dense_attention(q, k, v):
    B, S, H, dq = q.shape
    scale = dq ** -0.5
    qb = q.reshape(B, S // Q_BLOCK, Q_BLOCK, H, dq).swapaxes(0, 1)

    def one_block(qblk):
        s = jnp.einsum('bqhd,bkhd->bhqk', qblk, k, preferred_element_type=jnp.float32) * scale
        p = jax.nn.softmax(s, axis=-1).astype(v.dtype)
        return jnp.einsum('bhqk,bkhd->bqhd', p, v, preferred_element_type=jnp.float32).astype(q.dtype)

    o = lax.map(one_block, qb)
    return o.swapaxes(0, 1).reshape(B, S, H, v.shape[-1])


def banded_attention(q, k, v, radius, sink=None, return_lse=False):
    N, L, Hq, hd = q.shape
    Hkv = k.shape[2]
    G = Hq // Hkv
    blk = radius
    nb = -(-L // blk)
    Lp = nb * blk
    pad = Lp - L
    qb = jnp.pad(q, ((0, 0), (0, pad), (0, 0), (0, 0))).reshape(N, nb, blk, Hkv, G, hd)

    def windows(t):
        tp = jnp.pad(t, ((0, 0), (blk, pad + blk), (0, 0), (0, 0))).reshape(N, nb + 2, blk, Hkv, hd)
        return jnp.concatenate([tp[:, :-2], tp[:, 1:-1], tp[:, 2:]], axis=2)

    kw, vw = windows(k), windows(v)
    s = jnp.einsum('nbqhgd,nbjhd->nbhgqj', qb, kw, preferred_element_type=jnp.float32) * (hd ** -0.5)
    qpos = jnp.arange(nb)[:, None] * blk + jnp.arange(blk)[None, :]
    kpos = (jnp.arange(nb)[:, None] - 1) * blk + jnp.arange(3 * blk)[None, :]
    valid = ((jnp.abs(qpos[:, :, None] - kpos[:, None, :]) <= radius)
             & (kpos[:, None, :] >= 0) & (kpos[:, None, :] < L))
    s = jnp.where(valid[None, :, None, None], s, -jnp.inf)
    m = jnp.max(s, axis=-1, keepdims=True)
    if sink is not None:
        sk = sink.astype(jnp.float32).reshape(Hkv, G)[None, None, :, :, None, None]
        m = jnp.maximum(m, sk)
        p = jnp.exp(s - m)
        den = jnp.sum(p, axis=-1, keepdims=True) + jnp.exp(sk - m)
    else:
        p = jnp.exp(s - m)
        den = jnp.sum(p, axis=-1, keepdims=True)
    o = jnp.einsum('nbhgqj,nbjhd->nbqhgd', (p / den).astype(v.dtype), vw,
                   preferred_element_type=jnp.float32)
    o = o.reshape(N, Lp, Hq, hd)[:, :L].astype(q.dtype)
    if return_lse:
        lse = (m + jnp.log(den))[..., 0]
        lse = lse.transpose(0, 1, 4, 2, 3).reshape(N, Lp, Hq)[:, :L]
        return o, lse
    return o


def to_strided(t, dil):
    B, S = t.shape[:2]
    t = t.reshape((B, S // dil, dil) + t.shape[2:])
    t = jnp.moveaxis(t, 2, 1)
    return t.reshape((B * dil, S // dil) + t.shape[3:])


def from_strided(t, dil, B):
    L = t.shape[1]
    t = t.reshape((B, dil, L) + t.shape[2:])
    t = jnp.moveaxis(t, 1, 2)
    return t.reshape((B, L * dil) + t.shape[3:])


def mixer_mla_swa(h, cos, sin, w_in, g_q, w_qb, g_kv, w_kvb, sink, w_out):
    B, S, _ = h.shape
    proj = h @ w_in
    cq, ckv, kr, qs, ks, vs = jnp.split(proj, [int(i) for i in np.cumsum(AB_SPLITS)[:-1]], axis=-1)
    qa = (rmsnorm(cq, g_q) @ w_qb).reshape(B, S, MLA_HEADS, MLA_NOPE + MLA_ROPE)
    q_rope = apply_rope(qa[..., MLA_NOPE:], cos, sin)
    kv = (rmsnorm(ckv, g_kv) @ w_kvb).reshape(B, S, MLA_HEADS, MLA_NOPE + MLA_V)
    k_nope, v_a = kv[..., :MLA_NOPE], kv[..., MLA_NOPE:]
    k_rope = apply_rope(kr.reshape(B, S, 1, MLA_ROPE), cos, sin)
    q_a = jnp.concatenate([qa[..., :MLA_NOPE], q_rope], axis=-1)
    k_a = jnp.concatenate([k_nope, jnp.broadcast_to(k_rope, (B, S, MLA_HEADS, MLA_ROPE))], axis=-1)
    o_a = dense_attention(q_a, k_a, v_a)
    q_b = apply_rope(qs.reshape(B, S, SWA_Q_HEADS, SWA_HEAD_DIM), cos, sin)
    k_b = apply_rope(ks.reshape(B, S, SWA_KV_HEADS, SWA_HEAD_DIM), cos, sin)
    v_b = vs.reshape(B, S, SWA_KV_HEADS, SWA_HEAD_DIM)
    o_b = banded_attention(q_b, k_b, v_b, SWA_RADIUS, sink=sink)
    o = jnp.concatenate([o_a.reshape(B, S, -1), o_b.reshape(B, S, -1)], axis=-1)
    return o @ w_out


def mixer_dilated(h, cos, sin, w_in, w_out):
    B, S, _ = h.shape
    proj = (h @ w_in).reshape(B, S, DIL_GROUPS, 3, DIL_HEADS, DIL_HEAD_DIM)
    outs, lses = [], []
    for g, (window, dil) in enumerate(DIL_PATTERN):
        q = apply_rope(proj[:, :, g, 0], cos, sin)
        k = apply_rope(proj[:, :, g, 1], cos, sin)
        v = proj[:, :, g, 2]
        radius = window // (2 * dil)
        o, lse = banded_attention(to_strided(q, dil), to_strided(k, dil), to_strided(v, dil),
                                  radius, return_lse=True)
        outs.append(from_strided(o, dil, B))
        lses.append(from_strided(lse, dil, B))
    wts = jax.nn.softmax(jnp.stack(lses, axis=0), axis=0)
    o = jnp.sum(wts[..., None] * jnp.stack(outs, axis=0).astype(jnp.float32), axis=0).astype(h.dtype)
    return o.reshape(B, S, C_MIX) @ w_out


def moe_ffn(h, w_router, b_router, w_gu, b_gu, w_down, b_down):
    Bs, S, D = h.shape
    T = Bs * S
    ht = h.reshape(T, D)
    logits = jnp.dot(ht, w_router, preferred_element_type=jnp.float32) + b_router.astype(jnp.float32)
    top_val, top_idx = lax.top_k(logits, TOP_K)
    gate = jax.nn.softmax(top_val, axis=-1)
    e_flat = top_idx.reshape(-1).astype(jnp.int32)
    tok_flat = jnp.arange(T * TOP_K, dtype=jnp.int32) // TOP_K
    order = jnp.argsort(e_flat)
    e_sorted = e_flat[order]
    tok_sorted = tok_flat[order]
    g_sorted = gate.reshape(-1)[order]
    counts = jnp.bincount(e_flat, length=N_EXPERTS).astype(jnp.int32)
    padded = (counts + MOE_BLOCK - 1) // MOE_BLOCK * MOE_BLOCK
    start = jnp.cumsum(counts) - counts
    pend = jnp.cumsum(padded)
    pstart = pend - padded
    rank = jnp.arange(T * TOP_K, dtype=jnp.int32) - start[e_sorted]
    dest = pstart[e_sorted] + rank
    n_rows = T * TOP_K + N_EXPERTS * MOE_BLOCK
    n_blocks = n_rows // MOE_BLOCK
    row_tok = jnp.full((n_rows,), T, dtype=jnp.int32).at[dest].set(tok_sorted)
    ht_pad = jnp.concatenate([ht, jnp.zeros((1, D), ht.dtype)], axis=0)
    xb = ht_pad[row_tok].reshape(n_blocks, MOE_BLOCK, D)
    blk_start = jnp.arange(n_blocks, dtype=jnp.int32) * MOE_BLOCK
    blk_expert = jnp.minimum(jnp.searchsorted(pend, blk_start, side='right'), N_EXPERTS - 1)

    def expert_block(args):
        xblk, e = args
        gu = jnp.dot(xblk, w_gu[e], preferred_element_type=jnp.float32) + b_gu[e].astype(jnp.float32)
        glu = jnp.minimum(gu[:, :D_FF], SWIGLU_LIMIT)
        lin = jnp.clip(gu[:, D_FF:], -SWIGLU_LIMIT, SWIGLU_LIMIT)
        act = (glu * jax.nn.sigmoid(SWIGLU_ALPHA * glu) * (lin + 1.0)).astype(xblk.dtype)
        out = jnp.dot(act, w_down[e], preferred_element_type=jnp.float32) + b_down[e].astype(jnp.float32)
        return out.astype(xblk.dtype)

    yb = lax.map(expert_block, (xb, blk_expert)).reshape(n_rows, D)
    contrib = yb[dest] * g_sorted[:, None].astype(h.dtype)
    y = jnp.zeros((T, D), h.dtype).at[tok_sorted].add(contrib)
    return y.reshape(Bs, S, D)


def setup_inputs(seed: int = 0) -> dict:
    key = jax.random.key(seed)
    ks = jax.random.split(key, 24)
    f32 = jnp.float32

    def nrm(k, shape, fan_in, gain=1.0):
        return jax.random.normal(k, shape, f32) * (gain * fan_in ** -0.5)

    def gain_init(k, shape):
        return 1.0 + 0.05 * jax.random.normal(k, shape, f32)

    def small(k, shape, s):
        return s * jax.random.normal(k, shape, f32)

    D = D_MODEL
    x = jax.random.normal(ks[0], (BATCH, SEQ, D), f32)
    c = jax.random.normal(ks[1], (BATCH, D), f32)
    offs = jax.random.randint(ks[2], (BATCH, 1), 0, SEQ, dtype=jnp.int32)
    positions = jnp.arange(SEQ, dtype=jnp.int32)[None, :] + offs
    return {
        "x": x,
        "c": c,
        "positions": positions,
        "w_mod": nrm(ks[3], (DEPTH, D, 6 * D), D, 0.5),
        "b_mod": small(ks[4], (DEPTH, 6 * D), 0.02),
        "g_norm_mix": gain_init(ks[5], (DEPTH, D)),
        "g_norm_ffn": gain_init(ks[6], (DEPTH, D)),
        "w_in_ab": nrm(ks[7], (N_EVEN, D, AB_IN), D),
        "mla_g_q": gain_init(ks[8], (N_EVEN, MLA_Q_LORA)),
        "mla_w_qb": nrm(ks[9], (N_EVEN, MLA_Q_LORA, MLA_HEADS * (MLA_NOPE + MLA_ROPE)), MLA_Q_LORA),
        "mla_g_kv": gain_init(ks[10], (N_EVEN, MLA_KV_LORA)),
        "mla_w_kvb": nrm(ks[11], (N_EVEN, MLA_KV_LORA, MLA_HEADS * (MLA_NOPE + MLA_V)), MLA_KV_LORA),
        "swa_sink": small(ks[12], (N_EVEN, SWA_Q_HEADS), 0.5),
        "w_out_ab": nrm(ks[13], (N_EVEN, AB_MIX, D), AB_MIX),
        "w_in_c": nrm(ks[14], (N_ODD, D, C_IN), D),
        "w_out_c": nrm(ks[15], (N_ODD, C_MIX, D), C_MIX),
        "w_router": nrm(ks[16], (DEPTH, D, N_EXPERTS), D),
        "b_router": small(ks[17], (DEPTH, N_EXPERTS), 0.01),
        "w_gu": nrm(ks[18], (DEPTH, N_EXPERTS, D, 2 * D_FF), D),
        "b_gu": small(ks[19], (DEPTH, N_EXPERTS, 2 * D_FF), 0.02),
        "w_down": nrm(ks[20], (DEPTH, N_EXPERTS, D_FF, D), D_FF),
        "b_down": small(ks[21], (DEPTH, N_EXPERTS, D), 0.02),
        "g_final": gain_init(ks[22], (D,)),
    }


def reference(x, c, positions, w_mod, b_mod, g_norm_mix, g_norm_ffn,
              w_in_ab, mla_g_q, mla_w_qb, mla_g_kv, mla_w_kvb, swa_sink, w_out_ab,
              w_in_c, w_out_c, w_router, b_router, w_gu, b_gu, w_down, b_down, g_final):
    cos, sin = rope_tables(positions)
    c_act = jax.nn.silu(c)
    for layer in range(DEPTH):
        mod = c_act @ w_mod[layer] + b_mod[layer]
        sh1, sc1, g1, sh2, sc2, g2 = jnp.split(mod, 6, axis=-1)
        h = ada_norm(x, g_norm_mix[layer], sh1, sc1)
        li = layer // 2
        if layer % 2 == 0:
            mix = mixer_mla_swa(h, cos, sin, w_in_ab[li], mla_g_q[li], mla_w_qb[li],
                                mla_g_kv[li], mla_w_kvb[li], swa_sink[li], w_out_ab[li])
        else:
            mix = mixer_dilated(h, cos, sin, w_in_c[li], w_out_c[li])
        x = x + g1[:, None, :] * mix
        h = ada_norm(x, g_norm_ffn[layer], sh2, sc2)
        ffn = moe_ffn(h, w_router[layer], b_router[layer], w_gu[layer], b_gu[layer],
                      w_down[layer], b_down[layer])
        x = x + g2[:, None, :] * ffn
    return rmsnorm(x, g_final)
```

```cpp
#include <hip/hip_runtime.h>
#include <cstdio>
#include <cstdint>

#ifndef MK_MULTI
#define MK_MULTI 0
#endif

#define GAS __attribute__((address_space(1)))
#define LAS __attribute__((address_space(3)))
typedef unsigned short bf16_t;
typedef short bf16x8 __attribute__((ext_vector_type(8)));
typedef short s16x4 __attribute__((ext_vector_type(4)));
typedef float f32x2 __attribute__((ext_vector_type(2)));
typedef float f32x4 __attribute__((ext_vector_type(4)));
typedef float f32x16 __attribute__((ext_vector_type(16)));
typedef unsigned u32x2 __attribute__((ext_vector_type(2)));
typedef unsigned u32x4 __attribute__((ext_vector_type(4)));
typedef int i32x4v __attribute__((ext_vector_type(4)));

constexpr int T = 32768, D = 1024, NBATCH = 8, SEQ = 4096, DEPTH = 4, NE = 32, TOPK = 4;
constexpr float EPS = 1e-6f;
constexpr int AB_IN = 1984, AB_MIX = 2048, C_IN = 9216;
constexpr int NWAVES = 8, NTHR = 512;

constexpr size_t MiB = 1u << 20;
constexpr size_t WS_CTL = 0, CTL_ZERO_BYTES = 1 * MiB;
constexpr size_t WS_MOD = 1 * MiB;
constexpr size_t WS_COS = 2 * MiB, WS_SIN = 6 * MiB;
constexpr size_t WS_WROUT = 10 * MiB;
constexpr size_t WS_WINAB = 11 * MiB;
constexpr size_t WS_WQB = 19 * MiB;
constexpr size_t WS_WKVB = 22 * MiB;
constexpr size_t WS_WOUTAB = 24 * MiB;
constexpr size_t WS_WINC = 32 * MiB;
constexpr size_t WS_WOUTC = 68 * MiB;
constexpr size_t WS_WGU = 72 * MiB;
constexpr size_t WS_WDOWN = 584 * MiB;
constexpr size_t WS_X = 840 * MiB;
constexpr size_t WS_H = 968 * MiB;
constexpr size_t WS_A0 = 1032 * MiB;
constexpr size_t WS_QB = WS_A0;
constexpr size_t WS_KB = WS_A0 + 64 * MiB;
constexpr size_t WS_VB = WS_A0 + 72 * MiB;
constexpr size_t WS_KR = WS_A0 + 80 * MiB;
constexpr size_t WS_CQ = WS_A0 + 84 * MiB;
constexpr size_t WS_CKV = WS_A0 + 108 * MiB;
constexpr size_t WS_SSQ = WS_A0 + 124 * MiB;
constexpr size_t WS_QA = WS_A0 + 126 * MiB;
constexpr size_t WS_KV = WS_A0 + 222 * MiB;
constexpr size_t WS_O = WS_A0 + 350 * MiB;
constexpr size_t WS_PC = WS_A0;
constexpr size_t WS_OG = WS_A0 + 576 * MiB;
constexpr size_t WS_LSE = WS_A0 + 768 * MiB;
constexpr size_t WS_OC = WS_A0 + 774 * MiB;
constexpr size_t WS_MOE = WS_A0 + 840 * MiB;
constexpr size_t WS_LIST = WS_MOE;
constexpr size_t WS_TOKE = WS_MOE + 4 * MiB;
constexpr size_t WS_GATE = WS_MOE + 5 * MiB;
constexpr int ACT_ROWS = T * TOPK + NE * 256;
constexpr size_t WS_ACT = WS_MOE + 6 * MiB;
constexpr size_t WS_H8 = WS_ACT + 136 * MiB;
constexpr size_t WS_YB = WS_ACT + 272 * MiB;
constexpr size_t WS_END = WS_YB + 272 * MiB;

constexpr int CW_BAR = 4096;
constexpr int CW_CNT = 8192;

constexpr int RING_BYTES = 131072;
constexpr int TAB_OFF = RING_BYTES;
constexpr int TAB_TINFO = TAB_OFF, TAB_ECNT = TAB_OFF + 576 * 4, TAB_TSTART = TAB_ECNT + 32 * 4, TAB_NT = TAB_TSTART + 36 * 4;
constexpr int MISC_OFF = TAB_OFF + 4096;
constexpr int LDS_BYTES = 147456;
static_assert(TAB_NT + 16 <= MISC_OFF && MISC_OFF + 128 <= LDS_BYTES, "lds map");

#define LDS_WAIT() asm volatile("s_waitcnt lgkmcnt(0)" ::: "memory")
#define VM_WAIT() asm volatile("s_waitcnt vmcnt(0)" ::: "memory")
#define SBAR() __builtin_amdgcn_sched_barrier(0)

__device__ __forceinline__ unsigned cvt_pk_bf16(float lo, float hi) { unsigned r; asm volatile("v_cvt_pk_bf16_f32 %0, %1, %2" : "=v"(r) : "v"(lo), "v"(hi)); return r; }
__device__ __forceinline__ float bf_lo(unsigned u) { return __uint_as_float(u << 16); }
__device__ __forceinline__ float bf_hi(unsigned u) { return __uint_as_float(u & 0xffff0000u); }
__device__ __forceinline__ float wave_sum(float v) {
#pragma unroll
    for (int o = 1; o < 64; o <<= 1) v += __shfl_xor(v, o);
    return v;
}

#define XB_TMO      128
#define XB_XCNT(j)  (256  + 64 * (j))
#define XB_XSUB(j)  (1280 + 64 * (j))
#define XB_XGEN(j)  (2304 + 64 * (j))
#define XB_TOP      3328
#define XB_TOPGEN   3392
#define XCD_BAR_WORDS 3456
#define XB_SPIN_CAP (1u << 20)
__device__ __forceinline__ unsigned xb_ld(unsigned* p)              { return __hip_atomic_load(p, __ATOMIC_RELAXED, __HIP_MEMORY_SCOPE_AGENT); }
__device__ __forceinline__ unsigned xb_add(unsigned* p, unsigned v) { return __hip_atomic_fetch_add(p, v, __ATOMIC_RELAXED, __HIP_MEMORY_SCOPE_AGENT); }
__device__ __forceinline__ unsigned xb_xcc_id() { return (unsigned)__builtin_amdgcn_s_getreg((3 << 11) | 20) & 0xFu; }
#define XB_SPIN(cond, bar) do { unsigned _sp = 0; while (cond) { __builtin_amdgcn_s_sleep(1); \
    if ((++_sp & 255u) == 0u) { if (xb_ld(&(bar)[XB_TMO])) break; if (_sp > XB_SPIN_CAP) { atomicAdd(&(bar)[XB_TMO], 1u); break; } } } } while (0)
struct XcdBarrier { unsigned* bar; unsigned x; volatile LAS unsigned* st; };
__device__ __forceinline__ XcdBarrier xcd_barrier_post(unsigned* bar, volatile LAS unsigned* st) {
    XcdBarrier b; b.bar = bar; b.x = xb_xcc_id(); b.st = st;
    if (threadIdx.x == 0) (void)xb_add(&bar[XB_XCNT(b.x)], 1u);
    return b;
}
__device__ __forceinline__ void xcd_barrier_complete(unsigned* bar, unsigned x, unsigned& nloc, unsigned& nx) {
    const unsigned G = gridDim.x * gridDim.y * gridDim.z;
    unsigned sum, cnt, mine, sp = 0u;
    for (;;) {
        sum = 0u; cnt = 0u; mine = 0u;
#pragma unroll
        for (unsigned j = 0; j < 16; ++j) { const unsigned c = xb_ld(&bar[XB_XCNT(j)]); sum += c; cnt += (c > 0u) ? 1u : 0u; mine = (j == x) ? c : mine; }
        if (sum == G) break;
        __builtin_amdgcn_s_sleep(1);
        if ((++sp & 255u) == 0u) { if (xb_ld(&bar[XB_TMO])) break; if (sp > XB_SPIN_CAP) { atomicAdd(&bar[XB_TMO], 1u); break; } }
    }
    nloc = mine > 0u ? mine : 1u; nx = cnt > 0u ? cnt : 1u;
}
__device__ __forceinline__ void xcd_barrier(const XcdBarrier& b) {
    asm volatile("s_waitcnt vmcnt(0)" ::: "memory");
    __syncthreads();
    if (threadIdx.x == 0) {
        unsigned* bar = b.bar;
        __builtin_amdgcn_s_waitcnt(0);
        unsigned nloc = b.st[0], nx = b.st[1];
        if (nloc == 0u) { xcd_barrier_complete(bar, b.x, nloc, nx); b.st[0] = nloc; b.st[1] = nx; }
        const unsigned old = xb_add(&bar[XB_XSUB(b.x)], 1u);
        const unsigned gen = old / nloc;
        if (old + 1u == (gen + 1u) * nloc) {
            __builtin_amdgcn_fence(__ATOMIC_RELEASE, "agent");
            asm volatile("s_waitcnt vmcnt(0)" ::: "memory");
            const unsigned og = xb_add(&bar[XB_TOP], 1u);
            const unsigned tg = og / nx;
            if (og + 1u == (tg + 1u) * nx) xb_add(&bar[XB_TOPGEN], 1u);
            else XB_SPIN(xb_ld(&bar[XB_TOPGEN]) == tg, bar);
            __builtin_amdgcn_fence(__ATOMIC_ACQUIRE, "agent");
            xb_add(&bar[XB_XGEN(b.x)], 1u);
            asm volatile("s_waitcnt vmcnt(0)" ::: "memory");
        } else {
            XB_SPIN(xb_ld(&bar[XB_XGEN(b.x)]) == gen, bar);
            __builtin_amdgcn_fence(__ATOMIC_ACQUIRE, "agent");
            asm volatile("s_waitcnt vmcnt(0)" ::: "memory");
        }
    }
    __syncthreads();
}

struct Params {
    const float* x; const float* c; const int* positions; const float* w_mod; const float* b_mod; const float* g_norm_mix; const float* g_norm_ffn;
    const float* w_in_ab; const float* mla_g_q; const float* mla_w_qb; const float* mla_g_kv; const float* mla_w_kvb; const float* swa_sink; const float* w_out_ab;
    const float* w_in_c; const float* w_out_c; const float* w_router; const float* b_router; const float* w_gu; const float* b_gu; const float* w_down; const float* b_down; const float* g_final;
    float* out; unsigned char* ws;
    int ph_lo, ph_hi;
};

namespace g8 {
constexpr int BM = 256, BK = 64, HALF = 128, HTB = HALF * BK * 2, STAGE_BYTES = 8 * HTB, NXCD = 8, WGM = 8;
__device__ __forceinline__ int lds_byte(int r, int c) { const int st = (r >> 4) * 2 + (c >> 5), rr = r & 15, cc = c & 31, ob = rr * 64 + cc * 2; return st * 1024 + (ob ^ (((ob >> 9) & 1) << 5)); }
__device__ __forceinline__ void stage_rc(int b, int& R, int& C) { const int st = b / 1024, sb = b % 1024, swz = sb ^ (((sb >> 9) & 1) << 5); R = (st >> 1) * 16 + swz / 64; C = (st & 1) * 32 + (swz % 64) / 2; }
__device__ __forceinline__ int perm32(int rho) { const int n = rho >> 4, i = rho & 15; return 8 * (i >> 2) + 4 * n + (i & 3); }

struct Unit { int pm, pn, aux; };
typedef int i32x4 __attribute__((ext_vector_type(4)));
typedef int i32x8 __attribute__((ext_vector_type(8)));
__device__ __forceinline__ bf16x8 lo8(i32x8 v) { return __builtin_bit_cast(bf16x8, __builtin_shufflevector(v, v, 0, 1, 2, 3)); }
__device__ __forceinline__ bf16x8 hi8(i32x8 v) { return __builtin_bit_cast(bf16x8, __builtin_shufflevector(v, v, 4, 5, 6, 7)); }
__device__ __forceinline__ i32x8 cat8(bf16x8 a, bf16x8 b) { const i32x4 x = __builtin_bit_cast(i32x4, a), y = __builtin_bit_cast(i32x4, b); return __builtin_shufflevector(x, y, 0, 1, 2, 3, 4, 5, 6, 7); }

struct DenseSched {
    const char* A; const char* Bt; int K; int nM, nN, nwg, G, c;
    __device__ __forceinline__ void init(const void* A_, const void* Bt_, int K_, int M, int N, int G_, int c_) { A = (const char*)A_; Bt = (const char*)Bt_; asm volatile("" : "+s"(A), "+s"(Bt));     K = K_; nM = M / BM; nN = N / BM; nwg = nM * nN; G = G_; c = c_; }
    __device__ __forceinline__ bool next(int i, Unit& u) const {
        const long L = (long)i * G + c; if (L >= nwg) return false;
        int wgid = (int)L; { const int q = nwg / NXCD, r = nwg % NXCD, xcd = wgid % NXCD, off = wgid / NXCD; wgid = (xcd < r ? xcd * (q + 1) : r * (q + 1) + (xcd - r) * q) + off; }
        const int nig = WGM * nN, gid = wgid / nig, fm = gid * WGM, gsz = (nM - fm) < WGM ? (nM - fm) : WGM;
        u.pm = fm + ((wgid % nig) % gsz); u.pn = (wgid % nig) / gsz; u.aux = 0; return true;
    }
    static constexpr bool GATHER = false;
    __device__ __forceinline__ const char* a_base() const { return A; }
    __device__ __forceinline__ const char* a_tile(const Unit& u) const { return A + (size_t)u.pm * BM * K * 2; }
    __device__ __forceinline__ unsigned a_off(const Unit& u, int r) const { return 0u; }
    __device__ __forceinline__ const char* b_tile(const Unit& u) const { return Bt + (size_t)u.pn * BM * K * 2; }
};

template <class Epi, class Sched, bool ALIGN_EPI, bool FP8 = false>
__device__ __forceinline__ void gemm_phase(LAS unsigned char* lds, const int K, const Sched& S, const Epi& E) {
    int tid = threadIdx.x; asm volatile("" : "+v"(tid));
    const int wid = __builtin_amdgcn_readfirstlane(tid >> 6), lane = tid & 63, wr = wid >> 2, wc = wid & 3, fr = lane & 15, fq = lane >> 4;
    const int nt = K / BK;
    constexpr bool GATHER = Sched::GATHER;
    int Ra[2]; unsigned Ca2[2], voffB[2], voffA[2];
#pragma unroll
    for (int i = 0; i < 2; ++i) { int R, C; stage_rc(tid * 16 + i * 8192, R, C); const int Rb = (R & ~31) + perm32(R & 31);
        Ra[i] = R; Ca2[i] = (unsigned)C * 2u; voffB[i] = (unsigned)(Rb * K + C) * 2u; voffA[i] = (unsigned)(R * K + C) * 2u; }
    const size_t kstep = (size_t)(BK * 2);
    const size_t hstep = (size_t)HALF * K * 2;
    const unsigned ldsw = (unsigned)wid * 1024u;
    const int aoff = lds_byte(wr * 64 + fr, fq * 8), boff = lds_byte(wc * 32 + fr, fq * 8);
#define G8_SA(b, h) (((b) * 2 + (h)) * HTB)
#define G8_SB(b, h) ((4 + (b) * 2 + (h)) * HTB)
#define G8_STAGE(bufoff, gbase, voff) do { _Pragma("unroll") for (int _i = 0; _i < 2; ++_i) \
        __builtin_amdgcn_global_load_lds((const unsigned*)((const char*)(gbase) + (voff)[_i]), (LAS unsigned*)(lds + (bufoff) + ldsw + _i * 8192), 16, 0, 0); } while (0)
#define G8_LDA(dst, b, h) do { _Pragma("unroll") for (int m = 0; m < 4; ++m) dst[m] = cat8(*(const LAS bf16x8*)(lds + G8_SA(b, h) + aoff + m * 2048), *(const LAS bf16x8*)(lds + G8_SA(b, h) + aoff + m * 2048 + 1024)); } while (0)
#define G8_LDB(dst, b, h) do { _Pragma("unroll") for (int n = 0; n < 2; ++n) dst[n] = cat8(*(const LAS bf16x8*)(lds + G8_SB(b, h) + boff + n * 2048), *(const LAS bf16x8*)(lds + G8_SB(b, h) + boff + n * 2048 + 1024)); } while (0)
#define G8_MMA(ai, bj, At, Bt) do { __builtin_amdgcn_s_setprio(1); _Pragma("unroll") for (int m = 0; m < 4; ++m) _Pragma("unroll") for (int n = 0; n < 2; ++n) { \
        if constexpr (FP8) asm volatile("v_mfma_f32_16x16x128_f8f6f4 %0, %1, %2, %0" : "+v"(acc[ai][bj][m][n]) : "v"(Bt[n]), "v"(At[m]));     \
        else { acc[ai][bj][m][n] = __builtin_amdgcn_mfma_f32_16x16x32_bf16(lo8(Bt[n]), lo8(At[m]), acc[ai][bj][m][n], 0, 0, 0); acc[ai][bj][m][n] = __builtin_amdgcn_mfma_f32_16x16x32_bf16(hi8(Bt[n]), hi8(At[m]), acc[ai][bj][m][n], 0, 0, 0); } } __builtin_amdgcn_s_setprio(0); } while (0)
#define G8_WAIT_V(n) asm volatile("s_waitcnt vmcnt(" #n ")" ::: "memory")
#define G8_WAIT_L(n) asm volatile("s_waitcnt lgkmcnt(" #n ")" ::: "memory")
#define G8_BAR __builtin_amdgcn_s_barrier()
#define G8_SCHED __builtin_amdgcn_sched_barrier(0)
    Unit cur, nxt; int ui = 0;
    if (!S.next(0, cur)) return;
    f32x4 acc[2][2][4][2];
#pragma unroll
    for (int a = 0; a < 2; ++a)
#pragma unroll
        for (int b = 0; b < 2; ++b)
#pragma unroll
            for (int m = 0; m < 4; ++m)
#pragma unroll
                for (int n = 0; n < 2; ++n) acc[a][b][m][n] = (f32x4){0.f, 0.f, 0.f, 0.f};
    i32x8 At[4], B0[2], B1[2];
    const char* Ab = GATHER ? S.a_base() : S.a_tile(cur);
    unsigned cA0[2], cA1[2], nA0[2], nA1[2];
#pragma unroll
    for (int i = 0; i < 2; ++i) { if constexpr (GATHER) { cA0[i] = S.a_off(cur, Ra[i]) + Ca2[i]; cA1[i] = S.a_off(cur, HALF + Ra[i]) + Ca2[i]; } else { cA0[i] = voffA[i]; cA1[i] = voffA[i] + (unsigned)hstep; } }
    const char* cB = S.b_tile(cur);
    G8_STAGE(G8_SB(0, 0), cB, voffB); G8_STAGE(G8_SB(0, 1), cB + hstep, voffB); G8_STAGE(G8_SA(0, 0), Ab, cA0); G8_STAGE(G8_SA(0, 1), Ab, cA1);
    if (wr == 1) G8_BAR;
    G8_WAIT_V(2); G8_BAR;
    G8_STAGE(G8_SB(1, 0), cB + kstep, voffB); G8_STAGE(G8_SA(1, 0), Ab + kstep, cA0); G8_STAGE(G8_SB(1, 1), cB + hstep + kstep, voffB);
    G8_WAIT_V(6); G8_BAR;
    for (;;) {
        const bool has_next = S.next(ui + 1, nxt);
        const char* nB = cB; const char* nAb = Ab;
        if constexpr (GATHER) {
#pragma unroll
            for (int i = 0; i < 2; ++i) { nA0[i] = cA0[i]; nA1[i] = cA1[i]; } }
        if (has_next) { nB = S.b_tile(nxt);
            if constexpr (GATHER) {
#pragma unroll
                for (int i = 0; i < 2; ++i) { nA0[i] = S.a_off(nxt, Ra[i]) + Ca2[i]; nA1[i] = S.a_off(nxt, HALF + Ra[i]) + Ca2[i]; } }
            else nAb = S.a_tile(nxt); }
#pragma clang loop unroll(disable)
        for (int t = 0; t < nt; t += 2) {
            const bool last = (t == nt - 2);
            const char* a1 = Ab + (size_t)(t + 1) * kstep;
            const char* a2 = last ? nAb : Ab + (size_t)(t + 2) * kstep; const char* b2 = last ? nB : cB + (size_t)(t + 2) * kstep;
            const char* a3 = a2 + kstep; const char* b3 = b2 + kstep;
            unsigned o20[2], o21[2];
#pragma unroll
            for (int i = 0; i < 2; ++i) { if constexpr (GATHER) { o20[i] = last ? nA0[i] : cA0[i]; o21[i] = last ? nA1[i] : cA1[i]; } else { o20[i] = cA0[i]; o21[i] = cA1[i]; } }
            const bool relax = Epi::NSTORE > 0 && !GATHER && t == 0 && ui > 0;
            G8_LDB(B0, 0, 0); G8_LDB(B1, 0, 1); G8_SCHED; G8_LDA(At, 0, 0); G8_STAGE(G8_SA(1, 1), a1, cA1);
            if (relax) asm volatile("s_waitcnt vmcnt(%0)" :: "n"(8 + Epi::NSTORE) : "memory"); else G8_WAIT_V(8);
            G8_WAIT_L(0); G8_BAR; G8_MMA(0, 0, At, B0); G8_MMA(0, 1, At, B1); G8_BAR; G8_SCHED;
            G8_LDA(At, 0, 1); G8_STAGE(G8_SB(0, 0), b2, voffB); G8_STAGE(G8_SB(0, 1), b2 + hstep, voffB); G8_STAGE(G8_SA(0, 0), a2, o20);
            if (relax) asm volatile("s_waitcnt vmcnt(%0)" :: "n"(8 + Epi::NSTORE) : "memory"); else G8_WAIT_V(8);
            G8_WAIT_L(0); G8_BAR; G8_MMA(1, 0, At, B0); G8_MMA(1, 1, At, B1); G8_BAR; G8_SCHED;
            G8_LDB(B0, 1, 0); G8_LDB(B1, 1, 1); G8_SCHED; G8_LDA(At, 1, 0); G8_STAGE(G8_SA(0, 1), a2, o21);
            G8_WAIT_V(8); G8_WAIT_L(0); G8_BAR; G8_MMA(0, 0, At, B0); G8_MMA(0, 1, At, B1); G8_BAR; G8_SCHED;
            G8_LDA(At, 1, 1); G8_STAGE(G8_SB(1, 0), b3, voffB); G8_STAGE(G8_SB(1, 1), b3 + hstep, voffB); G8_STAGE(G8_SA(1, 0), a3, o20);
            G8_WAIT_V(8); G8_WAIT_L(0); G8_BAR; G8_MMA(1, 0, At, B0); G8_MMA(1, 1, At, B1); G8_BAR; G8_SCHED;
        }
        if constexpr (FP8) asm volatile("s_nop 15\n\ts_nop 15" ::: "memory");
        if constexpr (ALIGN_EPI) { if (wr == 0) G8_BAR; }
        E(acc, cur, wr, wc, fr, fq);
        if (!has_next) break;
#pragma unroll
        for (int a = 0; a < 2; ++a)
#pragma unroll
            for (int b = 0; b < 2; ++b)
#pragma unroll
                for (int m = 0; m < 4; ++m)
#pragma unroll
                    for (int n = 0; n < 2; ++n) acc[a][b][m][n] = (f32x4){0.f, 0.f, 0.f, 0.f};
        cur = nxt; cB = nB; ++ui;
        if constexpr (GATHER) {
#pragma unroll
            for (int i = 0; i < 2; ++i) { cA0[i] = nA0[i]; cA1[i] = nA1[i]; } }
        else Ab = nAb;
        if constexpr (ALIGN_EPI) { if (wr == 1) G8_BAR; }
    }
    G8_WAIT_V(0);
    if constexpr (!ALIGN_EPI) { if (wr == 0) G8_BAR; }
    G8_BAR;
#undef G8_SA
#undef G8_SB
#undef G8_STAGE
#undef G8_LDA
#undef G8_LDB
#undef G8_MMA
#undef G8_WAIT_V
#undef G8_WAIT_L
#undef G8_BAR
#undef G8_SCHED
}
}

typedef f32x4 Acc[2][2][4][2];
__device__ __forceinline__ u32x4 pack8(const f32x4 a, const f32x4 b) { u32x4 w; w.x = cvt_pk_bf16(a[0], a[1]); w.y = cvt_pk_bf16(a[2], a[3]); w.z = cvt_pk_bf16(b[0], b[1]); w.w = cvt_pk_bf16(b[2], b[3]); return w; }

__device__ __forceinline__ float sq8(const f32x4 a, const f32x4 b) { return (a[0] * a[0] + a[1] * a[1]) + (a[2] * a[2] + a[3] * a[3]) + (b[0] * b[0] + b[1] * b[1]) + (b[2] * b[2] + b[3] * b[3]); }
__device__ __forceinline__ void rope_inplace(Acc& acc, const float* __restrict__ COS, const float* __restrict__ SIN, int row0, int x0, const float (&sc)[8]) {
#pragma unroll
    for (int h = 0; h < 4; ++h) { f32x4 c0[2], c1[2], s0[2], s1[2];
#pragma unroll
        for (int q = 0; q < 2; ++q) { const int i = h * 2 + q; const size_t t = (size_t)(row0 + (i >> 2) * 128 + (i & 3) * 16) * 32 + x0;
            c0[q] = *(const f32x4*)(COS + t); c1[q] = *(const f32x4*)(COS + t + 4); s0[q] = *(const f32x4*)(SIN + t); s1[q] = *(const f32x4*)(SIN + t + 4); }
#pragma unroll
        for (int q = 0; q < 2; ++q) { const int i = h * 2 + q, ai = i >> 2, m = i & 3; const float k = sc[i]; const f32x4 lo0 = acc[ai][0][m][0], lo1 = acc[ai][0][m][1], hi0 = acc[ai][1][m][0], hi1 = acc[ai][1][m][1];
            acc[ai][0][m][0] = (lo0 * c0[q] - hi0 * s0[q]) * k; acc[ai][0][m][1] = (lo1 * c1[q] - hi1 * s1[q]) * k;
            acc[ai][1][m][0] = (hi0 * c0[q] + lo0 * s0[q]) * k; acc[ai][1][m][1] = (hi1 * c1[q] + lo1 * s1[q]) * k; } }
    asm volatile("" ::: "memory");
}

struct EpiInAB {
    static constexpr int NSTORE = 0;
    bf16_t *QB, *KB, *VB, *KR, *CQ, *CKV; float* SSQ; const float *COS, *SIN;
    __device__ __forceinline__ void operator()(Acc& acc, const g8::Unit& u, int wr, int wc, int fr, int fq) const {
        const int pn = u.pn, row0 = u.pm * 256 + wr * 64 + fr;
        if (pn <= 4) {
            bf16_t* dst; int ld, cb;
            if (pn < 4) { dst = QB; ld = 1024; cb = (4 * pn + wc) * 64; }
            else if (wc < 2) { dst = KB; ld = 128; cb = wc * 64; }
            else if (wc == 2) { dst = KR; ld = 64; cb = 0; }
            else return;
            const float one[8] = {1.f, 1.f, 1.f, 1.f, 1.f, 1.f, 1.f, 1.f};
            rope_inplace(acc, COS, SIN, row0, 8 * fq, one);
#pragma unroll
            for (int ai = 0; ai < 2; ++ai)
#pragma unroll
                for (int m = 0; m < 4; ++m) { bf16_t* d = dst + (size_t)(row0 + ai * 128 + m * 16) * ld + cb + 8 * fq;
                    *(u32x4*)d = pack8(acc[ai][0][m][0], acc[ai][0][m][1]); *(u32x4*)(d + 32) = pack8(acc[ai][1][m][0], acc[ai][1][m][1]); }
        } else {
#pragma unroll
            for (int ai = 0; ai < 2; ++ai)
#pragma unroll
                for (int m = 0; m < 4; ++m) { const int t = row0 + ai * 128 + m * 16; const int c8 = 32 * wc + 8 * fq;
                    const u32x4 w0 = pack8(acc[ai][0][m][0], acc[ai][0][m][1]), w1 = pack8(acc[ai][1][m][0], acc[ai][1][m][1]);
                    float s = sq8(acc[ai][0][m][0], acc[ai][0][m][1]);
                    if (pn == 5) { *(u32x4*)(CQ + (size_t)t * 384 + c8) = w0; *(u32x4*)(CQ + (size_t)t * 384 + 128 + c8) = w1; s += sq8(acc[ai][1][m][0], acc[ai][1][m][1]); }
                    else if (pn == 6) { *(u32x4*)(CQ + (size_t)t * 384 + 256 + c8) = w0; *(u32x4*)(VB + (size_t)t * 128 + c8) = w1; }
                    else { *(u32x4*)(CKV + (size_t)t * 256 + c8) = w0; *(u32x4*)(CKV + (size_t)t * 256 + 128 + c8) = w1; s += sq8(acc[ai][1][m][0], acc[ai][1][m][1]); }
                    s += __shfl_xor(s, 16); s += __shfl_xor(s, 32);
                    if (fq == 0) SSQ[(size_t)t * 12 + (pn - 5) * 4 + wc] = s; }
        }
    }
};
struct EpiQUp {
    static constexpr int NSTORE = 16;
    bf16_t* QA; const float *SSQ, *COS, *SIN;
    __device__ __forceinline__ void operator()(Acc& acc, const g8::Unit& u, int wr, int wc, int fr, int fq) const {
        const int pn = u.pn, row0 = u.pm * 256 + wr * 64 + fr;
        float rstd[8];
#pragma unroll
        for (int i = 0; i < 8; ++i) { const int t = row0 + (i >> 2) * 128 + (i & 3) * 16;
            const f32x4 q0 = *(const f32x4*)(SSQ + (size_t)t * 12), q1 = *(const f32x4*)(SSQ + (size_t)t * 12 + 4);
            rstd[i] = 1.0f / sqrtf(((q0[0] + q0[1]) + (q0[2] + q0[3]) + (q1[0] + q1[1]) + (q1[2] + q1[3])) * (1.0f / 384.0f) + EPS); }
        if (pn < 2) { rope_inplace(acc, COS, SIN, row0, 8 * fq, rstd);
#pragma unroll
            for (int ai = 0; ai < 2; ++ai)
#pragma unroll
                for (int m = 0; m < 4; ++m) { bf16_t* d = QA + (size_t)(row0 + ai * 128 + m * 16) * 1536 + (4 * pn + wc) * 192 + 128 + 8 * fq;
                    *(u32x4*)d = pack8(acc[ai][0][m][0], acc[ai][0][m][1]); *(u32x4*)(d + 32) = pack8(acc[ai][1][m][0], acc[ai][1][m][1]); } }
        else { asm volatile("" ::: "memory");
#pragma unroll
            for (int ai = 0; ai < 2; ++ai)
#pragma unroll
                for (int m = 0; m < 4; ++m) { const float rs = rstd[ai * 4 + m];
#pragma unroll
                    for (int bj = 0; bj < 2; ++bj) *(u32x4*)(QA + (size_t)(row0 + ai * 128 + m * 16) * 1536 + (2 * (pn - 2) + bj) * 192 + 32 * wc + 8 * fq) = pack8(acc[ai][bj][m][0] * rs, acc[ai][bj][m][1] * rs); } }
    }
};
struct EpiKVUp {
    static constexpr int NSTORE = 16;
    bf16_t* KV; const float* SSQ;
    __device__ __forceinline__ void operator()(Acc& acc, const g8::Unit& u, int wr, int wc, int fr, int fq) const {
        const int row0 = u.pm * 256 + wr * 64 + fr;
        float rstd[8];
#pragma unroll
        for (int i = 0; i < 8; ++i) { const int t = row0 + (i >> 2) * 128 + (i & 3) * 16;
            const f32x4 q0 = *(const f32x4*)(SSQ + (size_t)t * 12 + 8);
            rstd[i] = 1.0f / sqrtf(((q0[0] + q0[1]) + (q0[2] + q0[3])) * (1.0f / 256.0f) + EPS); }
        asm volatile("" ::: "memory");
#pragma unroll
        for (int ai = 0; ai < 2; ++ai)
#pragma unroll
            for (int m = 0; m < 4; ++m) { const int t = row0 + ai * 128 + m * 16; const float rs = rstd[ai * 4 + m];
#pragma unroll
                for (int bj = 0; bj < 2; ++bj) *(u32x4*)(KV + (size_t)t * 2048 + u.pn * 256 + 128 * bj + 32 * wc + 8 * fq) = pack8(acc[ai][bj][m][0] * rs, acc[ai][bj][m][1] * rs); }
    }
};
struct EpiResid {
    static constexpr int NSTORE = 32;
    float* X; const float* gate;
    __device__ __forceinline__ void operator()(Acc& acc, const g8::Unit& u, int wr, int wc, int fr, int fq) const {
        const int row0 = u.pm * 256 + wr * 64 + fr; const float* gp = gate + (size_t)(u.pm >> 4) * 6144;
#pragma unroll
        for (int bj = 0; bj < 2; ++bj) { const int col = u.pn * 256 + 128 * bj + 32 * wc + 8 * fq;
            const f32x4 g0 = *(const f32x4*)(gp + col), g1 = *(const f32x4*)(gp + col + 4);
            f32x4 x0[8], x1[8];
#pragma unroll
            for (int i = 0; i < 8; ++i) { const float* xp = X + (size_t)(row0 + (i >> 2) * 128 + (i & 3) * 16) * 1024 + col; x0[i] = *(const f32x4*)xp; x1[i] = *(const f32x4*)(xp + 4); }
#pragma unroll
            for (int i = 0; i < 8; ++i) { acc[i >> 2][bj][i & 3][0] = x0[i] + g0 * acc[i >> 2][bj][i & 3][0]; acc[i >> 2][bj][i & 3][1] = x1[i] + g1 * acc[i >> 2][bj][i & 3][1]; } }
        asm volatile("" ::: "memory");
#pragma unroll
        for (int bj = 0; bj < 2; ++bj) { const int col = u.pn * 256 + 128 * bj + 32 * wc + 8 * fq;
#pragma unroll
            for (int i = 0; i < 8; ++i) { float* xp = X + (size_t)(row0 + (i >> 2) * 128 + (i & 3) * 16) * 1024 + col; *(f32x4*)xp = acc[i >> 2][bj][i & 3][0]; *(f32x4*)(xp + 4) = acc[i >> 2][bj][i & 3][1]; } }
    }
};
struct EpiInC {
    static constexpr int NSTORE = 16;
    bf16_t* PC; const float *COS, *SIN;
    __device__ __forceinline__ void operator()(Acc& acc, const g8::Unit& u, int wr, int wc, int fr, int fq) const {
        const int pn = u.pn, gs = pn >> 2, s = gs % 3, row0 = u.pm * 256 + wr * 64 + fr;
        if (s < 2) { const float one[8] = {1.f, 1.f, 1.f, 1.f, 1.f, 1.f, 1.f, 1.f};
            rope_inplace(acc, COS, SIN, row0, 8 * fq, one);
#pragma unroll
            for (int ai = 0; ai < 2; ++ai)
#pragma unroll
                for (int m = 0; m < 4; ++m) { bf16_t* d = PC + (size_t)(row0 + ai * 128 + m * 16) * 9216 + gs * 1024 + (4 * (pn & 3) + wc) * 64 + 8 * fq;
                    *(u32x4*)d = pack8(acc[ai][0][m][0], acc[ai][0][m][1]); *(u32x4*)(d + 32) = pack8(acc[ai][1][m][0], acc[ai][1][m][1]); } }
        else {
#pragma unroll
            for (int ai = 0; ai < 2; ++ai)
#pragma unroll
                for (int m = 0; m < 4; ++m)
#pragma unroll
                    for (int bj = 0; bj < 2; ++bj) *(u32x4*)(PC + (size_t)(row0 + ai * 128 + m * 16) * 9216 + pn * 256 + 128 * bj + 32 * wc + 8 * fq) = pack8(acc[ai][bj][m][0], acc[ai][bj][m][1]); }
    }
};
struct EpiSwiGLU {
    static constexpr int NSTORE = 8;
    unsigned char* ACT8; const float* bgu;
    __device__ __forceinline__ void operator()(Acc& acc, const g8::Unit& u, int wr, int wc, int fr, int fq) const {
        const int e = u.aux >> 16, col = u.pn * 128 + 32 * wc + 8 * fq, row0 = u.pm * 256 + wr * 64 + fr;
        const float* bp = bgu + (size_t)e * 2048 + col;
        const f32x4 bg0 = *(const f32x4*)bp, bg1 = *(const f32x4*)(bp + 4), bl0 = *(const f32x4*)(bp + 1024), bl1 = *(const f32x4*)(bp + 1028);
#pragma unroll
        for (int ai = 0; ai < 2; ++ai)
#pragma unroll
            for (int m = 0; m < 4; ++m) { f32x4 r[2];
#pragma unroll
                for (int n = 0; n < 2; ++n) { const f32x4 g = acc[ai][0][m][n] * (1.0f / 32.0f) + (n ? bg1 : bg0), l = acc[ai][1][m][n] * (1.0f / 32.0f) + (n ? bl1 : bl0);
#pragma unroll
                    for (int i = 0; i < 4; ++i) { const float gl = fminf(g[i], 7.0f), li = fminf(fmaxf(l[i], -7.0f), 7.0f);
                        const float sg = __builtin_amdgcn_rcpf(1.0f + __builtin_amdgcn_exp2f(-1.702f * 1.4426950408889634f * gl)); r[n][i] = 4.0f * gl * sg * (li + 1.0f); } }
                u32x2 w; w.x = (unsigned)__builtin_amdgcn_cvt_pk_fp8_f32(r[0][2], r[0][3], __builtin_amdgcn_cvt_pk_fp8_f32(r[0][0], r[0][1], 0, false), true);
                w.y = (unsigned)__builtin_amdgcn_cvt_pk_fp8_f32(r[1][2], r[1][3], __builtin_amdgcn_cvt_pk_fp8_f32(r[1][0], r[1][1], 0, false), true);
                *(u32x2*)(ACT8 + (size_t)(row0 + ai * 128 + m * 16) * 1024 + col) = w; }
    }
};
struct EpiNull { static constexpr int NSTORE = 0; __device__ __forceinline__ void operator()(Acc& acc, const g8::Unit& u, int wr, int wc, int fr, int fq) const { asm volatile("" :: "v"(acc[0][0][0][0]), "v"(acc[1][1][3][1])); } };
struct EpiDown {
    static constexpr int NSTORE = 16;
    bf16_t* YB; const float* bdn;
    __device__ __forceinline__ void operator()(Acc& acc, const g8::Unit& u, int wr, int wc, int fr, int fq) const {
        const int e = u.aux >> 16, row0 = u.pm * 256 + wr * 64 + fr;
        f32x4 b[2][2];
#pragma unroll
        for (int bj = 0; bj < 2; ++bj) { const float* bp = bdn + (size_t)e * 1024 + u.pn * 256 + 128 * bj + 32 * wc + 8 * fq; b[bj][0] = *(const f32x4*)bp; b[bj][1] = *(const f32x4*)(bp + 4); }
        asm volatile("" ::: "memory");
#pragma unroll
        for (int bj = 0; bj < 2; ++bj) { const int col = u.pn * 256 + 128 * bj + 32 * wc + 8 * fq;
#pragma unroll
            for (int ai = 0; ai < 2; ++ai)
#pragma unroll
                for (int m = 0; m < 4; ++m) *(u32x4*)(YB + (size_t)(row0 + ai * 128 + m * 16) * 1024 + col) = pack8(acc[ai][bj][m][0] * (1.0f / 128.0f) + b[bj][0], acc[ai][bj][m][1] * (1.0f / 128.0f) + b[bj][1]); }
    }
};

struct MoeSchedUp {
    const char* H; const char* Wt; const int* list; const LAS int* tinfo; const LAS int* ecnt; int nunits, G, c;
    __device__ __forceinline__ bool next(int i, g8::Unit& u) const { const int L = i * G + c; if (L >= nunits) return false; u.pm = L >> 3; u.pn = L & 7; u.aux = tinfo[u.pm]; return true; }
    static constexpr bool GATHER = true;
    __device__ __forceinline__ const char* a_base() const { return H; }
    __device__ __forceinline__ const char* a_tile(const g8::Unit& u) const { return H; }
    __device__ __forceinline__ unsigned a_off(const g8::Unit& u, int r) const { const int e = u.aux >> 16, slot = (u.aux & 0xffff) * 256 + r; const int tok = slot < ecnt[e] ? list[(size_t)e * T + slot] : 0; return (unsigned)(tok & (T - 1)) * 1024u; }
    __device__ __forceinline__ const char* b_tile(const g8::Unit& u) const { return Wt + ((size_t)(u.aux >> 16) * 2048 + (size_t)u.pn * 256) * 1024; }
};
struct MoeSchedDown {
    const char* A; const char* Wt; const LAS int* tinfo; int nunits, G, c;
    __device__ __forceinline__ bool next(int i, g8::Unit& u) const { const int L = i * G + c; if (L >= nunits) return false; u.pm = L >> 2; u.pn = L & 3; u.aux = tinfo[u.pm]; return true; }
    static constexpr bool GATHER = false;
    __device__ __forceinline__ const char* a_base() const { return A; }
    __device__ __forceinline__ const char* a_tile(const g8::Unit& u) const { return A + (size_t)u.pm * 256 * 1024; }
    __device__ __forceinline__ unsigned a_off(const g8::Unit& u, int r) const { return 0u; }
    __device__ __forceinline__ const char* b_tile(const g8::Unit& u) const { return Wt + ((size_t)(u.aux >> 16) * 1024 + (size_t)u.pn * 256) * 1024; }
};
__device__ __forceinline__ void build_moe_tables(LAS unsigned char* lds, unsigned* gcnt) {
    LAS int* tinfo = (LAS int*)(lds + TAB_TINFO); LAS int* ecnt = (LAS int*)(lds + TAB_ECNT); LAS int* tstart = (LAS int*)(lds + TAB_TSTART); LAS int* ntp = (LAS int*)(lds + TAB_NT);
    int tid = threadIdx.x; asm volatile("" : "+v"(tid));
    __syncthreads();
    if (tid < 32) ecnt[tid] = (int)__hip_atomic_load(gcnt + tid, __ATOMIC_RELAXED, __HIP_MEMORY_SCOPE_AGENT);
    __syncthreads();
    if (tid < 32) { int ts = 0; for (int e = 0; e < tid; ++e) ts += (ecnt[e] + 255) >> 8; const int n = (ecnt[tid] + 255) >> 8; tstart[tid] = ts;
        for (int lt = 0; lt < n; ++lt) tinfo[ts + lt] = (tid << 16) | lt; if (tid == 31) ntp[0] = ts + n; }
    __syncthreads();
}

namespace att {
constexpr int QBLK = 32, KVBLK = 64;
#define KSWZ256(row, colB) ((row) * 256 + ((colB) ^ (((row) & 7) << 4)))
#define KSWZ128(row, colB) ((row) * 128 + ((colB) ^ (((row) & 7) << 4)))
__device__ __forceinline__ int crow(int r, int hi) { return (r & 3) + 8 * (r >> 2) + 4 * hi; }
__device__ __forceinline__ int v_st(int k, int c) { const int kk = (k & ~0xC) | ((k & 4) << 1) | ((k & 8) >> 1); return ((kk >> 3) * 4 + (c >> 5)) * 512 + ((kk & 7) * 32 + (c & 31)) * 2; }
__device__ __forceinline__ int v_rd_base(int lane) { return ((lane & 3) << 3) | (((lane >> 2) & 3) << 6) | (((lane >> 4) & 1) << 5) | (((lane >> 5) & 1) << 8); }
constexpr int v_rd_off(int d0, int ks, int half) { return d0 * 512 + ks * 4096 + half * 2048; }
template <int OFF> __device__ __forceinline__ s16x4 tr_read(int vb) { s16x4 r; asm volatile("ds_read_b64_tr_b16 %0, %1 offset:%2" : "=&v"(r) : "v"(vb), "i"(OFF) : "memory"); return r; }
template <int D0> __device__ __forceinline__ void pv_one(f32x16& od, int vb, bf16x8 pa0, bf16x8 pa1, bf16x8 pa2, bf16x8 pa3) {
    const s16x4 l0 = tr_read<v_rd_off(D0, 0, 0)>(vb), h0 = tr_read<v_rd_off(D0, 0, 1)>(vb), l1 = tr_read<v_rd_off(D0, 1, 0)>(vb), h1 = tr_read<v_rd_off(D0, 1, 1)>(vb);
    const s16x4 l2 = tr_read<v_rd_off(D0, 2, 0)>(vb), h2 = tr_read<v_rd_off(D0, 2, 1)>(vb), l3 = tr_read<v_rd_off(D0, 3, 0)>(vb), h3 = tr_read<v_rd_off(D0, 3, 1)>(vb);
    asm volatile("s_waitcnt lgkmcnt(0)" ::: "memory"); SBAR();
#define PKV(L, H) (bf16x8){L[0], L[1], L[2], L[3], H[0], H[1], H[2], H[3]}
    od = __builtin_amdgcn_mfma_f32_32x32x16_bf16(pa0, PKV(l0, h0), od, 0, 0, 0);
    od = __builtin_amdgcn_mfma_f32_32x32x16_bf16(pa1, PKV(l1, h1), od, 0, 0, 0);
    od = __builtin_amdgcn_mfma_f32_32x32x16_bf16(pa2, PKV(l2, h2), od, 0, 0, 0);
    od = __builtin_amdgcn_mfma_f32_32x32x16_bf16(pa3, PKV(l3, h3), od, 0, 0, 0);
#undef PKV
}
template <int D0, int H> __device__ __forceinline__ void pv_half(f32x16& od, int vb, bf16x8 pa, bf16x8 pb) {
    const s16x4 l0 = tr_read<v_rd_off(D0, 2 * H, 0)>(vb), h0 = tr_read<v_rd_off(D0, 2 * H, 1)>(vb), l1 = tr_read<v_rd_off(D0, 2 * H + 1, 0)>(vb), h1 = tr_read<v_rd_off(D0, 2 * H + 1, 1)>(vb);
    asm volatile("s_waitcnt lgkmcnt(0)" ::: "memory"); SBAR();
#define PKV(L, H_) (bf16x8){L[0], L[1], L[2], L[3], H_[0], H_[1], H_[2], H_[3]}
    od = __builtin_amdgcn_mfma_f32_32x32x16_bf16(pa, PKV(l0, h0), od, 0, 0, 0);
    od = __builtin_amdgcn_mfma_f32_32x32x16_bf16(pb, PKV(l1, h1), od, 0, 0, 0);
#undef PKV
}
__device__ __forceinline__ void p_to_frag(const f32x16& p0, const f32x16& p1, bf16x8& pa0, bf16x8& pa1, bf16x8& pa2, bf16x8& pa3) {
#define PK4(P, BASE, OUT) do { unsigned a0 = cvt_pk_bf16(P[BASE + 0], P[BASE + 1]), a1 = cvt_pk_bf16(P[BASE + 2], P[BASE + 3]);   \
    unsigned b0 = cvt_pk_bf16(P[BASE + 4], P[BASE + 5]), b1 = cvt_pk_bf16(P[BASE + 6], P[BASE + 7]);                              \
    auto r0 = __builtin_amdgcn_permlane32_swap(a0, b0, false, false); auto r1 = __builtin_amdgcn_permlane32_swap(a1, b1, false, false); \
    u32x4 w = {r0[0], r1[0], r0[1], r1[1]}; OUT = *reinterpret_cast<bf16x8*>(&w); } while (0)
    PK4(p0, 0, pa0); PK4(p0, 8, pa1); PK4(p1, 0, pa2); PK4(p1, 8, pa3);
#undef PK4
}

constexpr float SCALE_D = 0.07216878364870322f;
constexpr float THR = 8.f;
constexpr size_t SHM_V = KVBLK * 128 * 2, SHM_K = KVBLK * 128 * 2, SHM_R = KVBLK * 64 * 2;
constexpr int DENSE_LDS = 2 * SHM_V + 2 * SHM_K + 2 * SHM_R + NWAVES * 64 * 4 + NWAVES * 4096;
__device__ __forceinline__ void partialSM(f32x16& p0, f32x16& p1, float& m_reg, float& mn, float& alpha) {
    constexpr float C = SCALE_D * 1.4426950408889634f;
    float pmax = p0[0];
#pragma unroll
    for (int r = 1; r < 16; ++r) pmax = fmaxf(pmax, p0[r]);
#pragma unroll
    for (int r = 0; r < 16; ++r) pmax = fmaxf(pmax, p1[r]);
    { auto rr = __builtin_amdgcn_permlane32_swap(__float_as_uint(pmax), __float_as_uint(pmax), false, false);
      pmax = fmaxf(__uint_as_float(rr[0]), __uint_as_float(rr[1])); }
    if (__builtin_expect(__all(pmax - m_reg <= THR / SCALE_D), 1)) { mn = m_reg; alpha = 1.f; }
    else { mn = fmaxf(m_reg, pmax); alpha = __builtin_amdgcn_exp2f((m_reg - mn) * C); m_reg = mn; }
    const float mnC = -mn * C;
#pragma unroll
    for (int r = 0; r < 16; ++r) p0[r] = fmaf(p0[r], C, mnC);
#pragma unroll
    for (int r = 0; r < 16; ++r) p1[r] = fmaf(p1[r], C, mnC);
#pragma unroll
    for (int r = 0; r < 16; ++r) p0[r] = __builtin_amdgcn_exp2f(p0[r]);
}
__device__ __forceinline__ void finishSM(f32x16& p0, f32x16& p1, float alpha, float& l_reg, bf16x8& pa0, bf16x8& pa1, bf16x8& pa2, bf16x8& pa3) {
#pragma unroll
    for (int r = 0; r < 16; ++r) p1[r] = __builtin_amdgcn_exp2f(p1[r]);
    float ps = 0;
#pragma unroll
    for (int r = 0; r < 16; ++r) ps += p0[r];
#pragma unroll
    for (int r = 0; r < 16; ++r) ps += p1[r];
    { auto rr = __builtin_amdgcn_permlane32_swap(__float_as_uint(ps), __float_as_uint(ps), false, false);
      ps = __uint_as_float(rr[0]) + __uint_as_float(rr[1]); }
    l_reg = l_reg * alpha + ps;
    p_to_frag(p0, p1, pa0, pa1, pa2, pa3);
}
__device__ __forceinline__ void qkt_d(f32x16& p0, f32x16& p1, const char* Kn, const char* Kr, const bf16x8* qr, const char* Qrl, int r32, int hi) {
    p0 = f32x16{}; p1 = f32x16{};
#pragma unroll
    for (int d0 = 0; d0 < 8; ++d0) { const int cb = (d0 * 16 + hi * 8) * 2;
        const bf16x8 b0 = *reinterpret_cast<const bf16x8*>(Kn + KSWZ256(r32, cb));
        const bf16x8 b1 = *reinterpret_cast<const bf16x8*>(Kn + KSWZ256(32 + r32, cb));
        p0 = __builtin_amdgcn_mfma_f32_32x32x16_bf16(b0, qr[d0], p0, 0, 0, 0);
        p1 = __builtin_amdgcn_mfma_f32_32x32x16_bf16(b1, qr[d0], p1, 0, 0, 0); }
#pragma unroll
    for (int d0 = 0; d0 < 4; ++d0) { const int cb = (d0 * 16 + hi * 8) * 2;
        const bf16x8 b0 = *reinterpret_cast<const bf16x8*>(Kr + KSWZ128(r32, cb));
        const bf16x8 b1 = *reinterpret_cast<const bf16x8*>(Kr + KSWZ128(32 + r32, cb));
        const bf16x8 qf = *reinterpret_cast<const bf16x8*>(Qrl + d0 * 1024);
        p0 = __builtin_amdgcn_mfma_f32_32x32x16_bf16(b0, qf, p0, 0, 0, 0);
        p1 = __builtin_amdgcn_mfma_f32_32x32x16_bf16(b1, qf, p1, 0, 0, 0); }
}
__device__ __forceinline__ void pv_d4(f32x16* o, int vb, bf16x8 pa0, bf16x8 pa1, bf16x8 pa2, bf16x8 pa3) {
    pv_one<0>(o[0], vb, pa0, pa1, pa2, pa3); pv_one<1>(o[1], vb, pa0, pa1, pa2, pa3); pv_one<2>(o[2], vb, pa0, pa1, pa2, pa3); pv_one<3>(o[3], vb, pa0, pa1, pa2, pa3);
}
__device__ __forceinline__ void dense_unit(const bf16_t* __restrict__ Qb, const bf16_t* __restrict__ Knp, const bf16_t* __restrict__ Vh, const bf16_t* __restrict__ Krp, bf16_t* __restrict__ Ob, int seq, char* lds) {
    constexpr int LDQ = 1536, LDK = 2048, LDR = 64, LDO = 2048, SD = 1;
    int tid = threadIdx.x; asm volatile("" : "+v"(tid));
    const int wid = tid >> 6, lane = tid & 63, r32 = lane & 31, hi = lane >> 5;
    char* V_lds = lds; char* K_lds = lds + 2 * SHM_V; char* R_lds = lds + 2 * SHM_V + 2 * SHM_K;
    float* ws = (float*)(lds + 2 * SHM_V + 2 * SHM_K + 2 * SHM_R) + wid * 64; float* li_l = ws; float* al_l = ws + 32;
    float m_reg = -1e30f, l_reg = 0; f32x16 o[4] = {}; bf16x8 qr[8];
    const bf16_t* Qw = Qb + (long)(wid * QBLK + r32) * LDQ + hi * 8;
    char* Qrl = lds + 2 * SHM_V + 2 * SHM_K + 2 * SHM_R + NWAVES * 64 * 4 + wid * 4096 + lane * 16;
#pragma unroll
    for (int d0 = 0; d0 < 8; ++d0) qr[d0] = *reinterpret_cast<const bf16x8*>(Qw + d0 * 16);
#pragma unroll
    for (int d0 = 0; d0 < 4; ++d0) *reinterpret_cast<bf16x8*>(Qrl + d0 * 1024) = *reinterpret_cast<const bf16x8*>(Qw + 128 + d0 * 16);
    const int sr = tid >> 4, sc = (tid & 15) * 8, vst0 = v_st(sr, sc), vst1 = v_st(32 + sr, sc);
    const int rr = tid >> 3, rc = (tid & 7) * 8;
    const int vb0 = (int)(uintptr_t)V_lds + v_rd_base(lane);
    struct { bf16x8 vs0, vs1, ks0, ks1, rs; } sr_[SD];
#define SLOAD(i, k0) do { sr_[i].vs0 = *(const bf16x8*)(&Vh[(long)((k0) + sr) * LDK + sc]); sr_[i].vs1 = *(const bf16x8*)(&Vh[(long)((k0) + 32 + sr) * LDK + sc]); \
    sr_[i].ks0 = *(const bf16x8*)(&Knp[(long)((k0) + sr) * LDK + sc]); sr_[i].ks1 = *(const bf16x8*)(&Knp[(long)((k0) + 32 + sr) * LDK + sc]); \
    sr_[i].rs = *(const bf16x8*)(&Krp[(long)((k0) + rr) * LDR + rc]); } while (0)
#define SWRITE(b, i) do { *(bf16x8*)(V_lds + (b) * SHM_V + vst0) = sr_[i].vs0; *(bf16x8*)(V_lds + (b) * SHM_V + vst1) = sr_[i].vs1; const int kc = sc * 2; \
    *(bf16x8*)(K_lds + (b) * SHM_K + KSWZ256(sr, kc)) = sr_[i].ks0; *(bf16x8*)(K_lds + (b) * SHM_K + KSWZ256(32 + sr, kc)) = sr_[i].ks1; \
    *(bf16x8*)(R_lds + (b) * SHM_R + KSWZ128(rr, rc * 2)) = sr_[i].rs; } while (0)
#define SWAIT() asm volatile("s_waitcnt vmcnt(0)" ::: "memory")
#define RESC(a) do { if (__any((a) < 1.f)) { if (hi == 0) al_l[r32] = (a); asm volatile("s_waitcnt lgkmcnt(0)" ::: "memory"); \
    _Pragma("unroll") for (int d = 0; d < 4; ++d) _Pragma("unroll") for (int r = 0; r < 16; ++r) o[d][r] *= al_l[crow(r, hi)]; } } while (0)
    f32x16 pA0, pA1, pB0, pB1; float mnA, mnB, alA, alB; bf16x8 pa0, pa1, pa2, pa3; const int NT = seq / KVBLK;
    __syncthreads();
    SLOAD(0, 0); asm volatile("s_waitcnt vmcnt(0)" ::: "memory"); SWRITE(0, 0); __syncthreads();
    qkt_d(pA0, pA1, K_lds, R_lds, qr, Qrl, r32, hi); partialSM(pA0, pA1, m_reg, mnA, alA);
    SLOAD(0, KVBLK);
    SWAIT(); SWRITE(1, 0); __syncthreads();
    for (int j = 1; j + 1 < NT; j += 2) {
        SBAR(); qkt_d(pB0, pB1, K_lds + SHM_K, R_lds + SHM_R, qr, Qrl, r32, hi);
        finishSM(pA0, pA1, alA, l_reg, pa0, pa1, pa2, pa3); SBAR();
        SLOAD(0, (j + 1) * KVBLK); SBAR();
        pv_d4(o, vb0, pa0, pa1, pa2, pa3); partialSM(pB0, pB1, m_reg, mnB, alB);
        __syncthreads(); SWAIT(); SWRITE(0, 0);
        RESC(alB); __syncthreads();
        SBAR(); qkt_d(pA0, pA1, K_lds, R_lds, qr, Qrl, r32, hi);
        finishSM(pB0, pB1, alB, l_reg, pa0, pa1, pa2, pa3); SBAR();
        SLOAD(0, (j + 2) * KVBLK); SBAR();
        pv_d4(o, vb0 + (int)SHM_V, pa0, pa1, pa2, pa3); partialSM(pA0, pA1, m_reg, mnA, alA);
        __syncthreads(); SWAIT(); SWRITE(1, 0);
        RESC(alA); __syncthreads();
    }
    SBAR(); qkt_d(pB0, pB1, K_lds + SHM_K, R_lds + SHM_R, qr, Qrl, r32, hi);
    finishSM(pA0, pA1, alA, l_reg, pa0, pa1, pa2, pa3); SBAR();
    pv_d4(o, vb0, pa0, pa1, pa2, pa3); partialSM(pB0, pB1, m_reg, mnB, alB);
    __syncthreads(); RESC(alB);
    finishSM(pB0, pB1, alB, l_reg, pa0, pa1, pa2, pa3); SBAR();
    pv_d4(o, vb0 + (int)SHM_V, pa0, pa1, pa2, pa3);
    if (hi == 0) li_l[r32] = l_reg; asm volatile("s_waitcnt lgkmcnt(0)" ::: "memory");
    float rli[16];
#pragma unroll
    for (int r = 0; r < 16; ++r) rli[r] = __builtin_amdgcn_rcpf(li_l[crow(r, hi)]);
    bf16_t* Ow = Ob + (long)(wid * QBLK) * LDO;
#pragma unroll
    for (int r = 0; r < 16; ++r) { const int orow = crow(r, hi);
#pragma unroll
        for (int d0 = 0; d0 < 4; ++d0) { const float v = o[d0][r] * rli[r]; Ow[(long)orow * LDO + d0 * 32 + r32] = (bf16_t)(cvt_pk_bf16(v, v) & 0xffffu); } }
#undef SLOAD
#undef SWRITE
#undef SWAIT
#undef RESC
}

constexpr float SCALE_B = 0.125f;

template <bool H0, bool H1>
__device__ __forceinline__ void band_tile(const char* Kc, int vbc, const bf16x8 (&qr)[4], f32x16 (&o)[2], float& m_reg, float& l_reg, float* al_l, int k0, int qw, int qi, int R, int r32, int hi) {
    constexpr float C = SCALE_B * 1.4426950408889634f;
    f32x16 p0 = {}, p1 = {};
#pragma unroll
    for (int d0 = 0; d0 < 4; ++d0) { const int cb = (d0 * 16 + hi * 8) * 2;
        if (H0) { const bf16x8 b0 = *reinterpret_cast<const bf16x8*>(Kc + KSWZ128(r32, cb)); p0 = __builtin_amdgcn_mfma_f32_32x32x16_bf16(b0, qr[d0], p0, 0, 0, 0); }
        if (H1) { const bf16x8 b1 = *reinterpret_cast<const bf16x8*>(Kc + KSWZ128(32 + r32, cb)); p1 = __builtin_amdgcn_mfma_f32_32x32x16_bf16(b1, qr[d0], p1, 0, 0, 0); } }
    const int klo = H0 ? k0 : k0 + 32, khi = H1 ? k0 + 63 : k0 + 31;
    if (!(khi - qw <= R && qw + 31 - klo <= R)) {
        const float NEG = -__builtin_inff();
#pragma unroll
        for (int r = 0; r < 16; ++r) { const int kj = k0 + crow(r, hi);
            if (H0) { int d = qi - kj; d = d < 0 ? -d : d; if (d > R) p0[r] = NEG; }
            if (H1) { int d2 = qi - kj - 32; d2 = d2 < 0 ? -d2 : d2; if (d2 > R) p1[r] = NEG; } } }
    float pmax = H0 ? p0[0] : p1[0];
#pragma unroll
    for (int r = 0; r < 16; ++r) { if (H0) pmax = fmaxf(pmax, p0[r]); if (H1) pmax = fmaxf(pmax, p1[r]); }
    { auto rr = __builtin_amdgcn_permlane32_swap(__float_as_uint(pmax), __float_as_uint(pmax), false, false);
      pmax = fmaxf(__uint_as_float(rr[0]), __uint_as_float(rr[1])); }
    const float mn = fmaxf(m_reg, pmax), alpha = __builtin_amdgcn_exp2f((m_reg - mn) * C); m_reg = mn;
    const float mnC = -mn * C; float ps = 0.f;
#pragma unroll
    for (int r = 0; r < 16; ++r) { if (H0) { p0[r] = __builtin_amdgcn_exp2f(fmaf(p0[r], C, mnC)); ps += p0[r]; } if (H1) { p1[r] = __builtin_amdgcn_exp2f(fmaf(p1[r], C, mnC)); ps += p1[r]; } }
    { auto rr = __builtin_amdgcn_permlane32_swap(__float_as_uint(ps), __float_as_uint(ps), false, false);
      ps = __uint_as_float(rr[0]) + __uint_as_float(rr[1]); }
    l_reg = l_reg * alpha + ps;
    if (__any(alpha < 1.f)) {
        if (hi == 0) al_l[r32] = alpha; asm volatile("s_waitcnt lgkmcnt(0)" ::: "memory");
#pragma unroll
        for (int d = 0; d < 2; ++d)
#pragma unroll
            for (int r = 0; r < 16; ++r) o[d][r] *= al_l[crow(r, hi)]; }
    bf16x8 pa0, pa1, pa2, pa3; p_to_frag(p0, p1, pa0, pa1, pa2, pa3);
    if (H0 && H1) { pv_one<0>(o[0], vbc, pa0, pa1, pa2, pa3); pv_one<1>(o[1], vbc, pa0, pa1, pa2, pa3); }
    else if (H0) { pv_half<0, 0>(o[0], vbc, pa0, pa1); pv_half<1, 0>(o[1], vbc, pa0, pa1); }
    else { pv_half<0, 1>(o[0], vbc, pa2, pa3); pv_half<1, 1>(o[1], vbc, pa2, pa3); }
}
constexpr int BAND_LDS = 2 * 8192 + 2 * 16384 + NWAVES * 64 * 4;
template <bool SINK, bool WLSE>
__device__ __forceinline__ void banded_unit(const bf16_t* __restrict__ Qb, long ldq, const bf16_t* __restrict__ Kb, const bf16_t* __restrict__ Vb, long ldk, bf16_t* __restrict__ Ob, long ldo,
                                            int L, int q0, int R, float sinkv, float* lse, long ldl, char* lds) {
    constexpr float C = SCALE_B * 1.4426950408889634f;
    int tid = threadIdx.x; asm volatile("" : "+v"(tid));
    const int wid = tid >> 6, lane = tid & 63, r32 = lane & 31, hi = lane >> 5;
    char* K_lds = lds; char* V_lds = lds + 2 * 8192; float* al_l = (float*)(lds + 2 * 8192 + 2 * 16384) + wid * 64;
    const int qw = q0 + wid * QBLK;
    bf16x8 qr[4];
    const bf16_t* Qw = Qb + (long)(wid * QBLK + r32) * ldq + hi * 8;
#pragma unroll
    for (int d0 = 0; d0 < 4; ++d0) qr[d0] = *reinterpret_cast<const bf16x8*>(Qw + d0 * 16);
    float m_reg = SINK ? sinkv * (1.0f / SCALE_B) : -1e30f, l_reg = SINK ? 1.f : 0.f; f32x16 o[2] = {};
    const int srow = tid >> 3, scol = (tid & 7) * 8, vst = v_st(srow, scol), kst = KSWZ128(srow, scol * 2);
    const int vb0 = (int)(uintptr_t)V_lds + v_rd_base(lane);
    const int kt0 = (q0 - R > 0 ? q0 - R : 0) / KVBLK, kt1 = (q0 + 256 + R < L ? q0 + 256 + R : L) / KVBLK;
    const int qi = qw + r32;
    const bf16_t* kp = Kb + (long)(kt0 * KVBLK + srow) * ldk + scol; const bf16_t* vp = Vb + (long)(kt0 * KVBLK + srow) * ldk + scol; const long tstep = (long)KVBLK * ldk;
    bf16x8 kreg = *(const bf16x8*)kp, vreg = *(const bf16x8*)vp;
    __syncthreads();
    for (int kt = kt0; kt < kt1; ++kt) {
        const int k0 = kt * KVBLK, bsel = (kt - kt0) & 1;
        char* Kc = K_lds + bsel * 8192; char* Vc = V_lds + bsel * 16384;
        *(bf16x8*)(Kc + kst) = kreg; *(bf16x8*)(Vc + vst) = vreg;
        if (kt + 1 < kt1) { kp += tstep; vp += tstep; kreg = *(const bf16x8*)kp; vreg = *(const bf16x8*)vp; }
        __syncthreads();
        const bool rel0 = (k0 + 31 >= qw - R) && (k0 <= qw + 31 + R), rel1 = (k0 + 63 >= qw - R) && (k0 + 32 <= qw + 31 + R);
        const int vbc = vb0 + bsel * 16384;
        if (rel0 && rel1) band_tile<true, true>(Kc, vbc, qr, o, m_reg, l_reg, al_l, k0, qw, qi, R, r32, hi);
        else if (rel0) band_tile<true, false>(Kc, vbc, qr, o, m_reg, l_reg, al_l, k0, qw, qi, R, r32, hi);
        else if (rel1) band_tile<false, true>(Kc, vbc, qr, o, m_reg, l_reg, al_l, k0, qw, qi, R, r32, hi);
    }
    asm volatile("s_waitcnt lgkmcnt(0)" ::: "memory");
    if (hi == 0) al_l[r32] = l_reg; asm volatile("s_waitcnt lgkmcnt(0)" ::: "memory");
    bf16_t* Ow = Ob + (long)(wid * QBLK) * ldo;
#pragma unroll
    for (int r = 0; r < 16; ++r) { const int orow = crow(r, hi); const float rl = __builtin_amdgcn_rcpf(al_l[orow]);
#pragma unroll
        for (int d0 = 0; d0 < 2; ++d0) { const float v = o[d0][r] * rl; Ow[(long)orow * ldo + d0 * 32 + r32] = (bf16_t)(cvt_pk_bf16(v, v) & 0xffffu); } }
    if (WLSE) { if (hi == 0) lse[(long)(wid * QBLK + r32) * ldl] = m_reg * SCALE_B + __logf(l_reg); }
    asm volatile("s_waitcnt lgkmcnt(0)" ::: "memory");
}

constexpr int B2_ROWS = 384, B2_K = B2_ROWS * 128, B2_V = B2_ROWS * 128, B2_LDS = B2_K + B2_V + NWAVES * 64 * 4;
__device__ __forceinline__ int v_st64(int k, int c) { const int kk = (k & ~0xC) | ((k & 4) << 1) | ((k & 8) >> 1); return ((kk >> 3) * 2 + (c >> 5)) * 512 + ((kk & 7) * 32 + (c & 31)) * 2; }
struct B2Stage { bf16x8 k[6], v[6]; };
__device__ __forceinline__ void b2_load(B2Stage& st, const bf16_t* __restrict__ Kb, const bf16_t* __restrict__ Vb, long ldk, int kb, int nrows, int tid) {
#pragma unroll
    for (int i = 0; i < 6; ++i) { const int id = tid + 512 * i, row = id >> 3, ch = (id & 7) * 8;
        const int rc = row < nrows ? row : nrows - 1;
        st.k[i] = *(const bf16x8*)(Kb + (long)(kb + rc) * ldk + ch); st.v[i] = *(const bf16x8*)(Vb + (long)(kb + rc) * ldk + ch); }
}
__device__ __forceinline__ void b2_write(const B2Stage& st, char* lds, int nrows, int tid) {
#pragma unroll
    for (int i = 0; i < 6; ++i) { const int id = tid + 512 * i, row = id >> 3, ch = (id & 7) * 8;
        if (row < nrows) { *(bf16x8*)(lds + KSWZ128(row, ch * 2)) = st.k[i]; *(bf16x8*)(lds + B2_K + v_st64(row, ch)) = st.v[i]; } }
}
template <int D0> __device__ __forceinline__ void pv_h(f32x16& od, int vb, bf16x8 pa, bf16x8 pb) {
    const s16x4 l0 = tr_read<D0 * 512>(vb), h0 = tr_read<D0 * 512 + 1024>(vb), l1 = tr_read<D0 * 512 + 2048>(vb), h1 = tr_read<D0 * 512 + 3072>(vb);
    asm volatile("s_waitcnt lgkmcnt(0)" ::: "memory"); SBAR();
#define PKV(L, H_) (bf16x8){L[0], L[1], L[2], L[3], H_[0], H_[1], H_[2], H_[3]}
    od = __builtin_amdgcn_mfma_f32_32x32x16_bf16(pa, PKV(l0, h0), od, 0, 0, 0);
    od = __builtin_amdgcn_mfma_f32_32x32x16_bf16(pb, PKV(l1, h1), od, 0, 0, 0);
#undef PKV
}
template <bool SINK, bool WLSE>
__device__ __forceinline__ void b2_task(const bf16x8 (&qr)[4], bf16_t* __restrict__ Ow, long ldo, float* lsew, long ldl, float sinkv, int qw, int kbase, int L, int R, const char* lds, float* al_l, int lane) {
    constexpr float C = SCALE_B * 1.4426950408889634f;
    const int r32 = lane & 31, hi = lane >> 5, qi = qw + r32;
    float m_reg = SINK ? sinkv * (1.0f / SCALE_B) : -1e30f, l_reg = SINK ? 1.f : 0.f; f32x16 o[2] = {};
    const int vb0 = (int)(uintptr_t)(lds + B2_K) + v_rd_base(lane);
    const int h0 = (qw - R > 0 ? qw - R : 0), h1 = (qw + R + 32 < L ? qw + R + 32 : L);
    for (int k0 = h0; k0 < h1; k0 += 32) { const int r0 = k0 - kbase;
        f32x16 p = {};
#pragma unroll
        for (int d0 = 0; d0 < 4; ++d0) { const bf16x8 kf = *reinterpret_cast<const bf16x8*>(lds + KSWZ128(r0 + r32, (d0 * 16 + hi * 8) * 2)); p = __builtin_amdgcn_mfma_f32_32x32x16_bf16(kf, qr[d0], p, 0, 0, 0); }
        if (k0 < qw - R + 32 || k0 + 31 > qw + R) {
            const float NEG = -__builtin_inff();
#pragma unroll
            for (int r = 0; r < 16; ++r) { int d = qi - (k0 + crow(r, hi)); d = d < 0 ? -d : d; if (d > R) p[r] = NEG; } }
        float pmax = p[0];
#pragma unroll
        for (int r = 1; r < 16; ++r) pmax = fmaxf(pmax, p[r]);
        { auto rr = __builtin_amdgcn_permlane32_swap(__float_as_uint(pmax), __float_as_uint(pmax), false, false); pmax = fmaxf(__uint_as_float(rr[0]), __uint_as_float(rr[1])); }
        const float mn = fmaxf(m_reg, pmax), alpha = __builtin_amdgcn_exp2f((m_reg - mn) * C); m_reg = mn;
        const float mnC = -mn * C; float ps = 0.f;
#pragma unroll
        for (int r = 0; r < 16; ++r) { p[r] = __builtin_amdgcn_exp2f(fmaf(p[r], C, mnC)); ps += p[r]; }
        { auto rr = __builtin_amdgcn_permlane32_swap(__float_as_uint(ps), __float_as_uint(ps), false, false); ps = __uint_as_float(rr[0]) + __uint_as_float(rr[1]); }
        l_reg = l_reg * alpha + ps;
        if (__any(alpha < 1.f)) {
            if (hi == 0) al_l[r32] = alpha; asm volatile("s_waitcnt lgkmcnt(0)" ::: "memory");
#pragma unroll
            for (int d = 0; d < 2; ++d)
#pragma unroll
                for (int r = 0; r < 16; ++r) o[d][r] *= al_l[crow(r, hi)]; }
        bf16x8 pa, pb;
        { unsigned a0 = cvt_pk_bf16(p[0], p[1]), a1 = cvt_pk_bf16(p[2], p[3]), b0 = cvt_pk_bf16(p[4], p[5]), b1 = cvt_pk_bf16(p[6], p[7]);
          auto x0 = __builtin_amdgcn_permlane32_swap(a0, b0, false, false); auto x1 = __builtin_amdgcn_permlane32_swap(a1, b1, false, false);
          u32x4 w = {x0[0], x1[0], x0[1], x1[1]}; pa = *reinterpret_cast<bf16x8*>(&w); }
        { unsigned a0 = cvt_pk_bf16(p[8], p[9]), a1 = cvt_pk_bf16(p[10], p[11]), b0 = cvt_pk_bf16(p[12], p[13]), b1 = cvt_pk_bf16(p[14], p[15]);
          auto x0 = __builtin_amdgcn_permlane32_swap(a0, b0, false, false); auto x1 = __builtin_amdgcn_permlane32_swap(a1, b1, false, false);
          u32x4 w = {x0[0], x1[0], x0[1], x1[1]}; pb = *reinterpret_cast<bf16x8*>(&w); }
        const int vbc = vb0 + r0 * 128;
        pv_h<0>(o[0], vbc, pa, pb); pv_h<1>(o[1], vbc, pa, pb);
    }
    asm volatile("s_waitcnt lgkmcnt(0)" ::: "memory");
    if (hi == 0) al_l[r32] = l_reg; asm volatile("s_waitcnt lgkmcnt(0)" ::: "memory");
#pragma unroll
    for (int r = 0; r < 16; ++r) { const int orow = crow(r, hi); const float rl = __builtin_amdgcn_rcpf(al_l[orow]);
#pragma unroll
        for (int d0 = 0; d0 < 2; ++d0) { const float v = o[d0][r] * rl; Ow[(long)orow * ldo + d0 * 32 + r32] = (bf16_t)(cvt_pk_bf16(v, v) & 0xffffu); } }
    if (WLSE) { if (hi == 0) lsew[(long)r32 * ldl] = m_reg * SCALE_B + __logf(l_reg); }
    asm volatile("s_waitcnt lgkmcnt(0)" ::: "memory");
}
}

__device__ __forceinline__ void norm_row_store(const f32x4 (&v)[4], const float* g, const float* sh, const float* sc, bf16_t* hrow, int lane) {
    float ss = 0.f;
#pragma unroll
    for (int j = 0; j < 4; ++j) ss += (v[j][0] * v[j][0] + v[j][1] * v[j][1]) + (v[j][2] * v[j][2] + v[j][3] * v[j][3]);
    const float rstd = 1.0f / sqrtf(wave_sum(ss) * (1.0f / 1024.0f) + EPS);
#pragma unroll
    for (int j = 0; j < 4; ++j) { const int c = 4 * lane + 256 * j;
        const f32x4 gv = *(const f32x4*)(g + c), shv = *(const f32x4*)(sh + c), scv = *(const f32x4*)(sc + c);
        const f32x4 y = v[j] * rstd * gv * (scv + 1.0f) + shv;
        u32x2 w; w.x = cvt_pk_bf16(y[0], y[1]); w.y = cvt_pk_bf16(y[2], y[3]);
        *(u32x2*)(hrow + c) = w; }
}

__device__ __forceinline__ void conv_item(const float* __restrict__ W, int ldw, int K, int src0, int k0, bf16_t* __restrict__ Wt, int pos0, const float* kscale, LAS float* scr, int lane) {
#pragma unroll 8
    for (int i = 0; i < 32; ++i) { const int kk = 2 * i + (lane >> 5); float v = 0.f;
        if (src0 >= 0) { v = W[(size_t)(k0 + kk) * ldw + src0 + (lane & 31)]; if (kscale) v *= kscale[k0 + kk]; }
        scr[kk * 33 + (lane & 31)] = v; }
    LDS_WAIT(); asm volatile("" ::: "memory");
    const int c = lane & 7;
#pragma unroll
    for (int j = 0; j < 4; ++j) { const int n = (lane >> 3) + 8 * j; const LAS float* s = scr + (8 * c) * 33 + n;
        u32x4 o; o.x = cvt_pk_bf16(s[0 * 33], s[1 * 33]); o.y = cvt_pk_bf16(s[2 * 33], s[3 * 33]); o.z = cvt_pk_bf16(s[4 * 33], s[5 * 33]); o.w = cvt_pk_bf16(s[6 * 33], s[7 * 33]);
        *(u32x4*)(Wt + (size_t)(pos0 + n) * K + k0 + 8 * c) = o; }
    LDS_WAIT(); asm volatile("" ::: "memory");
}
__device__ __forceinline__ int src_inab(int pg) { const int pn = pg >> 3, bj = (pg >> 2) & 1, w = pg & 3;
    if (pn < 4) return 704 + (4 * pn + w) * 64 + 32 * bj;
    if (pn == 4) return w < 2 ? 1728 + w * 64 + 32 * bj : (w == 2 ? 640 + 32 * bj : -1);
    if (pn == 5) return 128 * bj + 32 * w;
    if (pn == 6) return bj == 0 ? 256 + 32 * w : 1856 + 32 * w;
    return 384 + 128 * bj + 32 * w; }
__device__ __forceinline__ int src_qb(int pg) { const int pn = pg >> 3, bj = (pg >> 2) & 1, w = pg & 3;
    if (pn < 2) return (4 * pn + w) * 192 + 128 + 32 * bj;
    return (2 * (pn - 2) + bj) * 192 + 32 * w; }
__device__ __forceinline__ int src_inc(int pg) { const int pn = pg >> 3, bj = (pg >> 2) & 1, w = pg & 3, gs = pn >> 2;
    if (gs % 3 < 2) return gs * 1024 + (4 * (pn & 3) + w) * 64 + 32 * bj;
    return pg * 32; }
__device__ __forceinline__ int src_gu(int pg) { const int pn = pg >> 3, bj = (pg >> 2) & 1, w = pg & 3; return 1024 * bj + 128 * pn + 32 * w; }

struct MapIdent { __device__ __forceinline__ int operator()(int pg) const { return pg * 32; } };
struct MapInAB  { __device__ __forceinline__ int operator()(int pg) const { return src_inab(pg); } };
struct MapQB    { __device__ __forceinline__ int operator()(int pg) const { return src_qb(pg); } };
struct MapInC   { __device__ __forceinline__ int operator()(int pg) const { return src_inc(pg); } };
struct MapGU    { __device__ __forceinline__ int operator()(int pg) const { return src_gu(pg); } };
template <class Map>
__device__ __forceinline__ void conv_group(const float* W, size_t mat_stride, int ldw, int K, int npos, bf16_t* Wt, const float* kscale, int kscale_stride, int nmat, Map map, LAS float* scr, int gw, int NGW, int lane, int woff = 0) {
    const int npg = npos / 32, per = (K / 64) * npg, total = per * nmat;
    for (int it = (gw + NGW - woff % NGW) % NGW; it < total; it += NGW) { const int mat = it / per, r = it - mat * per, kb = r / npg, pg = r - kb * npg;
        conv_item(W + (size_t)mat * mat_stride, ldw, K, map(pg), kb * 64, Wt + (size_t)mat * npos * K, pg * 32, kscale ? kscale + (size_t)mat * kscale_stride : nullptr, scr, lane); }
}


typedef const __attribute__((address_space(4))) Params* KParams;
#define WSL() KParams kp = (KParams)__builtin_amdgcn_kernarg_segment_ptr(); asm volatile("" : "+s"(kp)); unsigned char* wsl = kp->ws; \
    int tid = threadIdx.x; asm volatile("" : "+v"(tid)); int vcl = vcu, bxl = bx; asm volatile("" : "+s"(vcl), "+s"(bxl)); const int lane = tid & 63, wave = __builtin_amdgcn_readfirstlane(tid >> 6), gw = vcl * NWAVES + wave; (void)lane; (void)gw
#define MOD ((float*)(wsl + WS_MOD))
#define COS ((float*)(wsl + WS_COS))
#define SIN ((float*)(wsl + WS_SIN))
#define WROUT ((bf16_t*)(wsl + WS_WROUT))
#define WINAB ((bf16_t*)(wsl + WS_WINAB))
#define WQB ((bf16_t*)(wsl + WS_WQB))
#define WKVB ((bf16_t*)(wsl + WS_WKVB))
#define WOUTAB ((bf16_t*)(wsl + WS_WOUTAB))
#define WINC ((bf16_t*)(wsl + WS_WINC))
#define WOUTC ((bf16_t*)(wsl + WS_WOUTC))
#define WGU ((bf16_t*)(wsl + WS_WGU))
#define WDOWN ((bf16_t*)(wsl + WS_WDOWN))
#define X ((float*)(wsl + WS_X))
#define H ((bf16_t*)(wsl + WS_H))
#define QB ((bf16_t*)(wsl + WS_QB))
#define KB ((bf16_t*)(wsl + WS_KB))
#define VB ((bf16_t*)(wsl + WS_VB))
#define KR ((bf16_t*)(wsl + WS_KR))
#define CQ ((bf16_t*)(wsl + WS_CQ))
#define CKV ((bf16_t*)(wsl + WS_CKV))
#define SSQ ((float*)(wsl + WS_SSQ))
#define QA ((bf16_t*)(wsl + WS_QA))
#define KV ((bf16_t*)(wsl + WS_KV))
#define OB ((bf16_t*)(wsl + WS_O))
#define PC ((bf16_t*)(wsl + WS_PC))
#define OG ((bf16_t*)(wsl + WS_OG))
#define LSE ((float*)(wsl + WS_LSE))
#define OC ((bf16_t*)(wsl + WS_OC))
#define LIST ((int*)(wsl + WS_LIST))
#define TOKE ((int*)(wsl + WS_TOKE))
#define GATE ((float*)(wsl + WS_GATE))
#define ACT ((unsigned char*)(wsl + WS_ACT))
#define H8 ((unsigned char*)(wsl + WS_H8))
#define YB ((bf16_t*)(wsl + WS_YB))

template <class Map>
__device__ __forceinline__ void conv2_group(const float* __restrict__ W, size_t mat_stride, int ldw, int K, int npos, bf16_t* __restrict__ Wt, const float* kscale, int kscale_stride, int nmat, Map map, int gw, int NGW, int lane, int woff = 0) {
    const int npb = npos / 256, per = (K / 64) * npb, total = per * nmat;
    for (int it = (gw + NGW - woff % NGW) % NGW; it < total; it += NGW) { const int mat = it / per, r = it - mat * per, kblk = r / npb, nb = r - kblk * npb;
        const int pos = nb * 256 + lane * 4; const int sg = map(pos >> 5); const int src = sg + (pos & 31);
        const float* wp = W + (size_t)mat * mat_stride + (size_t)(kblk * 64) * ldw + (sg < 0 ? 0 : src);
        const float* ks = kscale ? kscale + (size_t)mat * kscale_stride + kblk * 64 : nullptr;
        bf16_t* op = Wt + ((size_t)mat * npos + pos) * K + kblk * 64;
#pragma unroll 2
        for (int s8 = 0; s8 < 8; ++s8) { f32x4 v[8];
#pragma unroll
            for (int j = 0; j < 8; ++j) { v[j] = *(const f32x4*)(wp + (size_t)(s8 * 8 + j) * ldw); if (ks) v[j] = v[j] * ks[s8 * 8 + j]; }
            if (sg < 0) {
#pragma unroll
                for (int j = 0; j < 8; ++j) v[j] = (f32x4){0.f, 0.f, 0.f, 0.f}; }
#pragma unroll
            for (int i = 0; i < 4; ++i) { u32x4 o; o.x = cvt_pk_bf16(v[0][i], v[1][i]); o.y = cvt_pk_bf16(v[2][i], v[3][i]); o.z = cvt_pk_bf16(v[4][i], v[5][i]); o.w = cvt_pk_bf16(v[6][i], v[7][i]);
                *(u32x4*)(op + (size_t)i * K + s8 * 8) = o; } } }
}

__device__ __forceinline__ void conv8_load(f32x4 (&v)[16], const float* wp, int ldw) {
#pragma unroll
    for (int j = 0; j < 16; ++j) v[j] = *(const f32x4*)(wp + (size_t)j * ldw);
}
__device__ __forceinline__ void conv8_store(const f32x4 (&v)[16], unsigned char* op, int K, float scale) {
#pragma unroll
    for (int i = 0; i < 4; ++i) { u32x4 o;
        o.x = (unsigned)__builtin_amdgcn_cvt_pk_fp8_f32(v[2][i] * scale, v[3][i] * scale, __builtin_amdgcn_cvt_pk_fp8_f32(v[0][i] * scale, v[1][i] * scale, 0, false), true);
        o.y = (unsigned)__builtin_amdgcn_cvt_pk_fp8_f32(v[6][i] * scale, v[7][i] * scale, __builtin_amdgcn_cvt_pk_fp8_f32(v[4][i] * scale, v[5][i] * scale, 0, false), true);
        o.z = (unsigned)__builtin_amdgcn_cvt_pk_fp8_f32(v[10][i] * scale, v[11][i] * scale, __builtin_amdgcn_cvt_pk_fp8_f32(v[8][i] * scale, v[9][i] * scale, 0, false), true);
        o.w = (unsigned)__builtin_amdgcn_cvt_pk_fp8_f32(v[14][i] * scale, v[15][i] * scale, __builtin_amdgcn_cvt_pk_fp8_f32(v[12][i] * scale, v[13][i] * scale, 0, false), true);
        *(u32x4*)(op + (size_t)i * K) = o; }
}
template <class Map>
__device__ __forceinline__ void conv8_group(const float* __restrict__ W, size_t mat_stride, int ldw, int K, int npos, unsigned char* __restrict__ Wt, float scale, int nmat, Map map, int gw, int NGW, int lane) {
    const int npb = npos / 256, per = (K / 64) * npb, total = per * nmat;
    for (int it = gw; it < total; it += NGW) { const int mat = it / per, r = it - mat * per, kblk = r / npb, nb = r - kblk * npb;
        const int pos = nb * 256 + lane * 4; const int src = map(pos >> 5) + (pos & 31);
        const float* wp = W + (size_t)mat * mat_stride + (size_t)(kblk * 64) * ldw + src;
        unsigned char* op = Wt + ((size_t)mat * npos + pos) * K + kblk * 64;
        f32x4 va[16], vb[16];
        conv8_load(va, wp, ldw); conv8_load(vb, wp + (size_t)16 * ldw, ldw);
        conv8_store(va, op, K, scale); conv8_load(va, wp + (size_t)32 * ldw, ldw);
        conv8_store(vb, op + 16, K, scale); conv8_load(vb, wp + (size_t)48 * ldw, ldw);
        conv8_store(va, op + 32, K, scale); conv8_store(vb, op + 48, K, scale); }
}
constexpr int NPH = 2 + 9 * DEPTH;
__host__ __device__ constexpr bool phase_empty(int k) { return k >= 2 && ((((k - 2) / 9) % 2 == 0 && (k - 2) % 9 == 3) || (((k - 2) / 9) % 2 == 1 && (k - 2) % 9 == 1)); }

__global__ void __launch_bounds__(NTHR, 2) fwd_kernel(Params p) {
    extern __shared__ __attribute__((aligned(16))) unsigned char lds_raw[];
    LAS unsigned char* lds = (LAS unsigned char*)lds_raw;
    const int G = gridDim.x, bx = blockIdx.x, vcu = (G % 8 == 0) ? (bx % 8) * (G / 8) + bx / 8 : bx;
    const int NGW = G * NWAVES;
    unsigned* const ctl = (unsigned*)(p.ws + WS_CTL);
    if (threadIdx.x < 32) ((LAS unsigned*)(lds + MISC_OFF))[threadIdx.x] = 0u;
    __syncthreads();
    XcdBarrier bar; bar.bar = ctl + CW_BAR; bar.x = 0; bar.st = nullptr;
    const int lo = p.ph_lo, hi = p.ph_hi;
    if (hi - lo > 1) bar = xcd_barrier_post(ctl + CW_BAR, (volatile LAS unsigned*)(lds + MISC_OFF));
#ifndef PHMASK
#define PHMASK 0xFFFFFFFFu
#endif
#define ON(id) (((PHMASK) >> (id)) & 1u)
#ifndef REPMASK
#define REPMASK 0u
#endif
#define DSH(id) ((size_t)((((REPMASK) >> (id)) & 1u) && rep_ == 0 ? 1600 : 0) * MiB)
#define REP(id) for (int rep_ = 0; rep_ < ((((REPMASK) >> (id)) & 1u) ? 2 : 1); ++rep_)
#define IN(k) (lo <= (k) && (k) < hi)
#define SEAM(k) do { if (hi > (k) + 1) xcd_barrier(bar); } while (0)

    if (ON(0) && IN(0)) { WSL(); {
        REP(16) {
            LAS float* cact = (LAS float*)lds; LAS float* part = (LAS float*)(lds + 32768);
            for (int i = 0; i < 16; ++i) { const int idx = tid + 512 * i, b = idx >> 10, k = idx & 1023; const float cv = kp->c[idx]; cact[k * 8 + b] = cv / (1.0f + __expf(-cv)); }
            __syncthreads();
            for (int u = bx; u < 4 * 96; u += G) { const int layer = u / 96, n0 = (u % 96) * 64;
                float a0 = 0, a1 = 0, a2 = 0, a3 = 0, a4 = 0, a5 = 0, a6 = 0, a7 = 0;
                const float* wp = kp->w_mod + ((size_t)layer * 1024 + wave * 128) * 6144 + n0 + lane;
#pragma unroll 4
                for (int kk = 0; kk < 128; ++kk) { const float w = wp[(size_t)kk * 6144]; const LAS f32x4* cp = (const LAS f32x4*)(cact + (wave * 128 + kk) * 8); const f32x4 ca = cp[0], cb = cp[1];
                    a0 += ca[0] * w; a1 += ca[1] * w; a2 += ca[2] * w; a3 += ca[3] * w; a4 += cb[0] * w; a5 += cb[1] * w; a6 += cb[2] * w; a7 += cb[3] * w; }
                LAS float* pp = part + wave * 512 + lane;
                pp[0] = a0; pp[64] = a1; pp[128] = a2; pp[192] = a3; pp[256] = a4; pp[320] = a5; pp[384] = a6; pp[448] = a7;
                __syncthreads();
                { const int b = tid >> 6; float s = kp->b_mod[(size_t)layer * 6144 + n0 + lane];
#pragma unroll
                  for (int w = 0; w < 8; ++w) s += part[w * 512 + b * 64 + lane];
                  MOD[((size_t)layer * 8 + b) * 6144 + n0 + lane] = s; }
                __syncthreads(); }
        }
        REP(17) for (int idx = bx * NTHR + tid; idx < T * 32; idx += G * NTHR) { const int t = idx >> 5, i = idx & 31;
            const float inv = powf(10000.0f, -(float)i * (1.0f / 32.0f)); const float ang = (float)kp->positions[t] * inv;
            COS[idx] = cosf(ang); SIN[idx] = sinf(ang); }
        __syncthreads();
        LAS float* scr = (LAS float*)(lds + wave * 8448);
        REP(19) conv_group(kp->w_router, (size_t)1024 * 32, 32, 1024, 32, WROUT, nullptr, 0, 4, MapIdent(), scr, gw, NGW, lane, 0);
        REP(19) conv2_group(kp->w_in_ab, (size_t)1024 * 1984, 1984, 1024, 2048, WINAB, nullptr, 0, 2, MapInAB(), gw, NGW, lane, 64);
        REP(19) conv2_group(kp->mla_w_qb, (size_t)384 * 1536, 1536, 384, 1536, WQB, kp->mla_g_q, 384, 2, MapQB(), gw, NGW, lane, 320);
        REP(19) conv2_group(kp->mla_w_kvb, (size_t)256 * 2048, 2048, 256, 2048, WKVB, kp->mla_g_kv, 256, 2, MapIdent(), gw, NGW, lane, 392);
        REP(19) conv2_group(kp->w_out_ab, (size_t)2048 * 1024, 1024, 2048, 1024, WOUTAB, nullptr, 0, 2, MapIdent(), gw, NGW, lane, 456);
        REP(19) conv2_group(kp->w_in_c, (size_t)1024 * 9216, 9216, 1024, 9216, WINC, nullptr, 0, 2, MapInC(), gw, NGW, lane, 712);
        REP(19) conv2_group(kp->w_out_c, (size_t)1024 * 1024, 1024, 1024, 1024, WOUTC, nullptr, 0, 2, MapIdent(), gw, NGW, lane, 1864);
        REP(18) conv8_group(kp->w_gu, (size_t)1024 * 2048, 2048, 1024, 2048, (unsigned char*)WGU, 32.0f, 128, MapGU(), gw, NGW, lane);
        REP(18) conv8_group(kp->w_down, (size_t)1024 * 1024, 1024, 1024, 1024, (unsigned char*)WDOWN, 32.0f, 128, MapIdent(), gw, NGW, lane);
        __syncthreads(); }
        SEAM(0);
    }
    if (ON(1) && IN(1)) { WSL();
        REP(1) for (int t = gw; t < T; t += NGW) { const int b = t >> 12; f32x4 v[4];
#pragma unroll
            for (int j = 0; j < 4; ++j) { v[j] = *(const f32x4*)(kp->x + (size_t)t * 1024 + 4 * lane + 256 * j); *(f32x4*)(X + (size_t)t * 1024 + 4 * lane + 256 * j) = v[j]; }
            norm_row_store(v, kp->g_norm_mix, MOD + (size_t)b * 6144, MOD + (size_t)b * 6144 + 1024, H + (size_t)t * 1024, lane); }
        SEAM(1);
    }

    for (int layer = 0; layer < DEPTH; ++layer) {
        const int pb = 2 + 9 * layer, li = layer >> 1; const bool even = (layer & 1) == 0;
        if (IN(pb + 0)) { WSL();
            if (ON(2) && even) REP(2) { g8::DenseSched S; S.init(H, WINAB + (size_t)li * 2048 * 1024, 1024, T, 2048, G, bxl);
                EpiInAB E{QB, KB, VB, KR, CQ, CKV, SSQ, COS, SIN};
                g8::gemm_phase<EpiInAB, g8::DenseSched, true>(lds, 1024, S, E); }
            else if (ON(3) && !even) REP(3) { g8::DenseSched S; S.init(H, WINC + (size_t)li * 9216 * 1024, 1024, T, 9216, G, bxl);
                EpiInC E{PC, COS, SIN};
                g8::gemm_phase<EpiInC, g8::DenseSched, true>(lds, 1024, S, E); }
            SEAM(pb + 0);
        }
        if (ON(4) && IN(pb + 1) && even) { WSL();
            if (ON(14)) REP(4) { g8::DenseSched S; S.init(CQ, WQB + (size_t)li * 1536 * 384, 384, T, 1536, G, bxl); EpiQUp E{QA, SSQ, COS, SIN};
              g8::gemm_phase<EpiQUp, g8::DenseSched, true>(lds, 384, S, E); }
            if (ON(15)) REP(4) { g8::DenseSched S; S.init(CKV, WKVB + (size_t)li * 2048 * 256, 256, T, 2048, G, bxl); EpiKVUp E{KV, SSQ};
              g8::gemm_phase<EpiKVUp, g8::DenseSched, true>(lds, 256, S, E); }
            SEAM(pb + 1);
        }
        if (IN(pb + 2)) { WSL();
            if (even) {
                if (ON(5)) REP(5) for (int i = 0;; ++i) { const int u = i * G + vcl; if (u >= NBATCH * 8 * 16) break; const int qb = u & 15, h = (u >> 4) & 7, b = u >> 7;
                    const size_t r0 = (size_t)b * SEQ;
                    att::dense_unit(QA + (r0 + qb * 256) * 1536 + h * 192, KV + r0 * 2048 + h * 256, KV + r0 * 2048 + h * 256 + 128, KR + r0 * 64, OB + (r0 + qb * 256) * 2048 + h * 128, SEQ, (char*)lds_raw); }
                if (ON(6)) REP(6) {
                    int tid = threadIdx.x; asm volatile("" : "+v"(tid));
                    att::B2Stage st = {}; const int lane_ = tid & 63, wv = tid >> 6; float* al_l = (float*)((char*)lds_raw + att::B2_K + att::B2_V) + wv * 64;
                    int u = vcl; bool have = u < NBATCH * 2 * 32;
#define SWA_GEO(uu, b_, kvh_, q0_, kb_, nr_) const int b_ = (uu) >> 6, kvh_ = ((uu) >> 5) & 1, q0_ = ((uu) & 31) * 128, kb_ = q0_ - 128 > 0 ? q0_ - 128 : 0, nr_ = (q0_ + 256 < SEQ ? q0_ + 256 : SEQ) - kb_
                    if (have) { SWA_GEO(u, b, kvh, q0, kb, nr); (void)q0; att::b2_load(st, KB + (size_t)b * SEQ * 128 + kvh * 64, VB + (size_t)b * SEQ * 128 + kvh * 64, 128, kb, nr, tid); }
                    while (have) { SWA_GEO(u, b, kvh, q0, kb, nr);
                        __syncthreads(); att::b2_write(st, (char*)lds_raw, nr, tid);
                        const int un = u + G; const bool hn = un < NBATCH * 2 * 32;
                        if (hn) { SWA_GEO(un, b2, kvh2, q02, kb2, nr2); (void)q02; att::b2_load(st, KB + (size_t)b2 * SEQ * 128 + kvh2 * 64, VB + (size_t)b2 * SEQ * 128 + kvh2 * 64, 128, kb2, nr2, tid); }
                        __syncthreads();
                        const int hq = kvh * 8 + wv; const size_t r0 = (size_t)b * SEQ; const float sinkv = kp->swa_sink[li * 16 + hq];
                        for (int j = 0; j < 4; ++j) { const int qw = q0 + 32 * j; bf16x8 qr[4];
                            const bf16_t* Qw = QB + (r0 + qw + (lane_ & 31)) * 1024 + hq * 64 + (lane_ >> 5) * 8;
#pragma unroll
                            for (int d0 = 0; d0 < 4; ++d0) qr[d0] = *reinterpret_cast<const bf16x8*>(Qw + d0 * 16);
                            att::b2_task<true, false>(qr, OB + (r0 + qw) * 2048 + 1024 + hq * 64, 2048, nullptr, 0, sinkv, qw, kb, SEQ, 128, (const char*)lds_raw, al_l, lane_); }
                        u = un; have = hn; }
#undef SWA_GEO
                }
            } else {
                if (ON(7)) REP(7) {
                    att::B2Stage st = {}; const int lane_ = tid & 63, wv = tid >> 6; float* al_l = (float*)((char*)lds_raw + att::B2_K + att::B2_V) + wv * 64;
                    int u = vcl; bool have = u < 3 * 2048; bf16x8 qn[4] = {};
#define DIL_QLOAD(dst, g_, head_, dil_, q0_, s0_) do { const bf16_t* Qw_ = PC + (s0_ + (size_t)dil_ * (q0_ + 32 * wv + (lane_ & 31))) * 9216 + (g_ * 3 + 0) * 1024 + head_ * 64 + (lane_ >> 5) * 8; \
        _Pragma("unroll") for (int d0 = 0; d0 < 4; ++d0) dst[d0] = *reinterpret_cast<const bf16x8*>(Qw_ + d0 * 16); } while (0)
#define DIL_GEO(uu, g_, head_, dil_, L_, q0_, s0_, kb_, nr_) const int g_ = (uu) >> 11, rem_##g_ = (uu) & 2047, head_ = rem_##g_ & 15, rest_##g_ = rem_##g_ >> 4, dil_ = g_ == 0 ? 1 : (g_ == 1 ? 4 : 16), L_ = SEQ / dil_, nqb_##g_ = L_ / 256, \
        q0_ = (rest_##g_ % nqb_##g_) * 256, seqi_##g_ = rest_##g_ / nqb_##g_; const size_t s0_ = (size_t)(seqi_##g_ / dil_) * SEQ + (seqi_##g_ % dil_); const int kb_ = q0_ - 64 > 0 ? q0_ - 64 : 0, nr_ = (q0_ + 320 < L_ ? q0_ + 320 : L_) - kb_
                    if (have) { DIL_GEO(u, g, head, dil, L, q0, s0, kb, nr); DIL_QLOAD(qn, g, head, dil, q0, s0); att::b2_load(st, PC + s0 * 9216 + (g * 3 + 1) * 1024 + head * 64, PC + s0 * 9216 + (g * 3 + 2) * 1024 + head * 64, (long)dil * 9216, kb, nr, tid); }
                    while (have) { DIL_GEO(u, g, head, dil, L, q0, s0, kb, nr);
                        __syncthreads(); att::b2_write(st, (char*)lds_raw, nr, tid);
                        bf16x8 qr[4];
#pragma unroll
                        for (int d0 = 0; d0 < 4; ++d0) qr[d0] = qn[d0];
                        const int un = u + G; const bool hn = un < 3 * 2048;
                        if (hn) { DIL_GEO(un, g2, head2, dil2, L2, q02, s02, kb2, nr2); DIL_QLOAD(qn, g2, head2, dil2, q02, s02); att::b2_load(st, PC + s02 * 9216 + (g2 * 3 + 1) * 1024 + head2 * 64, PC + s02 * 9216 + (g2 * 3 + 2) * 1024 + head2 * 64, (long)dil2 * 9216, kb2, nr2, tid); }
                        __syncthreads();
                        { const int qw = q0 + 32 * wv; const size_t qrow = s0 + (size_t)dil * qw;
                          att::b2_task<false, true>(qr, OG + (qrow * 3 + g) * 1024 + head * 64, (long)dil * 3072, LSE + (qrow * 3 + g) * 16 + head, (long)dil * 48, 0.f, qw, kb, L, 64, (const char*)lds_raw, al_l, lane_); }
                        u = un; have = hn; }
#undef DIL_QLOAD
#undef DIL_GEO
                }
            }
            SEAM(pb + 2);
        }
        if (ON(8) && IN(pb + 3) && !even) { WSL();
            REP(8) for (int t = gw; t < T; t += NGW) {
#pragma unroll
                for (int j = 0; j < 4; ++j) { const int c = 4 * lane + 256 * j, head = c >> 6;
                    const float l0 = LSE[((size_t)t * 3 + 0) * 16 + head], l1 = LSE[((size_t)t * 3 + 1) * 16 + head], l2 = LSE[((size_t)t * 3 + 2) * 16 + head];
                    const float m = fmaxf(l0, fmaxf(l1, l2)); float w0 = __expf(l0 - m), w1 = __expf(l1 - m), w2 = __expf(l2 - m); const float inv = 1.0f / (w0 + w1 + w2); w0 *= inv; w1 *= inv; w2 *= inv;
                    const u32x2 a = *(const u32x2*)(OG + ((size_t)t * 3 + 0) * 1024 + c), bq = *(const u32x2*)(OG + ((size_t)t * 3 + 1) * 1024 + c), cq = *(const u32x2*)(OG + ((size_t)t * 3 + 2) * 1024 + c);
                    u32x2 o; o.x = cvt_pk_bf16(w0 * bf_lo(a.x) + w1 * bf_lo(bq.x) + w2 * bf_lo(cq.x), w0 * bf_hi(a.x) + w1 * bf_hi(bq.x) + w2 * bf_hi(cq.x));
                    o.y = cvt_pk_bf16(w0 * bf_lo(a.y) + w1 * bf_lo(bq.y) + w2 * bf_lo(cq.y), w0 * bf_hi(a.y) + w1 * bf_hi(bq.y) + w2 * bf_hi(cq.y));
                    *(u32x2*)(OC + (size_t)t * 1024 + c) = o; } }
            SEAM(pb + 3);
        }
        if (ON(9) && IN(pb + 4)) { WSL();
            g8::DenseSched S;
            if (even) S.init(OB, WOUTAB + (size_t)li * 1024 * 2048, 2048, T, 1024, G, bxl); else S.init(OC, WOUTC + (size_t)li * 1024 * 1024, 1024, T, 1024, G, bxl);
            REP(9) { EpiResid E{(float*)((char*)X + DSH(9)), MOD + (size_t)layer * 8 * 6144 + 2048};
            g8::gemm_phase<EpiResid, g8::DenseSched, true>(lds, even ? 2048 : 1024, S, E); }
            SEAM(pb + 4);
        }
        if (ON(10) && IN(pb + 5)) { WSL();
            LAS bf16_t* HT = (LAS bf16_t*)lds; LAS float* PART = (LAS float*)(lds + 66048); LAS float* LOG = (LAS float*)(lds + 98816);
            LAS int* LCNT = (LAS int*)(lds + 103040); LAS int* LBASE = (LAS int*)(lds + 103168); LAS int* SELE = (LAS int*)(lds + 103296); LAS int* SELR = (LAS int*)(lds + 103808); LAS float* SELG = (LAS float*)(lds + 104320);
            const float* gn = kp->g_norm_ffn + (size_t)layer * 1024;
            const int r32 = lane & 31, hi2 = lane >> 5;
            REP(10) { unsigned* gcnt = (unsigned*)(wsl + WS_CTL) + CW_CNT + layer * 32 + (DSH(10) ? 4096 : 0); const size_t dsh = DSH(10);
            if (tid < 32) LCNT[tid] = 0;
            __syncthreads();
            for (int u = bxl; u < T / 32; u += G) { const int t0 = u * 32, b = t0 >> 12; const float* sh = MOD + ((size_t)layer * 8 + b) * 6144 + 3072; const float* sc = sh + 1024;
                for (int q = 0; q < 4; ++q) { const int tl = wave * 4 + q, t = t0 + tl; f32x4 v[4]; float ss = 0.f;
#pragma unroll
                    for (int j = 0; j < 4; ++j) { v[j] = *(const f32x4*)(X + (size_t)t * 1024 + 4 * lane + 256 * j); ss += (v[j][0] * v[j][0] + v[j][1] * v[j][1]) + (v[j][2] * v[j][2] + v[j][3] * v[j][3]); }
                    const float rstd = 1.0f / sqrtf(wave_sum(ss) * (1.0f / 1024.0f) + EPS);
#pragma unroll
                    for (int j = 0; j < 4; ++j) { const int c = 4 * lane + 256 * j; const f32x4 gv = *(const f32x4*)(gn + c), shv = *(const f32x4*)(sh + c), scv = *(const f32x4*)(sc + c);
                        const f32x4 y = v[j] * rstd * gv * (scv + 1.0f) + shv; u32x2 w; w.x = cvt_pk_bf16(y[0], y[1]); w.y = cvt_pk_bf16(y[2], y[3]);
                        *(unsigned*)((char*)(H8 + (size_t)t * 1024 + c) + dsh) = (unsigned)__builtin_amdgcn_cvt_pk_fp8_f32(y[2], y[3], __builtin_amdgcn_cvt_pk_fp8_f32(y[0], y[1], 0, false), true); *(LAS u32x2*)(HT + tl * 1032 + c) = w; } }
                __syncthreads();
                { f32x16 acc = {};
#pragma unroll
                  for (int s = 0; s < 8; ++s) { const int kk = wave * 128 + s * 16 + hi2 * 8; const bf16x8 a = *(const LAS bf16x8*)(HT + r32 * 1032 + kk);
                      const bf16x8 bb = *(const bf16x8*)(WROUT + ((size_t)layer * 32 + r32) * 1024 + kk); acc = __builtin_amdgcn_mfma_f32_32x32x16_bf16(a, bb, acc, 0, 0, 0); }
#pragma unroll
                  for (int r = 0; r < 16; ++r) PART[wave * 1024 + att::crow(r, hi2) * 32 + r32] = acc[r]; }
                __syncthreads();
#pragma unroll
                for (int i = 0; i < 2; ++i) { const int idx = tid + 512 * i; float s = kp->b_router[layer * 32 + (idx & 31)];
#pragma unroll
                    for (int w = 0; w < 8; ++w) s += PART[w * 1024 + idx];
                    LOG[(idx >> 5) * 33 + (idx & 31)] = s; }
                __syncthreads();
                if (tid < 32) { unsigned mask = 0u; float tv[4]; int te[4];
#pragma unroll
                    for (int k = 0; k < 4; ++k) { float best = -__builtin_inff(); int bi = 0;
                        for (int e = 0; e < 32; ++e) { const float v = LOG[tid * 33 + e]; const bool take = (v > best) && !((mask >> e) & 1u); best = take ? v : best; bi = take ? e : bi; }
                        mask |= 1u << bi; tv[k] = best; te[k] = bi; }
                    const float e0 = 1.0f, e1 = __expf(tv[1] - tv[0]), e2 = __expf(tv[2] - tv[0]), e3 = __expf(tv[3] - tv[0]); const float inv = 1.0f / (e0 + e1 + e2 + e3);
                    const float gk[4] = {e0 * inv, e1 * inv, e2 * inv, e3 * inv};
#pragma unroll
                    for (int k = 0; k < 4; ++k) { SELE[tid * 4 + k] = te[k]; SELG[tid * 4 + k] = gk[k]; SELR[tid * 4 + k] = __hip_atomic_fetch_add(LCNT + te[k], 1, __ATOMIC_RELAXED, __HIP_MEMORY_SCOPE_WORKGROUP); } }
                __syncthreads();
                if (tid < 32) { const int c = LCNT[tid]; LBASE[tid] = c ? (int)__hip_atomic_fetch_add(gcnt + tid, (unsigned)c, __ATOMIC_RELAXED, __HIP_MEMORY_SCOPE_AGENT) : 0; }
                __syncthreads();
                if (tid < 128) { const int e = SELE[tid], slot = LBASE[e] + SELR[tid], t = t0 + (tid >> 2);
                    if (slot < T) *(int*)((char*)(LIST + (size_t)e * T + slot) + dsh) = t; *(int*)((char*)(TOKE + (size_t)t * 4 + (tid & 3)) + dsh) = e | (slot << 8); *(float*)((char*)(GATE + (size_t)t * 4 + (tid & 3)) + dsh) = SELG[tid]; }
                __syncthreads();
                if (tid < 32) LCNT[tid] = 0;
            }
            __syncthreads(); }
            SEAM(pb + 5);
        }
        if (ON(11) && IN(pb + 6)) { WSL();
            build_moe_tables(lds, (unsigned*)(wsl + WS_CTL) + CW_CNT + layer * 32);
            const int ntiles = ((const LAS int*)(lds + TAB_NT))[0];
            MoeSchedUp S{(const char*)H8, (const char*)WGU + (size_t)layer * 32 * 2048 * 1024, LIST, (const LAS int*)(lds + TAB_TINFO), (const LAS int*)(lds + TAB_ECNT), ntiles * 8, G, vcl};
            EpiSwiGLU E{ACT, kp->b_gu + (size_t)layer * 32 * 2048};
            REP(11) g8::gemm_phase<EpiSwiGLU, MoeSchedUp, true, true>(lds, 512, S, E);
            SEAM(pb + 6);
        }
        if (ON(12) && IN(pb + 7)) { WSL();
            build_moe_tables(lds, (unsigned*)(wsl + WS_CTL) + CW_CNT + layer * 32);
            const int ntiles = ((const LAS int*)(lds + TAB_NT))[0];
            MoeSchedDown S{(const char*)ACT, (const char*)WDOWN + (size_t)layer * 32 * 1024 * 1024, (const LAS int*)(lds + TAB_TINFO), ntiles * 4, G, vcl};
            EpiDown E{YB, kp->b_down + (size_t)layer * 32 * 1024};
            if ((REPMASK >> 20) & 1u) { EpiNull EN; g8::gemm_phase<EpiNull, MoeSchedDown, true, true>(lds, 512, S, EN); }
            REP(12) g8::gemm_phase<EpiDown, MoeSchedDown, true, true>(lds, 512, S, E);
            SEAM(pb + 7);
        }
        if (ON(13) && IN(pb + 8)) { WSL();
            build_moe_tables(lds, (unsigned*)(wsl + WS_CTL) + CW_CNT + layer * 32);
            const LAS int* tstart = (const LAS int*)(lds + TAB_TSTART);
            REP(13) for (int t0 = gw; t0 < T; t0 += 2 * NGW) { const size_t dsh = DSH(13);
                f32x4 a[2][4]; int tt[2];
#pragma unroll
                for (int q = 0; q < 2; ++q) { const int t = (t0 + q * NGW < T) ? t0 + q * NGW : t0; tt[q] = t;
#pragma unroll
                    for (int j = 0; j < 4; ++j) a[q][j] = (f32x4){0.f, 0.f, 0.f, 0.f};
                    const i32x4v info4 = *(const i32x4v*)(TOKE + (size_t)t * 4); const f32x4 gk4 = *(const f32x4*)(GATE + (size_t)t * 4);
#pragma unroll
                    for (int k = 0; k < 4; ++k) { const int info = info4[k]; const float gk = gk4[k]; const size_t row = (size_t)tstart[info & 31] * 256 + (info >> 8);
#pragma unroll
                        for (int j = 0; j < 4; ++j) { const u32x2 y = *(const u32x2*)(YB + row * 1024 + 4 * lane + 256 * j); a[q][j][0] += gk * bf_lo(y.x); a[q][j][1] += gk * bf_hi(y.x); a[q][j][2] += gk * bf_lo(y.y); a[q][j][3] += gk * bf_hi(y.y); } } }
#pragma unroll
                for (int q = 0; q < 2; ++q) { const int t = tt[q], b = t >> 12; const float* g2 = MOD + ((size_t)layer * 8 + b) * 6144 + 5120;
                    if (q == 1 && t0 + NGW >= T) break;
                    f32x4 v[4];
#pragma unroll
                    for (int j = 0; j < 4; ++j) { const int c = 4 * lane + 256 * j; v[j] = *(const f32x4*)(X + (size_t)t * 1024 + c) + *(const f32x4*)(g2 + c) * a[q][j]; }
                    if (layer + 1 < DEPTH) {
#pragma unroll
                        for (int j = 0; j < 4; ++j) *(f32x4*)((char*)(X + (size_t)t * 1024 + 4 * lane + 256 * j) + dsh) = v[j];
                        norm_row_store(v, kp->g_norm_mix + (size_t)(layer + 1) * 1024, MOD + ((size_t)(layer + 1) * 8 + b) * 6144, MOD + ((size_t)(layer + 1) * 8 + b) * 6144 + 1024, (bf16_t*)((char*)(H + (size_t)t * 1024) + dsh), lane);
                    } else { float ss = 0.f;
#pragma unroll
                        for (int j = 0; j < 4; ++j) ss += (v[j][0] * v[j][0] + v[j][1] * v[j][1]) + (v[j][2] * v[j][2] + v[j][3] * v[j][3]);
                        const float rstd = 1.0f / sqrtf(wave_sum(ss) * (1.0f / 1024.0f) + EPS);
#pragma unroll
                        for (int j = 0; j < 4; ++j) { const int c = 4 * lane + 256 * j; *(f32x4*)(dsh ? (float*)((char*)(X + (size_t)t * 1024 + c) + dsh) : kp->out + (size_t)t * 1024 + c) = v[j] * rstd * *(const f32x4*)(kp->g_final + c); } } } }
            SEAM(pb + 8);
        }
    }
#undef IN
#undef SEAM
}

extern "C" void kernel_launch(void* const* d_in, const int* in_sizes, int n_in, void* d_out, int out_size, void* d_ws, size_t ws_size, hipStream_t stream) {
    static int grid = 0;
    if (grid == 0) {
        if (n_in != 23 || out_size != T * D || ws_size < WS_END) { fprintf(stderr, "kernel_launch: unexpected shapes n_in %d out %d ws %zu (need %zu)\n", n_in, out_size, ws_size, (size_t)WS_END); grid = -1; return; }
        int dev = 0, cus = 0, per_cu = 0;
        if (hipGetDevice(&dev) != hipSuccess || hipDeviceGetAttribute(&cus, hipDeviceAttributeMultiprocessorCount, dev) != hipSuccess) { grid = -1; return; }
        if (hipFuncSetAttribute((const void*)fwd_kernel, hipFuncAttributeMaxDynamicSharedMemorySize, LDS_BYTES) != hipSuccess) { fprintf(stderr, "kernel_launch: hipFuncSetAttribute failed\n"); grid = -1; return; }
        if (hipOccupancyMaxActiveBlocksPerMultiprocessor(&per_cu, (const void*)fwd_kernel, NTHR, LDS_BYTES) != hipSuccess || per_cu < 1) { fprintf(stderr, "kernel_launch: occupancy query says %d\n", per_cu); (void)hipGetLastError(); grid = -1; return; }
        grid = cus;
    }
    if (grid < 0) return;
    (void)hipMemsetAsync((char*)d_ws + WS_CTL, 0, CTL_ZERO_BYTES, stream);
    Params p{};
    p.x = (const float*)d_in[0]; p.c = (const float*)d_in[1]; p.positions = (const int*)d_in[2]; p.w_mod = (const float*)d_in[3]; p.b_mod = (const float*)d_in[4];
    p.g_norm_mix = (const float*)d_in[5]; p.g_norm_ffn = (const float*)d_in[6]; p.w_in_ab = (const float*)d_in[7]; p.mla_g_q = (const float*)d_in[8]; p.mla_w_qb = (const float*)d_in[9];
    p.mla_g_kv = (const float*)d_in[10]; p.mla_w_kvb = (const float*)d_in[11]; p.swa_sink = (const float*)d_in[12]; p.w_out_ab = (const float*)d_in[13]; p.w_in_c = (const float*)d_in[14];
    p.w_out_c = (const float*)d_in[15]; p.w_router = (const float*)d_in[16]; p.b_router = (const float*)d_in[17]; p.w_gu = (const float*)d_in[18]; p.b_gu = (const float*)d_in[19];
    p.w_down = (const float*)d_in[20]; p.b_down = (const float*)d_in[21]; p.g_final = (const float*)d_in[22];
    p.out = (float*)d_out; p.ws = (unsigned char*)d_ws;
#if MK_MULTI
    for (int k = 0; k < NPH; ++k) { if (phase_empty(k)) continue; p.ph_lo = k; p.ph_hi = k + 1;
        hipLaunchKernelGGL(fwd_kernel, dim3(grid), dim3(NTHR), LDS_BYTES, stream, p); }
#else
    p.ph_lo = 0; p.ph_hi = NPH;
    hipLaunchKernelGGL(fwd_kernel, dim3(grid), dim3(NTHR), LDS_BYTES, stream, p);
#endif
    const hipError_t le = hipPeekAtLastError();
    if (le != hipSuccess) fprintf(stderr, "kernel_launch: launch failed: %s\n", hipGetErrorName(le));
}
```

```cpp
#include <hip/hip_runtime.h>
#include <cstdio>
#include <cstdint>

#ifndef MK_MULTI
#define MK_MULTI 0
#endif

#define GAS __attribute__((address_space(1)))
#define LAS __attribute__((address_space(3)))
typedef unsigned short bf16_t;
typedef short bf16x8 __attribute__((ext_vector_type(8)));
typedef short s16x4 __attribute__((ext_vector_type(4)));
typedef float f32x2 __attribute__((ext_vector_type(2)));
typedef float f32x4 __attribute__((ext_vector_type(4)));
typedef float f32x16 __attribute__((ext_vector_type(16)));
typedef unsigned u32x2 __attribute__((ext_vector_type(2)));
typedef unsigned u32x4 __attribute__((ext_vector_type(4)));
typedef int i32x4v __attribute__((ext_vector_type(4)));

constexpr int T = 32768, D = 1024, NBATCH = 8, SEQ = 4096, DEPTH = 4, NE = 32, TOPK = 4;
constexpr float EPS = 1e-6f;
constexpr int AB_IN = 1984, AB_MIX = 2048, C_IN = 9216;
constexpr int NWAVES = 8, NTHR = 512;

constexpr size_t MiB = 1u << 20;
constexpr size_t WS_CTL = 0, CTL_ZERO_BYTES = 1 * MiB;
constexpr size_t WS_MOD = 1 * MiB;
constexpr size_t WS_COS = 2 * MiB, WS_SIN = 6 * MiB;
constexpr size_t WS_WROUT = 10 * MiB;
constexpr size_t WS_WINAB = 11 * MiB;
constexpr size_t WS_WQB = 19 * MiB;
constexpr size_t WS_WKVB = 22 * MiB;
constexpr size_t WS_WOUTAB = 24 * MiB;
constexpr size_t WS_WINC = 32 * MiB;
constexpr size_t WS_WOUTC = 68 * MiB;
constexpr size_t WS_WGU = 72 * MiB;
constexpr size_t WS_WDOWN = 584 * MiB;
constexpr size_t WS_X = 840 * MiB;
constexpr size_t WS_H = 968 * MiB;
constexpr size_t WS_A0 = 1032 * MiB;
constexpr size_t WS_QB = WS_A0;
constexpr size_t WS_KB = WS_A0 + 64 * MiB;
constexpr size_t WS_VB = WS_A0 + 72 * MiB;
constexpr size_t WS_KR = WS_A0 + 80 * MiB;
constexpr size_t WS_CQ = WS_A0 + 84 * MiB;
constexpr size_t WS_CKV = WS_A0 + 108 * MiB;
constexpr size_t WS_SSQ = WS_A0 + 124 * MiB;
constexpr size_t WS_QA = WS_A0 + 126 * MiB;
constexpr size_t WS_KV = WS_A0 + 222 * MiB;
constexpr size_t WS_O = WS_A0 + 350 * MiB;
constexpr size_t WS_PC = WS_A0;
constexpr size_t WS_OG = WS_A0 + 576 * MiB;
constexpr size_t WS_LSE = WS_A0 + 768 * MiB;
constexpr size_t WS_OC = WS_A0 + 774 * MiB;
constexpr size_t WS_MOE = WS_A0 + 840 * MiB;
constexpr size_t WS_LIST = WS_MOE;
constexpr size_t WS_TOKE = WS_MOE + 4 * MiB;
constexpr size_t WS_GATE = WS_MOE + 5 * MiB;
constexpr int ACT_ROWS = T * TOPK + NE * 256;
constexpr size_t WS_ACT = WS_MOE + 6 * MiB;
constexpr size_t WS_H8 = WS_ACT + 136 * MiB;
constexpr size_t WS_YB = WS_ACT + 272 * MiB;
constexpr size_t WS_END = WS_YB + 272 * MiB;

constexpr int CW_BAR = 4096;
constexpr int CW_CNT = 8192;

constexpr int RING_BYTES = 131072;
constexpr int TAB_OFF = RING_BYTES;
constexpr int TAB_TINFO = TAB_OFF, TAB_ECNT = TAB_OFF + 576 * 4, TAB_TSTART = TAB_ECNT + 32 * 4, TAB_NT = TAB_TSTART + 36 * 4;
constexpr int MISC_OFF = TAB_OFF + 4096;
constexpr int LTOK_OFF = MISC_OFF + 256;
constexpr int LDS_BYTES = 163840;
static_assert(LTOK_OFF + 24 * 1024 <= LDS_BYTES, "lds map");
static_assert(TAB_NT + 16 <= MISC_OFF && MISC_OFF + 128 <= LDS_BYTES, "lds map");

#define LDS_WAIT() asm volatile("s_waitcnt lgkmcnt(0)" ::: "memory")
#define VM_WAIT() asm volatile("s_waitcnt vmcnt(0)" ::: "memory")
#define SBAR() __builtin_amdgcn_sched_barrier(0)

__device__ __forceinline__ unsigned cvt_pk_bf16(float lo, float hi) { unsigned r; asm volatile("v_cvt_pk_bf16_f32 %0, %1, %2" : "=v"(r) : "v"(lo), "v"(hi)); return r; }
__device__ __forceinline__ float bf_lo(unsigned u) { return __uint_as_float(u << 16); }
__device__ __forceinline__ float bf_hi(unsigned u) { return __uint_as_float(u & 0xffff0000u); }
__device__ __forceinline__ float wave_sum(float v) {
#pragma unroll
    for (int o = 1; o < 64; o <<= 1) v += __shfl_xor(v, o);
    return v;
}

__device__ __forceinline__ int tid_now(int wave_s) { int l; asm volatile("v_mbcnt_lo_u32_b32 %0, -1, 0\n\tv_mbcnt_hi_u32_b32 %0, -1, %0" : "=&v"(l)); return (wave_s << 6) | l; }
#define XB_TMO      128
#define XB_XCNT(j)  (256  + 64 * (j))
#define XB_XSUB(j)  (1280 + 64 * (j))
#define XB_XGEN(j)  (2304 + 64 * (j))
#define XB_TOP      3328
#define XB_TOPGEN   3392
#define XCD_BAR_WORDS 3456
#define XB_SPIN_CAP (1u << 20)
__device__ __forceinline__ unsigned xb_ld(unsigned* p)              { return __hip_atomic_load(p, __ATOMIC_RELAXED, __HIP_MEMORY_SCOPE_AGENT); }
__device__ __forceinline__ unsigned xb_add(unsigned* p, unsigned v) { return __hip_atomic_fetch_add(p, v, __ATOMIC_RELAXED, __HIP_MEMORY_SCOPE_AGENT); }
__device__ __forceinline__ unsigned xb_xcc_id() { return (unsigned)__builtin_amdgcn_s_getreg((3 << 11) | 20) & 0xFu; }
#define XB_SPIN(cond, bar) do { unsigned _sp = 0; while (cond) { __builtin_amdgcn_s_sleep(1); \
    if ((++_sp & 255u) == 0u) { if (xb_ld(&(bar)[XB_TMO])) break; if (_sp > XB_SPIN_CAP) { atomicAdd(&(bar)[XB_TMO], 1u); break; } } } } while (0)
struct XcdBarrier { unsigned* bar; unsigned x; volatile LAS unsigned* st; };
__device__ __forceinline__ XcdBarrier xcd_barrier_post(unsigned* bar, volatile LAS unsigned* st) {
    XcdBarrier b; b.bar = bar; b.x = xb_xcc_id(); b.st = st;
    if (threadIdx.x == 0) (void)xb_add(&bar[XB_XCNT(b.x)], 1u);
    return b;
}
__device__ __forceinline__ void xcd_barrier_complete(unsigned* bar, unsigned x, unsigned& nloc, unsigned& nx) {
    const unsigned G = gridDim.x * gridDim.y * gridDim.z;
    unsigned sum, cnt, mine, sp = 0u;
    for (;;) {
        sum = 0u; cnt = 0u; mine = 0u;
#pragma unroll
        for (unsigned j = 0; j < 16; ++j) { const unsigned c = xb_ld(&bar[XB_XCNT(j)]); sum += c; cnt += (c > 0u) ? 1u : 0u; mine = (j == x) ? c : mine; }
        if (sum == G) break;
        __builtin_amdgcn_s_sleep(1);
        if ((++sp & 255u) == 0u) { if (xb_ld(&bar[XB_TMO])) break; if (sp > XB_SPIN_CAP) { atomicAdd(&bar[XB_TMO], 1u); break; } }
    }
    nloc = mine > 0u ? mine : 1u; nx = cnt > 0u ? cnt : 1u;
}
__device__ __forceinline__ void xcd_barrier(const XcdBarrier& b, const int wave_s_) {
    asm volatile("s_waitcnt vmcnt(0)" ::: "memory");
    __syncthreads();
    if (tid_now(wave_s_) == 0) {
        unsigned* bar = b.bar;
        __builtin_amdgcn_s_waitcnt(0);
        unsigned nloc = b.st[0], nx = b.st[1];
        if (nloc == 0u) { xcd_barrier_complete(bar, b.x, nloc, nx); b.st[0] = nloc; b.st[1] = nx; }
        const unsigned old = xb_add(&bar[XB_XSUB(b.x)], 1u);
        const unsigned gen = old / nloc;
        if (old + 1u == (gen + 1u) * nloc) {
            __builtin_amdgcn_fence(__ATOMIC_RELEASE, "agent");
            asm volatile("s_waitcnt vmcnt(0)" ::: "memory");
            const unsigned og = xb_add(&bar[XB_TOP], 1u);
            const unsigned tg = og / nx;
            if (og + 1u == (tg + 1u) * nx) xb_add(&bar[XB_TOPGEN], 1u);
            else XB_SPIN(xb_ld(&bar[XB_TOPGEN]) == tg, bar);
            __builtin_amdgcn_fence(__ATOMIC_ACQUIRE, "agent");
            xb_add(&bar[XB_XGEN(b.x)], 1u);
            asm volatile("s_waitcnt vmcnt(0)" ::: "memory");
        } else {
            XB_SPIN(xb_ld(&bar[XB_XGEN(b.x)]) == gen, bar);
            __builtin_amdgcn_fence(__ATOMIC_ACQUIRE, "agent");
            asm volatile("s_waitcnt vmcnt(0)" ::: "memory");
        }
    }
    __syncthreads();
}

struct Params {
    const float* x; const float* c; const int* positions; const float* w_mod; const float* b_mod; const float* g_norm_mix; const float* g_norm_ffn;
    const float* w_in_ab; const float* mla_g_q; const float* mla_w_qb; const float* mla_g_kv; const float* mla_w_kvb; const float* swa_sink; const float* w_out_ab;
    const float* w_in_c; const float* w_out_c; const float* w_router; const float* b_router; const float* w_gu; const float* b_gu; const float* w_down; const float* b_down; const float* g_final;
    float* out; unsigned char* ws;
    int ph_lo, ph_hi;
};

namespace g8 {
constexpr int BM = 256, BK = 64, HALF = 128, HTB = HALF * BK * 2, STAGE_BYTES = 8 * HTB, NXCD = 8, WGM = 8;
__device__ __forceinline__ int lds_byte(int r, int c) { const int st = (r >> 4) * 2 + (c >> 5), rr = r & 15, cc = c & 31, ob = rr * 64 + cc * 2; return st * 1024 + (ob ^ (((ob >> 9) & 1) << 5)); }
__device__ __forceinline__ void stage_rc(int b, int& R, int& C) { const int st = b / 1024, sb = b % 1024, swz = sb ^ (((sb >> 9) & 1) << 5); R = (st >> 1) * 16 + swz / 64; C = (st & 1) * 32 + (swz % 64) / 2; }
__device__ __forceinline__ int perm32(int rho) { const int n = rho >> 4, i = rho & 15; return 8 * (i >> 2) + 4 * n + (i & 3); }

struct Unit { int pm, pn, aux, ord; };
typedef int i32x4 __attribute__((ext_vector_type(4)));
typedef int i32x8 __attribute__((ext_vector_type(8)));
__device__ __forceinline__ bf16x8 lo8(i32x8 v) { return __builtin_bit_cast(bf16x8, __builtin_shufflevector(v, v, 0, 1, 2, 3)); }
__device__ __forceinline__ bf16x8 hi8(i32x8 v) { return __builtin_bit_cast(bf16x8, __builtin_shufflevector(v, v, 4, 5, 6, 7)); }
__device__ __forceinline__ i32x8 cat8(bf16x8 a, bf16x8 b) { const i32x4 x = __builtin_bit_cast(i32x4, a), y = __builtin_bit_cast(i32x4, b); return __builtin_shufflevector(x, y, 0, 1, 2, 3, 4, 5, 6, 7); }

struct DenseSched {
    const char* A; const char* Bt; int K; int nM, nN, nwg, G, c;
    __device__ __forceinline__ void init(const void* A_, const void* Bt_, int K_, int M, int N, int G_, int c_) { A = (const char*)A_; Bt = (const char*)Bt_; asm volatile("" : "+s"(A), "+s"(Bt));     K = K_; nM = M / BM; nN = N / BM; nwg = nM * nN; G = G_; c = c_; }
    __device__ __forceinline__ bool next(int i, Unit& u) const {
        const long L = (long)i * G + c; if (L >= nwg) return false;
        int wgid = (int)L; { const int q = nwg / NXCD, r = nwg % NXCD, xcd = wgid % NXCD, off = wgid / NXCD; wgid = (xcd < r ? xcd * (q + 1) : r * (q + 1) + (xcd - r) * q) + off; }
        const int nig = WGM * nN, gid = wgid / nig, fm = gid * WGM, gsz = (nM - fm) < WGM ? (nM - fm) : WGM;
        u.pm = fm + ((wgid % nig) % gsz); u.pn = (wgid % nig) / gsz; u.aux = 0; u.ord = i; return true;
    }
    static constexpr bool GATHER = false;
    __device__ __forceinline__ const char* a_base() const { return A; }
    __device__ __forceinline__ const char* a_tile(const Unit& u) const { return A + (size_t)u.pm * BM * K * 2; }
    __device__ __forceinline__ unsigned a_off(const Unit& u, int r) const { return 0u; }
    __device__ __forceinline__ const char* b_tile(const Unit& u) const { return Bt + (size_t)u.pn * BM * K * 2; }
};

template <class Epi, class Sched, bool ALIGN_EPI, bool FP8 = false>
__device__ __forceinline__ void gemm_phase(LAS unsigned char* lds, const int K, const Sched& S, const Epi& E, const int wave_s_, const int stagger = 0) {
    if (stagger > 0) { const unsigned long long t0_ = __builtin_amdgcn_s_memrealtime(); while (__builtin_amdgcn_s_memrealtime() - t0_ < (unsigned long long)stagger) __builtin_amdgcn_s_sleep(8); }
    const int tid = tid_now(wave_s_);
    const int wid = __builtin_amdgcn_readfirstlane(tid >> 6), lane = tid & 63, wr = wid >> 2, wc = wid & 3, fr = lane & 15, fq = lane >> 4;
    const int nt = K / BK;
    constexpr bool GATHER = Sched::GATHER;
    int Ra[2]; unsigned Ca2[2], voffB[2], voffA[2];
#pragma unroll
    for (int i = 0; i < 2; ++i) { int R, C; stage_rc(tid * 16 + i * 8192, R, C); const int Rb = (R & ~31) + perm32(R & 31);
        Ra[i] = R; Ca2[i] = (unsigned)C * 2u; voffB[i] = (unsigned)(Rb * K + C) * 2u; voffA[i] = (unsigned)(R * K + C) * 2u; }
    const size_t kstep = (size_t)(BK * 2);
    const size_t hstep = (size_t)HALF * K * 2;
    const unsigned ldsw = (unsigned)wid * 1024u;
    const int aoff = lds_byte(wr * 64 + fr, fq * 8), boff = lds_byte(wc * 32 + fr, fq * 8);
#define G8_SA(b, h) (((b) * 2 + (h)) * HTB)
#define G8_SB(b, h) ((4 + (b) * 2 + (h)) * HTB)
#define G8_STAGE(bufoff, gbase, voff) do { _Pragma("unroll") for (int _i = 0; _i < 2; ++_i) \
        __builtin_amdgcn_global_load_lds((const unsigned*)((const char*)(gbase) + (voff)[_i]), (LAS unsigned*)(lds + (bufoff) + ldsw + _i * 8192), 16, 0, 0); } while (0)
#define G8_LDA(dst, b, h) do { _Pragma("unroll") for (int m = 0; m < 4; ++m) dst[m] = cat8(*(const LAS bf16x8*)(lds + G8_SA(b, h) + aoff + m * 2048), *(const LAS bf16x8*)(lds + G8_SA(b, h) + aoff + m * 2048 + 1024)); } while (0)
#define G8_LDB(dst, b, h) do { _Pragma("unroll") for (int n = 0; n < 2; ++n) dst[n] = cat8(*(const LAS bf16x8*)(lds + G8_SB(b, h) + boff + n * 2048), *(const LAS bf16x8*)(lds + G8_SB(b, h) + boff + n * 2048 + 1024)); } while (0)
#define G8_MMA(ai, bj, At, Bt) do { __builtin_amdgcn_s_setprio(1); _Pragma("unroll") for (int m = 0; m < 4; ++m) _Pragma("unroll") for (int n = 0; n < 2; ++n) { \
        if constexpr (FP8) asm volatile("v_mfma_f32_16x16x128_f8f6f4 %0, %1, %2, %0" : "+v"(acc[ai][bj][m][n]) : "v"(Bt[n]), "v"(At[m]));     \
        else { acc[ai][bj][m][n] = __builtin_amdgcn_mfma_f32_16x16x32_bf16(lo8(Bt[n]), lo8(At[m]), acc[ai][bj][m][n], 0, 0, 0); acc[ai][bj][m][n] = __builtin_amdgcn_mfma_f32_16x16x32_bf16(hi8(Bt[n]), hi8(At[m]), acc[ai][bj][m][n], 0, 0, 0); } } __builtin_amdgcn_s_setprio(0); } while (0)
#define G8_WAIT_V(n) asm volatile("s_waitcnt vmcnt(" #n ")" ::: "memory")
#define G8_WAIT_L(n) asm volatile("s_waitcnt lgkmcnt(" #n ")" ::: "memory")
#define G8_BAR __builtin_amdgcn_s_barrier()
#define G8_SCHED __builtin_amdgcn_sched_barrier(0)
    Unit cur, nxt; int ui = 0;
    if (!S.next(0, cur)) return;
    f32x4 acc[2][2][4][2];
#pragma unroll
    for (int a = 0; a < 2; ++a)
#pragma unroll
        for (int b = 0; b < 2; ++b)
#pragma unroll
            for (int m = 0; m < 4; ++m)
#pragma unroll
                for (int n = 0; n < 2; ++n) acc[a][b][m][n] = (f32x4){0.f, 0.f, 0.f, 0.f};
    i32x8 At[4], B0[2], B1[2];
    const char* Ab = GATHER ? S.a_base() : S.a_tile(cur);
    unsigned cA0[2], cA1[2], nA0[2], nA1[2];
#pragma unroll
    for (int i = 0; i < 2; ++i) { if constexpr (GATHER) { cA0[i] = S.a_off(cur, Ra[i]) + Ca2[i]; cA1[i] = S.a_off(cur, HALF + Ra[i]) + Ca2[i]; } else { cA0[i] = voffA[i]; cA1[i] = voffA[i] + (unsigned)hstep; } }
    const char* cB = S.b_tile(cur);
    G8_STAGE(G8_SB(0, 0), cB, voffB); G8_STAGE(G8_SA(0, 0), Ab, cA0); G8_STAGE(G8_SB(0, 1), cB + hstep, voffB); G8_STAGE(G8_SA(0, 1), Ab, cA1);
    if (wr == 1) G8_BAR;
    G8_WAIT_V(4); G8_BAR;
    G8_STAGE(G8_SB(1, 0), cB + kstep, voffB); G8_STAGE(G8_SA(1, 0), Ab + kstep, cA0); G8_STAGE(G8_SB(1, 1), cB + hstep + kstep, voffB);
    G8_WAIT_V(6); G8_BAR;
    for (;;) {
        const bool has_next = S.next(ui + 1, nxt);
        const char* nB = cB; const char* nAb = Ab;
        if constexpr (GATHER) {
#pragma unroll
            for (int i = 0; i < 2; ++i) { nA0[i] = cA0[i]; nA1[i] = cA1[i]; } }
        if (has_next) { nB = S.b_tile(nxt);
            if constexpr (GATHER) {
#pragma unroll
                for (int i = 0; i < 2; ++i) { nA0[i] = S.a_off(nxt, Ra[i]) + Ca2[i]; nA1[i] = S.a_off(nxt, HALF + Ra[i]) + Ca2[i]; } }
            else nAb = S.a_tile(nxt); }
#pragma clang loop unroll(disable)
        for (int t = 0; t < nt; t += 2) {
            const bool last = (t == nt - 2);
            const char* a1 = Ab + (size_t)(t + 1) * kstep;
            const char* a2 = last ? nAb : Ab + (size_t)(t + 2) * kstep; const char* b2 = last ? nB : cB + (size_t)(t + 2) * kstep;
            const char* a3 = a2 + kstep; const char* b3 = b2 + kstep;
            unsigned o20[2], o21[2];
#pragma unroll
            for (int i = 0; i < 2; ++i) { if constexpr (GATHER) { o20[i] = last ? nA0[i] : cA0[i]; o21[i] = last ? nA1[i] : cA1[i]; } else { o20[i] = cA0[i]; o21[i] = cA1[i]; } }
            G8_LDB(B0, 0, 0); G8_SCHED; G8_LDA(At, 0, 0); G8_STAGE(G8_SA(1, 1), a1, cA1);
            G8_WAIT_L(8); G8_BAR; G8_WAIT_L(0); G8_MMA(0, 0, At, B0); G8_BAR; G8_SCHED;
            G8_LDB(B1, 0, 1); G8_STAGE(G8_SB(0, 0), b2, voffB);
            G8_BAR; G8_WAIT_L(0); G8_MMA(0, 1, At, B1); G8_BAR;
            G8_LDA(At, 0, 1); G8_STAGE(G8_SA(0, 0), a2, o20);
            G8_BAR; G8_WAIT_L(0); G8_MMA(1, 0, At, B0); G8_BAR; G8_SCHED;
            G8_STAGE(G8_SB(0, 1), b2 + hstep, voffB);
            G8_WAIT_V(6); G8_BAR; G8_MMA(1, 1, At, B1); G8_BAR;
            G8_LDB(B0, 1, 0); G8_SCHED; G8_LDA(At, 1, 0); G8_STAGE(G8_SA(0, 1), a2, o21);
            G8_WAIT_L(8); G8_BAR; G8_WAIT_L(0); G8_MMA(0, 0, At, B0); G8_BAR; G8_SCHED;
            G8_LDB(B1, 1, 1); G8_STAGE(G8_SB(1, 0), b3, voffB);
            G8_BAR; G8_WAIT_L(0); G8_MMA(0, 1, At, B1); G8_BAR;
            G8_LDA(At, 1, 1); G8_STAGE(G8_SA(1, 0), a3, o20);
            G8_BAR; G8_WAIT_L(0); G8_MMA(1, 0, At, B0); G8_BAR; G8_SCHED;
            G8_STAGE(G8_SB(1, 1), b3 + hstep, voffB);
            G8_WAIT_V(6); G8_BAR; G8_MMA(1, 1, At, B1); G8_BAR;
        }
        if constexpr (FP8) asm volatile("s_nop 15\n\ts_nop 15" ::: "memory");
        if constexpr (ALIGN_EPI) { if (wr == 0) G8_BAR; }
        E(acc, cur, wr, wc, fr, fq);
        if (!has_next) break;
#pragma unroll
        for (int a = 0; a < 2; ++a)
#pragma unroll
            for (int b = 0; b < 2; ++b)
#pragma unroll
                for (int m = 0; m < 4; ++m)
#pragma unroll
                    for (int n = 0; n < 2; ++n) acc[a][b][m][n] = (f32x4){0.f, 0.f, 0.f, 0.f};
        cur = nxt; cB = nB; ++ui;
        if constexpr (GATHER) {
#pragma unroll
            for (int i = 0; i < 2; ++i) { cA0[i] = nA0[i]; cA1[i] = nA1[i]; } }
        else Ab = nAb;
        if constexpr (ALIGN_EPI) { if (wr == 1) G8_BAR; }
    }
    G8_WAIT_V(0);
    if constexpr (!ALIGN_EPI) { if (wr == 0) G8_BAR; }
    G8_BAR;
#undef G8_SA
#undef G8_SB
#undef G8_STAGE
#undef G8_LDA
#undef G8_LDB
#undef G8_MMA
#undef G8_WAIT_V
#undef G8_WAIT_L
#undef G8_BAR
#undef G8_SCHED
}
}

typedef f32x4 Acc[2][2][4][2];
__device__ __forceinline__ u32x4 pack8(const f32x4 a, const f32x4 b) { u32x4 w; w.x = cvt_pk_bf16(a[0], a[1]); w.y = cvt_pk_bf16(a[2], a[3]); w.z = cvt_pk_bf16(b[0], b[1]); w.w = cvt_pk_bf16(b[2], b[3]); return w; }

__device__ __forceinline__ u32x2 pk8_fp8(const f32x4 a, const f32x4 b) { u32x2 w; w.x = (unsigned)__builtin_amdgcn_cvt_pk_fp8_f32(a[2], a[3], __builtin_amdgcn_cvt_pk_fp8_f32(a[0], a[1], 0, false), true); w.y = (unsigned)__builtin_amdgcn_cvt_pk_fp8_f32(b[2], b[3], __builtin_amdgcn_cvt_pk_fp8_f32(b[0], b[1], 0, false), true); return w; }
__device__ __forceinline__ float sq8(const f32x4 a, const f32x4 b) { return (a[0] * a[0] + a[1] * a[1]) + (a[2] * a[2] + a[3] * a[3]) + (b[0] * b[0] + b[1] * b[1]) + (b[2] * b[2] + b[3] * b[3]); }
__device__ __forceinline__ void rope_inplace(Acc& acc, const float* __restrict__ CSp, const float* __restrict__, int row0, int x0, const float (&sc)[8]) {
    const unsigned char* CS = (const unsigned char*)CSp;
#pragma unroll
    for (int h = 0; h < 2; ++h) { u32x4 cv[4], sv[4];
#pragma unroll
        for (int q = 0; q < 4; ++q) { const int i = h * 4 + q; const unsigned char* p = CS + ((size_t)(row0 + (i >> 2) * 128 + (i & 3) * 16) * 4 + (x0 >> 3)) * 32; cv[q] = *(const u32x4*)p; sv[q] = *(const u32x4*)(p + 16); }
#pragma unroll
        for (int q = 0; q < 4; ++q) { const int i = h * 4 + q, ai = i >> 2, m = i & 3; const float k = sc[i];
            const f32x4 c0 = {bf_lo(cv[q].x), bf_hi(cv[q].x), bf_lo(cv[q].y), bf_hi(cv[q].y)}, c1 = {bf_lo(cv[q].z), bf_hi(cv[q].z), bf_lo(cv[q].w), bf_hi(cv[q].w)};
            const f32x4 s0 = {bf_lo(sv[q].x), bf_hi(sv[q].x), bf_lo(sv[q].y), bf_hi(sv[q].y)}, s1 = {bf_lo(sv[q].z), bf_hi(sv[q].z), bf_lo(sv[q].w), bf_hi(sv[q].w)};
            const f32x4 lo0 = acc[ai][0][m][0], lo1 = acc[ai][0][m][1], hi0 = acc[ai][1][m][0], hi1 = acc[ai][1][m][1];
            acc[ai][0][m][0] = (lo0 * c0 - hi0 * s0) * k; acc[ai][0][m][1] = (lo1 * c1 - hi1 * s1) * k;
            acc[ai][1][m][0] = (hi0 * c0 + lo0 * s0) * k; acc[ai][1][m][1] = (hi1 * c1 + lo1 * s1) * k; } }
    asm volatile("" ::: "memory");
}

struct EpiInAB {
    static constexpr int NSTORE = 0;
    bf16_t *QB, *KB, *VB, *KR, *CQ, *CKV; float* SSQ; const float *COS, *SIN; float osc;
    __device__ __forceinline__ void operator()(Acc& acc, const g8::Unit& u, int wr, int wc, int fr, int fq) const {
        const int pn = u.pn, row0 = u.pm * 256 + wr * 64 + fr;
        if (pn <= 4) {
            if (pn == 4 && wc == 3) return;
            const float one[8] = {osc, osc, osc, osc, osc, osc, osc, osc};
            rope_inplace(acc, COS, SIN, row0, 8 * fq, one);
            if (pn == 4 && wc == 2) {
#pragma unroll
                for (int ai = 0; ai < 2; ++ai)
#pragma unroll
                    for (int m = 0; m < 4; ++m) { unsigned char* d8 = (unsigned char*)KR + (size_t)(row0 + ai * 128 + m * 16) * 64 + 8 * fq;
                        *(u32x2*)d8 = pk8_fp8(acc[ai][0][m][0], acc[ai][0][m][1]); *(u32x2*)(d8 + 32) = pk8_fp8(acc[ai][1][m][0], acc[ai][1][m][1]); }
            } else { unsigned char* dst = pn < 4 ? (unsigned char*)QB : (unsigned char*)KB; const int ld = pn < 4 ? 1024 : 128, cb = pn < 4 ? (4 * pn + wc) * 64 : wc * 64;
#pragma unroll
                for (int ai = 0; ai < 2; ++ai)
#pragma unroll
                    for (int m = 0; m < 4; ++m) { unsigned char* d = dst + (size_t)(row0 + ai * 128 + m * 16) * ld + cb + 8 * fq;
                        *(u32x2*)d = pk8_fp8(acc[ai][0][m][0], acc[ai][0][m][1]); *(u32x2*)(d + 32) = pk8_fp8(acc[ai][1][m][0], acc[ai][1][m][1]); } }
        } else {
#pragma unroll
            for (int ai = 0; ai < 2; ++ai)
#pragma unroll
                for (int m = 0; m < 4; ++m) { const int t = row0 + ai * 128 + m * 16; const int c8 = 32 * wc + 8 * fq;
#pragma unroll
                    for (int bj = 0; bj < 2; ++bj) { acc[ai][bj][m][0] = acc[ai][bj][m][0] * osc; acc[ai][bj][m][1] = acc[ai][bj][m][1] * osc; }
                    const u32x4 w0 = pack8(acc[ai][0][m][0], acc[ai][0][m][1]), w1 = pack8(acc[ai][1][m][0], acc[ai][1][m][1]);
                    float s = sq8(acc[ai][0][m][0], acc[ai][0][m][1]);
                    if (pn == 5) { *(u32x4*)(CQ + (size_t)t * 384 + c8) = w0; *(u32x4*)(CQ + (size_t)t * 384 + 128 + c8) = w1; s += sq8(acc[ai][1][m][0], acc[ai][1][m][1]); }
                    else if (pn == 6) { *(u32x4*)(CQ + (size_t)t * 384 + 256 + c8) = w0; *(u32x4*)(VB + (size_t)t * 128 + c8) = w1; }
                    else { *(u32x4*)(CKV + (size_t)t * 256 + c8) = w0; *(u32x4*)(CKV + (size_t)t * 256 + 128 + c8) = w1; s += sq8(acc[ai][1][m][0], acc[ai][1][m][1]); }
                    s += __shfl_xor(s, 16); s += __shfl_xor(s, 32);
                    if (fq == 0) SSQ[(size_t)t * 12 + (pn - 5) * 4 + wc] = s; }
        }
    }
};
struct EpiQUp {
    static constexpr int NSTORE = 16;
    unsigned char* QA8; const float *SSQ, *COS, *SIN;
    __device__ __forceinline__ void operator()(Acc& acc, const g8::Unit& u, int wr, int wc, int fr, int fq) const {
        const int pn = u.pn, row0 = u.pm * 256 + wr * 64 + fr;
        float rstd[8];
#pragma unroll
        for (int i = 0; i < 8; ++i) { const int t = row0 + (i >> 2) * 128 + (i & 3) * 16;
            const f32x4 q0 = *(const f32x4*)(SSQ + (size_t)t * 12), q1 = *(const f32x4*)(SSQ + (size_t)t * 12 + 4);
            rstd[i] = 1.0f / sqrtf(((q0[0] + q0[1]) + (q0[2] + q0[3]) + (q1[0] + q1[1]) + (q1[2] + q1[3])) * (1.0f / 384.0f) + EPS); }
        if (pn < 2) { rope_inplace(acc, COS, SIN, row0, 8 * fq, rstd);
#pragma unroll
            for (int ai = 0; ai < 2; ++ai)
#pragma unroll
                for (int m = 0; m < 4; ++m) { unsigned char* d = QA8 + (size_t)(row0 + ai * 128 + m * 16) * 1536 + (4 * pn + wc) * 192 + 128 + 8 * fq;
                    *(u32x2*)d = pk8_fp8(acc[ai][0][m][0], acc[ai][0][m][1]); *(u32x2*)(d + 32) = pk8_fp8(acc[ai][1][m][0], acc[ai][1][m][1]); } }
        else { asm volatile("" ::: "memory");
#pragma unroll
            for (int ai = 0; ai < 2; ++ai)
#pragma unroll
                for (int m = 0; m < 4; ++m) { const float rs = rstd[ai * 4 + m];
#pragma unroll
                    for (int bj = 0; bj < 2; ++bj) *(u32x2*)(QA8 + (size_t)(row0 + ai * 128 + m * 16) * 1536 + (2 * (pn - 2) + bj) * 192 + 32 * wc + 8 * fq) = pk8_fp8(acc[ai][bj][m][0] * rs, acc[ai][bj][m][1] * rs); } }
    }
};
struct EpiKVUp {
    static constexpr int NSTORE = 16;
    bf16_t* KV; unsigned char* V8; const float* SSQ;
    __device__ __forceinline__ void operator()(Acc& acc, const g8::Unit& u, int wr, int wc, int fr, int fq) const {
        const int row0 = u.pm * 256 + wr * 64 + fr;
        float rstd[8];
#pragma unroll
        for (int i = 0; i < 8; ++i) { const int t = row0 + (i >> 2) * 128 + (i & 3) * 16;
            const f32x4 q0 = *(const f32x4*)(SSQ + (size_t)t * 12 + 8);
            rstd[i] = 1.0f / sqrtf(((q0[0] + q0[1]) + (q0[2] + q0[3])) * (1.0f / 256.0f) + EPS); }
        asm volatile("" ::: "memory");
#pragma unroll
        for (int ai = 0; ai < 2; ++ai)
#pragma unroll
            for (int m = 0; m < 4; ++m) { const int t = row0 + ai * 128 + m * 16; const float rs = rstd[ai * 4 + m];
                *(u32x2*)((unsigned char*)KV + (size_t)t * 4096 + u.pn * 512 + 32 * wc + 8 * fq) = pk8_fp8(acc[ai][0][m][0] * rs, acc[ai][0][m][1] * rs);
                const u32x2 mine = pk8_fp8(acc[ai][1][m][0] * rs, acc[ai][1][m][1] * rs);
                u32x2 oth; oth.x = (unsigned)__builtin_amdgcn_mov_dpp((int)mine.x, 0xB1, 0xF, 0xF, true); oth.y = (unsigned)__builtin_amdgcn_mov_dpp((int)mine.y, 0xB1, 0xF, 0xF, true);
                const bool odd = fr & 1;
                const unsigned ev = odd ? oth.y : mine.x, od = odd ? mine.y : oth.x;
                u32x2 w; w.x = __builtin_amdgcn_perm(od, ev, 0x05010400u); w.y = __builtin_amdgcn_perm(od, ev, 0x07030602u);
                *(u32x2*)(V8 + ((size_t)(t >> 1) * 1024 + u.pn * 128 + 32 * wc + 8 * fq + (odd ? 4 : 0)) * 2) = w; }
    }
};
struct EpiResid {
    static constexpr int NSTORE = 16;
    float* X; const float* gate; float osc;
    __device__ __forceinline__ void operator()(Acc& acc, const g8::Unit& u, int wr, int wc, int fr, int fq) const {
        const int row0 = u.pm * 256 + wr * 64 + fr; const float* gp = gate + (size_t)(u.pm >> 4) * 6144;
        unsigned char* xb = (unsigned char*)X + (size_t)row0 * 2048 + (u.pn * 256 + 32 * wc + 8 * fq) * 2;
        u32x4 xv[2][8];
#pragma unroll
        for (int bj = 0; bj < 2; ++bj)
#pragma unroll
            for (int i = 0; i < 8; ++i) xv[bj][i] = *(const u32x4*)(xb + (size_t)((i >> 2) * 128 + (i & 3) * 16) * 2048 + bj * 256);
#pragma unroll
        for (int bj = 0; bj < 2; ++bj) { const int col = u.pn * 256 + 128 * bj + 32 * wc + 8 * fq;
            const f32x4 g0 = *(const f32x4*)(gp + col), g1 = *(const f32x4*)(gp + col + 4);
#pragma unroll
            for (int i = 0; i < 8; ++i) { const u32x4 q = xv[bj][i]; const f32x4 x0 = {bf_lo(q.x), bf_hi(q.x), bf_lo(q.y), bf_hi(q.y)}, x1 = {bf_lo(q.z), bf_hi(q.z), bf_lo(q.w), bf_hi(q.w)};
                const f32x4 r0 = x0 + g0 * (acc[i >> 2][bj][i & 3][0] * osc), r1 = x1 + g1 * (acc[i >> 2][bj][i & 3][1] * osc);
                xv[bj][i] = (u32x4){cvt_pk_bf16(r0[0], r0[1]), cvt_pk_bf16(r0[2], r0[3]), cvt_pk_bf16(r1[0], r1[1]), cvt_pk_bf16(r1[2], r1[3])}; } }
        asm volatile("" ::: "memory");
#pragma unroll
        for (int bj = 0; bj < 2; ++bj)
#pragma unroll
            for (int i = 0; i < 8; ++i) *(u32x4*)(xb + (size_t)((i >> 2) * 128 + (i & 3) * 16) * 2048 + bj * 256) = xv[bj][i];
    }
};
struct EpiInC {
    static constexpr int NSTORE = 16;
    bf16_t* PC; const float *COS, *SIN; float osc;
    __device__ __forceinline__ size_t rowoff(int t, int gs, int head, int lg) const { const int b = t >> 12, p = t & 4095, r = p & ((1 << lg) - 1), i = p >> lg;
        return ((size_t)((b * 9 + gs) * 16 + head) * 4096 + (size_t)r * (4096 >> lg) + i) * 64; }
    __device__ __forceinline__ void operator()(Acc& acc, const g8::Unit& u, int wr, int wc, int fr, int fq) const {
        const int pn = u.pn, gs = pn >> 2, g = gs / 3, s = gs - 3 * g, lg = 2 * g, row0 = u.pm * 256 + wr * 64 + fr;
        if (s < 2) { const float one[8] = {osc, osc, osc, osc, osc, osc, osc, osc};
            rope_inplace(acc, COS, SIN, row0, 8 * fq, one);
#pragma unroll
            for (int ai = 0; ai < 2; ++ai)
#pragma unroll
                for (int m = 0; m < 4; ++m) { const int t = row0 + ai * 128 + m * 16, b = t >> 12, p = t & 4095, r = p & ((1 << lg) - 1), i = p >> lg;
                    unsigned char* d = (unsigned char*)PC + (size_t)((b * 9 + gs) * 16 + 4 * (pn & 3) + wc) * (4096 * 128) + ((size_t)r * (4096 >> lg) + i) * 64 + 8 * fq;
                    *(u32x2*)d = pk8_fp8(acc[ai][0][m][0], acc[ai][0][m][1]); *(u32x2*)(d + 32) = pk8_fp8(acc[ai][1][m][0], acc[ai][1][m][1]); } }
        else {
#pragma unroll
            for (int ai = 0; ai < 2; ++ai)
#pragma unroll
                for (int m = 0; m < 4; ++m)
#pragma unroll
                    for (int bj = 0; bj < 2; ++bj) *(u32x4*)(PC + rowoff(row0 + ai * 128 + m * 16, gs, 4 * (pn & 3) + 2 * bj + (wc >> 1), lg) + 32 * (wc & 1) + 8 * fq) = pack8(acc[ai][bj][m][0] * osc, acc[ai][bj][m][1] * osc); }
    }
};
struct EpiSwiGLU {
    static constexpr int NSTORE = 8;
    unsigned char* ACT8; const float* bgu;
    __device__ __forceinline__ void operator()(Acc& acc, const g8::Unit& u, int wr, int wc, int fr, int fq) const {
        const int e = u.aux >> 16, col = u.pn * 128 + 32 * wc + 8 * fq, row0 = u.pm * 256 + wr * 64 + fr;
        const float* bp = bgu + (size_t)e * 2048 + col;
        const f32x4 bg0 = *(const f32x4*)bp, bg1 = *(const f32x4*)(bp + 4), bl0 = *(const f32x4*)(bp + 1024), bl1 = *(const f32x4*)(bp + 1028);
#pragma unroll
        for (int ai = 0; ai < 2; ++ai)
#pragma unroll
            for (int m = 0; m < 4; ++m) { f32x4 r[2];
#pragma unroll
                for (int n = 0; n < 2; ++n) { const f32x4 g = acc[ai][0][m][n] * (1.0f / 32.0f) + (n ? bg1 : bg0), l = acc[ai][1][m][n] * (1.0f / 32.0f) + (n ? bl1 : bl0);
#pragma unroll
                    for (int i = 0; i < 4; ++i) { const float gl = fminf(g[i], 7.0f), li = fminf(fmaxf(l[i], -7.0f), 7.0f);
                        const float sg = __builtin_amdgcn_rcpf(1.0f + __builtin_amdgcn_exp2f(-1.702f * 1.4426950408889634f * gl)); r[n][i] = 4.0f * gl * sg * (li + 1.0f); } }
                u32x2 w; w.x = (unsigned)__builtin_amdgcn_cvt_pk_fp8_f32(r[0][2], r[0][3], __builtin_amdgcn_cvt_pk_fp8_f32(r[0][0], r[0][1], 0, false), true);
                w.y = (unsigned)__builtin_amdgcn_cvt_pk_fp8_f32(r[1][2], r[1][3], __builtin_amdgcn_cvt_pk_fp8_f32(r[1][0], r[1][1], 0, false), true);
                *(u32x2*)(ACT8 + (size_t)(row0 + ai * 128 + m * 16) * 1024 + col) = w; }
    }
};
struct EpiNull { static constexpr int NSTORE = 0; __device__ __forceinline__ void operator()(Acc& acc, const g8::Unit& u, int wr, int wc, int fr, int fq) const { asm volatile("" :: "v"(acc[0][0][0][0]), "v"(acc[1][1][3][1])); } };
struct EpiP1 {
    static constexpr int NSTORE = 16; bf16_t* YB;
    __device__ __forceinline__ void operator()(Acc& acc, const g8::Unit& u, int wr, int wc, int fr, int fq) const {
        const int row0 = u.pm * 256 + wr * 64 + fr;
#pragma unroll
        for (int bj = 0; bj < 2; ++bj) { const int col = u.pn * 256 + 128 * bj + 32 * wc + 8 * fq;
#pragma unroll
            for (int ai = 0; ai < 2; ++ai)
#pragma unroll
                for (int m = 0; m < 4; ++m) *(u32x4*)(YB + (size_t)(row0 + ai * 128 + m * 16) * 1024 + col) = pack8(acc[ai][bj][m][0], acc[ai][bj][m][1]); }
    }
};
struct EpiP2 {
    static constexpr int NSTORE = 0; bf16_t* YB; const float* bdn;
    __device__ __forceinline__ void operator()(Acc& acc, const g8::Unit& u, int wr, int wc, int fr, int fq) const {
        const int e = u.aux >> 16, row0 = u.pm * 256 + wr * 64 + fr;
        f32x4 b[2][2];
#pragma unroll
        for (int bj = 0; bj < 2; ++bj) { const float* bp = bdn + (size_t)e * 1024 + u.pn * 256 + 128 * bj + 32 * wc + 8 * fq; b[bj][0] = *(const f32x4*)bp; b[bj][1] = *(const f32x4*)(bp + 4); }
        u32x4 x = {0u, 0u, 0u, 0u};
#pragma unroll
        for (int bj = 0; bj < 2; ++bj)
#pragma unroll
            for (int ai = 0; ai < 2; ++ai)
#pragma unroll
                for (int m = 0; m < 4; ++m) { const u32x4 w = pack8(acc[ai][bj][m][0] * (1.0f / 128.0f) + b[bj][0], acc[ai][bj][m][1] * (1.0f / 128.0f) + b[bj][1]); x = x ^ w; }
        *(u32x4*)(YB + (size_t)row0 * 1024 + u.pn * 256 + 32 * wc + 8 * fq) = x;
    }
};
struct EpiDown {
    static constexpr int NSTORE = 8;
    unsigned char* YB8; const float* bdn;
    __device__ __forceinline__ void operator()(Acc& acc, const g8::Unit& u, int wr, int wc, int fr, int fq) const {
        const int e = u.aux >> 16, row0 = u.pm * 256 + wr * 64 + fr, colb = u.pn * 256 + 64 * wc + 16 * fq;
        f32x4 b[2][2];
#pragma unroll
        for (int bj = 0; bj < 2; ++bj) { const float* bp = bdn + (size_t)e * 1024 + colb + 8 * bj; b[bj][0] = *(const f32x4*)bp; b[bj][1] = *(const f32x4*)(bp + 4); }
        asm volatile("" ::: "memory");
#pragma unroll
        for (int ai = 0; ai < 2; ++ai)
#pragma unroll
            for (int m = 0; m < 4; ++m) { const u32x2 lo = pk8_fp8(acc[ai][0][m][0] * (1.0f / 128.0f) + b[0][0], acc[ai][0][m][1] * (1.0f / 128.0f) + b[0][1]), hi = pk8_fp8(acc[ai][1][m][0] * (1.0f / 128.0f) + b[1][0], acc[ai][1][m][1] * (1.0f / 128.0f) + b[1][1]);
                *(u32x4*)(YB8 + (size_t)(row0 + ai * 128 + m * 16) * 1024 + colb) = (u32x4){lo.x, lo.y, hi.x, hi.y}; }
    }
};

struct MoeSchedUp {
    const char* H; const char* Wt; const LAS int* tinfo; const LAS int* ltok; int nunits, G, c;
    static constexpr bool GATHER = true;
    __device__ __forceinline__ bool next(int i, g8::Unit& u) const { const int L = i * G + c; if (L >= nunits) return false; u.pm = L >> 3; u.pn = L & 7; u.aux = tinfo[u.pm]; u.ord = i; return true; }
    __device__ __forceinline__ const char* a_base() const { return H; }
    __device__ __forceinline__ const char* a_tile(const g8::Unit& u) const { return H; }
    __device__ __forceinline__ unsigned a_off(const g8::Unit& u, int r) const { return (unsigned)ltok[u.ord * 256 + r] * 1024u; }
    __device__ __forceinline__ const char* b_tile(const g8::Unit& u) const { return Wt + ((size_t)(u.aux >> 16) * 2048 + (size_t)u.pn * 256) * 1024; }
};
struct MoeSchedDown {
    const char* A; const char* Wt; const LAS int* tinfo; int nunits, G, c;
    __device__ __forceinline__ bool next(int i, g8::Unit& u) const { const int L = i * G + c; if (L >= nunits) return false; u.pm = L >> 2; u.pn = L & 3; u.aux = tinfo[u.pm]; u.ord = i; return true; }
    static constexpr bool GATHER = false;
    __device__ __forceinline__ const char* a_base() const { return A; }
    __device__ __forceinline__ const char* a_tile(const g8::Unit& u) const { return A + (size_t)u.pm * 256 * 1024; }
    __device__ __forceinline__ unsigned a_off(const g8::Unit& u, int r) const { return 0u; }
    __device__ __forceinline__ const char* b_tile(const g8::Unit& u) const { return Wt + ((size_t)(u.aux >> 16) * 1024 + (size_t)u.pn * 256) * 1024; }
};
struct MoeSchedDownHot : MoeSchedDown {
    __device__ __forceinline__ const char* a_tile(const g8::Unit& u) const { return A; }
    __device__ __forceinline__ const char* b_tile(const g8::Unit& u) const { return Wt; }
};
__device__ __forceinline__ void build_moe_tables(LAS unsigned char* lds, unsigned* gcnt, const int wave_s_) {
    LAS int* tinfo = (LAS int*)(lds + TAB_TINFO); LAS int* ecnt = (LAS int*)(lds + TAB_ECNT); LAS int* tstart = (LAS int*)(lds + TAB_TSTART); LAS int* ntp = (LAS int*)(lds + TAB_NT);
    const int tid = tid_now(wave_s_);
    __syncthreads();
    if (tid < 32) ecnt[tid] = (int)__hip_atomic_load(gcnt + tid, __ATOMIC_RELAXED, __HIP_MEMORY_SCOPE_AGENT);
    __syncthreads();
    if (tid < 32) { int ts = 0; for (int e = 0; e < tid; ++e) ts += (ecnt[e] + 255) >> 8; const int n = (ecnt[tid] + 255) >> 8; tstart[tid] = ts;
        for (int lt = 0; lt < n; ++lt) tinfo[ts + lt] = (tid << 16) | lt; if (tid == 31) ntp[0] = ts + n; }
    __syncthreads();
}

__device__ __forceinline__ unsigned pk_fp8x4(float a, float b, float c, float d) { return (unsigned)__builtin_amdgcn_cvt_pk_fp8_f32(c, d, __builtin_amdgcn_cvt_pk_fp8_f32(a, b, 0, false), true); }
namespace att {
constexpr int QBLK = 32, KVBLK = 64;
#define KSWZ256(row, colB) ((row) * 256 + ((colB) ^ (((row) & 7) << 4)))
#define KSWZ128(row, colB) ((row) * 128 + ((colB) ^ ((((row) >> 1) & 7) << 4)))
__device__ __forceinline__ int crow(int r, int hi) { return (r & 3) + 8 * (r >> 2) + 4 * hi; }
__device__ __forceinline__ int v_st(int k, int c) { return ((k >> 3) * 4 + (c >> 5)) * 512 + ((k & 7) * 32 + (c & 31)) * 2; }
__device__ __forceinline__ int v_rd_base(int lane) { return ((lane & 3) << 3) | (((lane >> 2) & 3) << 6) | (((lane >> 4) & 1) << 5) | (((lane >> 5) & 1) << 8); }
constexpr int v_rd_off(int d0, int ks, int half) { return d0 * 512 + ks * 4096 + half * 2048; }
typedef short v4i16_t __attribute__((ext_vector_type(4)));
template <int OFF> __device__ __forceinline__ s16x4 tr_rd(int vb) { return __builtin_bit_cast(s16x4, __builtin_amdgcn_ds_read_tr16_b64_v4i16((LAS v4i16_t*)(unsigned)(vb + OFF))); }
template <int OFF> __device__ __forceinline__ s16x4 tr_read(int vb) { s16x4 r; asm volatile("ds_read_b64_tr_b16 %0, %1 offset:%2" : "=&v"(r) : "v"(vb), "i"(OFF) : "memory"); return r; }
template <int D0> __device__ __forceinline__ void pv_one(f32x16& od, int vb, bf16x8 pa0, bf16x8 pa1, bf16x8 pa2, bf16x8 pa3) {
    const s16x4 l0 = tr_read<v_rd_off(D0, 0, 0)>(vb), h0 = tr_read<v_rd_off(D0, 0, 1)>(vb), l1 = tr_read<v_rd_off(D0, 1, 0)>(vb), h1 = tr_read<v_rd_off(D0, 1, 1)>(vb);
    const s16x4 l2 = tr_read<v_rd_off(D0, 2, 0)>(vb), h2 = tr_read<v_rd_off(D0, 2, 1)>(vb), l3 = tr_read<v_rd_off(D0, 3, 0)>(vb), h3 = tr_read<v_rd_off(D0, 3, 1)>(vb);
    asm volatile("s_waitcnt lgkmcnt(0)" ::: "memory"); SBAR();
#define PKV(L, H) (bf16x8){L[0], L[1], L[2], L[3], H[0], H[1], H[2], H[3]}
    od = __builtin_amdgcn_mfma_f32_32x32x16_bf16(PKV(l0, h0), pa0, od, 0, 0, 0);
    od = __builtin_amdgcn_mfma_f32_32x32x16_bf16(PKV(l1, h1), pa1, od, 0, 0, 0);
    od = __builtin_amdgcn_mfma_f32_32x32x16_bf16(PKV(l2, h2), pa2, od, 0, 0, 0);
    od = __builtin_amdgcn_mfma_f32_32x32x16_bf16(PKV(l3, h3), pa3, od, 0, 0, 0);
#undef PKV
}
template <int D0, int H> __device__ __forceinline__ void pv_half(f32x16& od, int vb, bf16x8 pa, bf16x8 pb) {
    const s16x4 l0 = tr_read<v_rd_off(D0, 2 * H, 0)>(vb), h0 = tr_read<v_rd_off(D0, 2 * H, 1)>(vb), l1 = tr_read<v_rd_off(D0, 2 * H + 1, 0)>(vb), h1 = tr_read<v_rd_off(D0, 2 * H + 1, 1)>(vb);
    asm volatile("s_waitcnt lgkmcnt(0)" ::: "memory"); SBAR();
#define PKV(L, H_) (bf16x8){L[0], L[1], L[2], L[3], H_[0], H_[1], H_[2], H_[3]}
    od = __builtin_amdgcn_mfma_f32_32x32x16_bf16(pa, PKV(l0, h0), od, 0, 0, 0);
    od = __builtin_amdgcn_mfma_f32_32x32x16_bf16(pb, PKV(l1, h1), od, 0, 0, 0);
#undef PKV
}
__device__ __forceinline__ unsigned cvt2(float lo, float hi) { typedef float f2 __attribute__((ext_vector_type(2))); typedef __bf16 b2 __attribute__((ext_vector_type(2))); f2 v = {lo, hi}; b2 r = __builtin_convertvector(v, b2); return __builtin_bit_cast(unsigned, r); }
__device__ __forceinline__ void p_to_frag(const f32x16& p0, const f32x16& p1, bf16x8& pa0, bf16x8& pa1, bf16x8& pa2, bf16x8& pa3) {
    u32x4 w0 = {cvt2(p0[0], p0[1]), cvt2(p0[2], p0[3]), cvt2(p0[4], p0[5]), cvt2(p0[6], p0[7])}, w1 = {cvt2(p0[8], p0[9]), cvt2(p0[10], p0[11]), cvt2(p0[12], p0[13]), cvt2(p0[14], p0[15])};
    u32x4 w2 = {cvt2(p1[0], p1[1]), cvt2(p1[2], p1[3]), cvt2(p1[4], p1[5]), cvt2(p1[6], p1[7])}, w3 = {cvt2(p1[8], p1[9]), cvt2(p1[10], p1[11]), cvt2(p1[12], p1[13]), cvt2(p1[14], p1[15])};
    pa0 = *reinterpret_cast<bf16x8*>(&w0); pa1 = *reinterpret_cast<bf16x8*>(&w1); pa2 = *reinterpret_cast<bf16x8*>(&w2); pa3 = *reinterpret_cast<bf16x8*>(&w3);
}

constexpr float SCALE_D = 0.07216878364870322f;
constexpr float THR = 2.5f;
constexpr size_t SHM_V = KVBLK * 128, SHM_K = KVBLK * 128, SHM_R = KVBLK * 64;
constexpr int DENSE_NBUF = 5;
constexpr int DENSE_LDS = DENSE_NBUF * (SHM_V + SHM_K + SHM_R);
#define KSWZ64(row, colB) ((row) * 64 + ((colB) ^ ((((row) >> 2) & 3) << 4)))
typedef int i32x8q __attribute__((ext_vector_type(8)));
__device__ __forceinline__ void partialSM(f32x16& p0, f32x16& p1, float& m_reg, float& mn, float& alpha) {
    constexpr float C = SCALE_D * 1.4426950408889634f;
    float pmax = p0[0];
#pragma unroll
    for (int r = 1; r < 16; ++r) pmax = fmaxf(pmax, p0[r]);
#pragma unroll
    for (int r = 0; r < 16; ++r) pmax = fmaxf(pmax, p1[r]);
    { auto rr = __builtin_amdgcn_permlane32_swap(__float_as_uint(pmax), __float_as_uint(pmax), false, false);
      pmax = fmaxf(__uint_as_float(rr[0]), __uint_as_float(rr[1])); }
    if (__builtin_expect(__all(pmax - m_reg <= THR / SCALE_D), 1)) { mn = m_reg; alpha = 1.f; }
    else { mn = fmaxf(m_reg, pmax); alpha = __builtin_amdgcn_exp2f((m_reg - mn) * C); m_reg = mn; }
    const float mnC = 5.0f - mn * C;
#pragma unroll
    for (int r = 0; r < 16; ++r) p0[r] = fmaf(p0[r], C, mnC);
#pragma unroll
    for (int r = 0; r < 16; ++r) p1[r] = fmaf(p1[r], C, mnC);
#pragma unroll
    for (int r = 0; r < 16; ++r) p0[r] = __builtin_amdgcn_exp2f(p0[r]);
}
__device__ __forceinline__ void finishSM(f32x16& p0, f32x16& p1, float alpha, float& l_reg, i32x8q& pq) {
#pragma unroll
    for (int r = 0; r < 16; ++r) p1[r] = __builtin_amdgcn_exp2f(p1[r]);
    float ps = 0;
#pragma unroll
    for (int r = 0; r < 16; ++r) ps += p0[r];
#pragma unroll
    for (int r = 0; r < 16; ++r) ps += p1[r];
    { auto rr = __builtin_amdgcn_permlane32_swap(__float_as_uint(ps), __float_as_uint(ps), false, false);
      ps = __uint_as_float(rr[0]) + __uint_as_float(rr[1]); }
    l_reg = l_reg * alpha + ps;
#pragma unroll
    for (int i = 0; i < 4; ++i) { pq[i] = (int)pk_fp8x4(p0[4 * i], p0[4 * i + 1], p0[4 * i + 2], p0[4 * i + 3]); pq[4 + i] = (int)pk_fp8x4(p1[4 * i], p1[4 * i + 1], p1[4 * i + 2], p1[4 * i + 3]); }
}
__device__ __forceinline__ void qkt_d(f32x16& p0, f32x16& p1, const char* Kn, const char* Kr, const i32x8q (&qr)[3], int r32, int hi) {
    { const int cb = hi * 32;
      const i32x8q ka = g8::cat8(*reinterpret_cast<const bf16x8*>(Kn + KSWZ128(r32, cb)), *reinterpret_cast<const bf16x8*>(Kn + KSWZ128(r32, cb + 16)));
      const i32x8q kb = g8::cat8(*reinterpret_cast<const bf16x8*>(Kn + KSWZ128(32 + r32, cb)), *reinterpret_cast<const bf16x8*>(Kn + KSWZ128(32 + r32, cb + 16)));
      asm volatile("v_mfma_f32_32x32x64_f8f6f4 %0, %2, %3, 0\n\tv_mfma_f32_32x32x64_f8f6f4 %1, %4, %3, 0" : "=&v"(p0), "=&v"(p1) : "v"(ka), "v"(qr[0]), "v"(kb)); }
    { const int cb = 64 + hi * 32;
      const i32x8q ka = g8::cat8(*reinterpret_cast<const bf16x8*>(Kn + KSWZ128(r32, cb)), *reinterpret_cast<const bf16x8*>(Kn + KSWZ128(r32, cb + 16)));
      const i32x8q kb = g8::cat8(*reinterpret_cast<const bf16x8*>(Kn + KSWZ128(32 + r32, cb)), *reinterpret_cast<const bf16x8*>(Kn + KSWZ128(32 + r32, cb + 16)));
      asm volatile("v_mfma_f32_32x32x64_f8f6f4 %0, %2, %3, %0\n\tv_mfma_f32_32x32x64_f8f6f4 %1, %4, %3, %1" : "+v"(p0), "+v"(p1) : "v"(ka), "v"(qr[1]), "v"(kb)); }
    { const int cb = hi * 32;
      const i32x8q ka = g8::cat8(*reinterpret_cast<const bf16x8*>(Kr + KSWZ64(r32, cb)), *reinterpret_cast<const bf16x8*>(Kr + KSWZ64(r32, cb + 16)));
      const i32x8q kb = g8::cat8(*reinterpret_cast<const bf16x8*>(Kr + KSWZ64(32 + r32, cb)), *reinterpret_cast<const bf16x8*>(Kr + KSWZ64(32 + r32, cb + 16)));
      asm volatile("v_mfma_f32_32x32x64_f8f6f4 %0, %2, %3, %0\n\tv_mfma_f32_32x32x64_f8f6f4 %1, %4, %3, %1\n\ts_nop 15\n\ts_nop 7" : "+v"(p0), "+v"(p1) : "v"(ka), "v"(qr[2]), "v"(kb)); }
}
template <int D0> __device__ __forceinline__ void pv8_one(f32x16& od, int vb, const i32x8q& pq) {
    const s16x4 a = tr_rd<v_rd_off(D0, 0, 0)>(vb), b = tr_rd<v_rd_off(D0, 0, 1)>(vb), c = tr_rd<v_rd_off(D0, 1, 0)>(vb), d = tr_rd<v_rd_off(D0, 1, 1)>(vb);
    typedef int i2 __attribute__((ext_vector_type(2)));
    const i2 a2 = __builtin_bit_cast(i2, a), b2 = __builtin_bit_cast(i2, b), c2 = __builtin_bit_cast(i2, c), d2 = __builtin_bit_cast(i2, d);
    const i32x8q vf = {a2[0], a2[1], b2[0], b2[1], c2[0], c2[1], d2[0], d2[1]};
    asm volatile("s_nop 3\n\tv_mfma_f32_32x32x64_f8f6f4 %0, %1, %2, %0" : "+v"(od) : "v"(vf), "v"(pq));
}
__device__ __forceinline__ void pv_d4(f32x16* o, int vb, const i32x8q& pq) {
    pv8_one<0>(o[0], vb, pq); pv8_one<1>(o[1], vb, pq); pv8_one<2>(o[2], vb, pq); pv8_one<3>(o[3], vb, pq);
}
__device__ __forceinline__ void partial_max(const f32x16& c0, const f32x16& c1, float& m_reg, float& alCur) {
    constexpr float C = SCALE_D * 1.4426950408889634f;
    float pmax = c0[0];
#pragma unroll
    for (int r = 1; r < 16; ++r) pmax = fmaxf(pmax, c0[r]);
#pragma unroll
    for (int r = 0; r < 16; ++r) pmax = fmaxf(pmax, c1[r]);
    { auto rr = __builtin_amdgcn_permlane32_swap(__float_as_uint(pmax), __float_as_uint(pmax), false, false);
      pmax = fmaxf(__uint_as_float(rr[0]), __uint_as_float(rr[1])); }
    const bool keep = __all(pmax - m_reg <= THR / SCALE_D);
    const float mn = keep ? m_reg : fmaxf(m_reg, pmax);
    alCur = __builtin_amdgcn_exp2f((m_reg - mn) * C); m_reg = mn;
}
template <class Mid>
__device__ __forceinline__ void dense_step(f32x16& c0, f32x16& c1, f32x16& p0, f32x16& p1, float& m_reg, float& l_reg, const float alPrev, float& alCur, f32x16 (&o)[4], const i32x8q (&qr)[3],
                                           const char* Kn, const char* Kr, const int vbp, const int r32, const int hi, Mid&& mid) {
    constexpr float C = SCALE_D * 1.4426950408889634f;
    typedef int i2 __attribute__((ext_vector_type(2)));
#define KOP_(base, SW, row, cb) g8::cat8(*reinterpret_cast<const bf16x8*>((base) + SW(row, cb)), *reinterpret_cast<const bf16x8*>((base) + SW(row, (cb) + 16)))
#define VOP_(D0) ([&]() { const s16x4 a_ = tr_rd<v_rd_off(D0, 0, 0)>(vbp), b_ = tr_rd<v_rd_off(D0, 0, 1)>(vbp), c_ = tr_rd<v_rd_off(D0, 1, 0)>(vbp), d_ = tr_rd<v_rd_off(D0, 1, 1)>(vbp); \
        const i2 a2 = __builtin_bit_cast(i2, a_), b2 = __builtin_bit_cast(i2, b_), c2 = __builtin_bit_cast(i2, c_), d2 = __builtin_bit_cast(i2, d_); return (i32x8q){a2[0], a2[1], b2[0], b2[1], c2[0], c2[1], d2[0], d2[1]}; }())
    const i32x8q ka0 = KOP_(Kn, KSWZ128, r32, hi * 32), kb0 = KOP_(Kn, KSWZ128, 32 + r32, hi * 32);
    SBAR();
    asm volatile("v_mfma_f32_32x32x64_f8f6f4 %0, %2, %3, 0\n\tv_mfma_f32_32x32x64_f8f6f4 %1, %4, %3, 0" : "=&v"(c0), "=&v"(c1) : "v"(ka0), "v"(qr[0]), "v"(kb0));
    const i32x8q ka1 = KOP_(Kn, KSWZ128, r32, 64 + hi * 32), kb1 = KOP_(Kn, KSWZ128, 32 + r32, 64 + hi * 32);
    SBAR();
    { const float mnC = 5.0f - m_reg * C;
#pragma unroll
      for (int r = 0; r < 16; ++r) p0[r] = __builtin_amdgcn_exp2f(fmaf(p0[r], C, mnC));
#pragma unroll
      for (int r = 0; r < 16; ++r) p1[r] = fmaf(p1[r], C, mnC); }
    SBAR();
    asm volatile("s_nop 1\n\tv_mfma_f32_32x32x64_f8f6f4 %0, %2, %3, %0\n\tv_mfma_f32_32x32x64_f8f6f4 %1, %4, %3, %1" : "+v"(c0), "+v"(c1) : "v"(ka1), "v"(qr[1]), "v"(kb1));
    const i32x8q ka2 = KOP_(Kr, KSWZ64, r32, hi * 32), kb2 = KOP_(Kr, KSWZ64, 32 + r32, hi * 32);
    SBAR();
#pragma unroll
    for (int r = 0; r < 16; ++r) p1[r] = __builtin_amdgcn_exp2f(p1[r]);
    float psa = p0[0], psb = p1[0];
#pragma unroll
    for (int r = 1; r < 16; ++r) { psa += p0[r]; psb += p1[r]; }
    SBAR();
    asm volatile("s_nop 1\n\tv_mfma_f32_32x32x64_f8f6f4 %0, %2, %3, %0\n\tv_mfma_f32_32x32x64_f8f6f4 %1, %4, %3, %1" : "+v"(c0), "+v"(c1) : "v"(ka2), "v"(qr[2]), "v"(kb2));
    SBAR();
    mid();
    SBAR();
    const i32x8q vf0 = VOP_(0), vf1 = VOP_(1);
    SBAR();
    i32x8q pq;
    { float ps = psa + psb; auto rr = __builtin_amdgcn_permlane32_swap(__float_as_uint(ps), __float_as_uint(ps), false, false);
      ps = __uint_as_float(rr[0]) + __uint_as_float(rr[1]); l_reg = l_reg * alPrev + ps; }
#pragma unroll
    for (int i = 0; i < 4; ++i) { pq[i] = (int)pk_fp8x4(p0[4 * i], p0[4 * i + 1], p0[4 * i + 2], p0[4 * i + 3]); pq[4 + i] = (int)pk_fp8x4(p1[4 * i], p1[4 * i + 1], p1[4 * i + 2], p1[4 * i + 3]); }
    SBAR();
    asm volatile("s_nop 3\n\tv_mfma_f32_32x32x64_f8f6f4 %0, %1, %2, %0" : "+v"(o[0]) : "v"(vf0), "v"(pq));
    const i32x8q vf2 = VOP_(2);
    asm volatile("s_nop 3\n\tv_mfma_f32_32x32x64_f8f6f4 %0, %1, %2, %0" : "+v"(o[1]) : "v"(vf1), "v"(pq));
    const i32x8q vf3 = VOP_(3);
    SBAR();
    partial_max(c0, c1, m_reg, alCur);
    SBAR();
    asm volatile("s_nop 3\n\tv_mfma_f32_32x32x64_f8f6f4 %0, %1, %2, %0" : "+v"(o[2]) : "v"(vf2), "v"(pq));
    asm volatile("s_nop 3\n\tv_mfma_f32_32x32x64_f8f6f4 %0, %1, %2, %0" : "+v"(o[3]) : "v"(vf3), "v"(pq));
    SBAR();
#undef KOP_
#undef VOP_
}
__device__ __forceinline__ void dense_unit(const unsigned char* __restrict__ Qb, const unsigned char* __restrict__ Knp, const unsigned char* __restrict__ Vh, const unsigned char* __restrict__ Krp, bf16_t* __restrict__ Ob, int seq, char* lds, const int wave_s_) {
    constexpr int LDQ = 1536, LDKN = 4096, LDVP = 2048  , LDR = 64, LDO = 2048;
    const int tid = tid_now(wave_s_);
    const int wid = tid >> 6, lane = tid & 63, r32 = lane & 31, hi = lane >> 5;
    char* V_lds = lds; char* K_lds = lds + DENSE_NBUF * SHM_V; char* R_lds = lds + DENSE_NBUF * SHM_V + DENSE_NBUF * SHM_K;
    float m_reg = -1e30f, l_reg = 0; f32x16 o[4] = {}; i32x8q qr[3];
    const unsigned char* Qw = Qb + (long)(wid * QBLK + r32) * LDQ + hi * 32;
#pragma unroll
    for (int m = 0; m < 3; ++m) qr[m] = g8::cat8(*reinterpret_cast<const bf16x8*>(Qw + m * 64), *reinterpret_cast<const bf16x8*>(Qw + m * 64 + 16));
    const int vkp = tid >> 4, vch = tid & 15, vst0 = v_st((vkp & ~6) | ((vkp & 2) << 1) | ((vkp & 4) >> 1), vch * 8);
    const int kr_ = tid >> 3, kc_ = (tid & 7) * 16;
    const int rr = (tid >> 2) & 63, rc = (tid & 3) * 16;
    const int vb0 = (int)(uintptr_t)V_lds + v_rd_base(lane);
    struct { bf16x8 vs0, kn, rs; } sr_;
#define SLOAD(k0) do { sr_.vs0 = *(const bf16x8*)(Vh + (long)(((k0) >> 1) + vkp) * LDVP + vch * 16); \
    sr_.kn = *(const bf16x8*)(Knp + (long)((k0) + kr_) * LDKN + kc_); sr_.rs = *(const bf16x8*)(Krp + (long)((k0) + rr) * LDR + rc); } while (0)
#define SWRITE(b) do { *(bf16x8*)(V_lds + (b) * SHM_V + vst0) = sr_.vs0; \
    *(bf16x8*)(K_lds + (b) * SHM_K + KSWZ128(kr_, kc_)) = sr_.kn; *(bf16x8*)(R_lds + (b) * SHM_R + KSWZ64(rr, rc)) = sr_.rs; } while (0)
#define SWAIT() asm volatile("s_waitcnt vmcnt(0)" ::: "memory")
#define RESC(a) do { if (__any((a) < 1.f)) { asm volatile("s_nop 15\n\ts_nop 7" ::: "memory"); _Pragma("unroll") for (int d = 0; d < 4; ++d) _Pragma("unroll") for (int r = 0; r < 16; ++r) o[d][r] *= (a); } } while (0)
    f32x16 pA0, pA1, pB0, pB1; float mnA, mnB, alA, alB; i32x8q pq; const int NT = seq / KVBLK;
    __syncthreads();
#define BNEXT(b, k) (((b) + (k)) >= DENSE_NBUF ? (b) + (k) - DENSE_NBUF : (b) + (k))
    SLOAD(0); SWAIT(); SWRITE(0); SLOAD(KVBLK); SWAIT(); SWRITE(1); SLOAD(2 * KVBLK); __syncthreads();
    SWAIT(); SWRITE(2); SLOAD(3 * KVBLK);
    qkt_d(pA0, pA1, K_lds, R_lds, qr, r32, hi); partial_max(pA0, pA1, m_reg, alA);
    int bc = 1, bp = 0;
    for (int j = 1; j + 1 < NT; j += 2) {
        { const int bw = BNEXT(bc, 2);
          dense_step(pB0, pB1, pA0, pA1, m_reg, l_reg, alA, alB, o, qr, K_lds + bc * SHM_K, R_lds + bc * SHM_R, vb0 + bp * (int)SHM_V, r32, hi, [&]() { if (j + 2 < NT) { SWAIT(); SWRITE(bw); if (j + 3 < NT) SLOAD((j + 3) * KVBLK); } });
          RESC(alB);
          bp = bc; bc = BNEXT(bc, 1); }
        __syncthreads();
        { const int bw = BNEXT(bc, 2);
          dense_step(pA0, pA1, pB0, pB1, m_reg, l_reg, alB, alA, o, qr, K_lds + bc * SHM_K, R_lds + bc * SHM_R, vb0 + bp * (int)SHM_V, r32, hi, [&]() { if (j + 3 < NT) { SWAIT(); SWRITE(bw); if (j + 4 < NT) SLOAD((j + 4) * KVBLK); } });
          RESC(alA);
          bp = bc; bc = BNEXT(bc, 1); }
    }
    dense_step(pB0, pB1, pA0, pA1, m_reg, l_reg, alA, alB, o, qr, K_lds + bc * SHM_K, R_lds + bc * SHM_R, vb0 + bp * (int)SHM_V, r32, hi, []() {});
    RESC(alB);
#undef BNEXT
    { const float mnC = 5.0f - m_reg * (SCALE_D * 1.4426950408889634f);
#pragma unroll
      for (int r = 0; r < 16; ++r) { pB0[r] = __builtin_amdgcn_exp2f(fmaf(pB0[r], SCALE_D * 1.4426950408889634f, mnC)); pB1[r] = fmaf(pB1[r], SCALE_D * 1.4426950408889634f, mnC); } }
    finishSM(pB0, pB1, alB, l_reg, pq); SBAR();
    pv_d4(o, vb0 + bc * (int)SHM_V, pq);
    asm volatile("s_nop 15\n\ts_nop 7" ::: "memory");
    const float rl = 8.0f * __builtin_amdgcn_rcpf(l_reg);
    unsigned char* Oq = (unsigned char*)Ob + (long)(wid * QBLK + r32) * LDO + 4 * hi;
#pragma unroll
    for (int d0 = 0; d0 < 4; ++d0)
#pragma unroll
        for (int g = 0; g < 4; ++g) *(unsigned*)(Oq + d0 * 32 + 8 * g) = pk_fp8x4(o[d0][4 * g] * rl, o[d0][4 * g + 1] * rl, o[d0][4 * g + 2] * rl, o[d0][4 * g + 3] * rl);
#undef SLOAD
#undef SWRITE
#undef SWAIT
#undef RESC
}

constexpr float SCALE_B = 0.125f;

template <bool H0, bool H1>
__device__ __forceinline__ void band_tile(const char* Kc, int vbc, const bf16x8 (&qr)[4], f32x16 (&o)[2], float& m_reg, float& l_reg, float* al_l, int k0, int qw, int qi, int R, int r32, int hi) {
    constexpr float C = SCALE_B * 1.4426950408889634f;
    f32x16 p0 = {}, p1 = {};
#pragma unroll
    for (int d0 = 0; d0 < 4; ++d0) { const int cb = (d0 * 16 + hi * 8) * 2;
        if (H0) { const bf16x8 b0 = *reinterpret_cast<const bf16x8*>(Kc + KSWZ128(r32, cb)); p0 = __builtin_amdgcn_mfma_f32_32x32x16_bf16(b0, qr[d0], p0, 0, 0, 0); }
        if (H1) { const bf16x8 b1 = *reinterpret_cast<const bf16x8*>(Kc + KSWZ128(32 + r32, cb)); p1 = __builtin_amdgcn_mfma_f32_32x32x16_bf16(b1, qr[d0], p1, 0, 0, 0); } }
    const int klo = H0 ? k0 : k0 + 32, khi = H1 ? k0 + 63 : k0 + 31;
    if (!(khi - qw <= R && qw + 31 - klo <= R)) {
        const float NEG = -__builtin_inff();
#pragma unroll
        for (int r = 0; r < 16; ++r) { const int kj = k0 + crow(r, hi);
            if (H0) { int d = qi - kj; d = d < 0 ? -d : d; if (d > R) p0[r] = NEG; }
            if (H1) { int d2 = qi - kj - 32; d2 = d2 < 0 ? -d2 : d2; if (d2 > R) p1[r] = NEG; } } }
    float pmax = H0 ? p0[0] : p1[0];
#pragma unroll
    for (int r = 0; r < 16; ++r) { if (H0) pmax = fmaxf(pmax, p0[r]); if (H1) pmax = fmaxf(pmax, p1[r]); }
    { auto rr = __builtin_amdgcn_permlane32_swap(__float_as_uint(pmax), __float_as_uint(pmax), false, false);
      pmax = fmaxf(__uint_as_float(rr[0]), __uint_as_float(rr[1])); }
    const float mn = fmaxf(m_reg, pmax), alpha = __builtin_amdgcn_exp2f((m_reg - mn) * C); m_reg = mn;
    const float mnC = -mn * C; float ps = 0.f;
#pragma unroll
    for (int r = 0; r < 16; ++r) { if (H0) { p0[r] = __builtin_amdgcn_exp2f(fmaf(p0[r], C, mnC)); ps += p0[r]; } if (H1) { p1[r] = __builtin_amdgcn_exp2f(fmaf(p1[r], C, mnC)); ps += p1[r]; } }
    { auto rr = __builtin_amdgcn_permlane32_swap(__float_as_uint(ps), __float_as_uint(ps), false, false);
      ps = __uint_as_float(rr[0]) + __uint_as_float(rr[1]); }
    l_reg = l_reg * alpha + ps;
    if (__any(alpha < 1.f)) {
        if (hi == 0) al_l[r32] = alpha; asm volatile("s_waitcnt lgkmcnt(0)" ::: "memory");
#pragma unroll
        for (int d = 0; d < 2; ++d)
#pragma unroll
            for (int r = 0; r < 16; ++r) o[d][r] *= al_l[crow(r, hi)]; }
    bf16x8 pa0, pa1, pa2, pa3; p_to_frag(p0, p1, pa0, pa1, pa2, pa3);
    if (H0 && H1) { pv_one<0>(o[0], vbc, pa0, pa1, pa2, pa3); pv_one<1>(o[1], vbc, pa0, pa1, pa2, pa3); }
    else if (H0) { pv_half<0, 0>(o[0], vbc, pa0, pa1); pv_half<1, 0>(o[1], vbc, pa0, pa1); }
    else { pv_half<0, 1>(o[0], vbc, pa2, pa3); pv_half<1, 1>(o[1], vbc, pa2, pa3); }
}
constexpr int BAND_LDS = 2 * 8192 + 2 * 16384 + NWAVES * 64 * 4;
template <bool SINK, bool WLSE>
__device__ __forceinline__ void banded_unit(const bf16_t* __restrict__ Qb, long ldq, const bf16_t* __restrict__ Kb, const bf16_t* __restrict__ Vb, long ldk, bf16_t* __restrict__ Ob, long ldo,
                                            int L, int q0, int R, float sinkv, float* lse, long ldl, char* lds) {
    constexpr float C = SCALE_B * 1.4426950408889634f;
    int tid = threadIdx.x; asm volatile("" : "+v"(tid));
    const int wid = tid >> 6, lane = tid & 63, r32 = lane & 31, hi = lane >> 5;
    char* K_lds = lds; char* V_lds = lds + 2 * 8192; float* al_l = (float*)(lds + 2 * 8192 + 2 * 16384) + wid * 64;
    const int qw = q0 + wid * QBLK;
    bf16x8 qr[4];
    const bf16_t* Qw = Qb + (long)(wid * QBLK + r32) * ldq + hi * 8;
#pragma unroll
    for (int d0 = 0; d0 < 4; ++d0) qr[d0] = *reinterpret_cast<const bf16x8*>(Qw + d0 * 16);
    float m_reg = SINK ? sinkv * (1.0f / SCALE_B) : -1e30f, l_reg = SINK ? 1.f : 0.f; f32x16 o[2] = {};
    const int srow = tid >> 3, scol = (tid & 7) * 8, vst = v_st(srow, scol), kst = KSWZ128(srow, scol * 2);
    const int vb0 = (int)(uintptr_t)V_lds + v_rd_base(lane);
    const int kt0 = (q0 - R > 0 ? q0 - R : 0) / KVBLK, kt1 = (q0 + 256 + R < L ? q0 + 256 + R : L) / KVBLK;
    const int qi = qw + r32;
    const bf16_t* kp = Kb + (long)(kt0 * KVBLK + srow) * ldk + scol; const bf16_t* vp = Vb + (long)(kt0 * KVBLK + srow) * ldk + scol; const long tstep = (long)KVBLK * ldk;
    bf16x8 kreg = *(const bf16x8*)kp, vreg = *(const bf16x8*)vp;
    __syncthreads();
    for (int kt = kt0; kt < kt1; ++kt) {
        const int k0 = kt * KVBLK, bsel = (kt - kt0) & 1;
        char* Kc = K_lds + bsel * 8192; char* Vc = V_lds + bsel * 16384;
        *(bf16x8*)(Kc + kst) = kreg; *(bf16x8*)(Vc + vst) = vreg;
        if (kt + 1 < kt1) { kp += tstep; vp += tstep; kreg = *(const bf16x8*)kp; vreg = *(const bf16x8*)vp; }
        __syncthreads();
        const bool rel0 = (k0 + 31 >= qw - R) && (k0 <= qw + 31 + R), rel1 = (k0 + 63 >= qw - R) && (k0 + 32 <= qw + 31 + R);
        const int vbc = vb0 + bsel * 16384;
        if (rel0 && rel1) band_tile<true, true>(Kc, vbc, qr, o, m_reg, l_reg, al_l, k0, qw, qi, R, r32, hi);
        else if (rel0) band_tile<true, false>(Kc, vbc, qr, o, m_reg, l_reg, al_l, k0, qw, qi, R, r32, hi);
        else if (rel1) band_tile<false, true>(Kc, vbc, qr, o, m_reg, l_reg, al_l, k0, qw, qi, R, r32, hi);
    }
    asm volatile("s_waitcnt lgkmcnt(0)" ::: "memory");
    if (hi == 0) al_l[r32] = l_reg; asm volatile("s_waitcnt lgkmcnt(0)" ::: "memory");
    bf16_t* Ow = Ob + (long)(wid * QBLK) * ldo;
#pragma unroll
    for (int r = 0; r < 16; ++r) { const int orow = crow(r, hi); const float rl = __builtin_amdgcn_rcpf(al_l[orow]);
#pragma unroll
        for (int d0 = 0; d0 < 2; ++d0) { const float v = o[d0][r] * rl; Ow[(long)orow * ldo + d0 * 32 + r32] = (bf16_t)(cvt_pk_bf16(v, v) & 0xffffu); } }
    if (WLSE) { if (hi == 0) lse[(long)(wid * QBLK + r32) * ldl] = m_reg * SCALE_B + __logf(l_reg); }
    asm volatile("s_waitcnt lgkmcnt(0)" ::: "memory");
}

constexpr int B2_ROWS = 384, B2_K = B2_ROWS * 64, B2_V = B2_ROWS * 128, B2_LDS = B2_K + B2_V + NWAVES * 64 * 4;
__device__ __forceinline__ int v_st64(int k, int c) { return ((k >> 3) * 2 + (c >> 5)) * 512 + ((k & 7) * 32 + (c & 31)) * 2; }
struct B2Stage { bf16x8 k[3], v[6]; };
__device__ __forceinline__ void b2_load(B2Stage& st, const unsigned char* __restrict__ Kb, long ldkb  , const bf16_t* __restrict__ Vb, long ldv  , int kb, int nrows, int tid) {
#pragma unroll
    for (int i = 0; i < 6; ++i) { const int id = tid + 512 * i, row = id >> 3, ch = (id & 7) * 8;
        const int rc = row < nrows ? row : nrows - 1;
        st.v[i] = *(const bf16x8*)(Vb + (long)(kb + rc) * ldv + ch); }
#pragma unroll
    for (int i = 0; i < 3; ++i) { const int id = tid + 512 * i, row = id >> 2, cb = (id & 3) * 16;
        const int rc = row < nrows ? row : nrows - 1;
        st.k[i] = *(const bf16x8*)(Kb + (long)(kb + rc) * ldkb + cb); }
}
__device__ __forceinline__ void b2_write(const B2Stage& st, char* lds, int nrows, int tid) {
#pragma unroll
    for (int i = 0; i < 6; ++i) { const int id = tid + 512 * i, row = id >> 3, ch = (id & 7) * 8;
        if (row < nrows) *(bf16x8*)(lds + B2_K + v_st64(row, ch)) = st.v[i]; }
#pragma unroll
    for (int i = 0; i < 3; ++i) { const int id = tid + 512 * i, row = id >> 2, cb = (id & 3) * 16;
        if (row < nrows) *(bf16x8*)(lds + KSWZ64(row, cb)) = st.k[i]; }
}
template <int D0> __device__ __forceinline__ void pv_h(f32x16& od, int vb, bf16x8 pb0, bf16x8 pb1) {
    const s16x4 l0 = tr_read<D0 * 512>(vb), h0 = tr_read<D0 * 512 + 1024>(vb), l1 = tr_read<D0 * 512 + 2048>(vb), h1 = tr_read<D0 * 512 + 3072>(vb);
    asm volatile("s_waitcnt lgkmcnt(0)" ::: "memory"); SBAR();
#define PKV(L, H_) (bf16x8){L[0], L[1], L[2], L[3], H_[0], H_[1], H_[2], H_[3]}
    od = __builtin_amdgcn_mfma_f32_32x32x16_bf16(PKV(l0, h0), pb0, od, 0, 0, 0);
    od = __builtin_amdgcn_mfma_f32_32x32x16_bf16(PKV(l1, h1), pb1, od, 0, 0, 0);
#undef PKV
}
template <bool SINK, bool WLSE, bool OUT8>
__device__ __forceinline__ void b2_task(const i32x8q& qr, bf16_t* __restrict__ Ow, long ldo, float* lsew, long ldl, float sinkv, int qw, int kbase, int L, int R, const char* lds, float* al_l, int lane) {
    constexpr float C = SCALE_B * 1.4426950408889634f;
    const int r32 = lane & 31, hi = lane >> 5, qi = qw + r32;
    float m_reg = SINK ? sinkv * (1.0f / SCALE_B) : -1e30f, l_reg = SINK ? 1.f : 0.f; f32x16 o[2] = {};
    const int vb0 = (int)(uintptr_t)(lds + B2_K) + v_rd_base(lane);
    const int h0 = (qw - R > 0 ? qw - R : 0), h1 = (qw + R + 32 < L ? qw + R + 32 : L);
    for (int k0 = h0; k0 < h1; k0 += 32) { const int r0 = k0 - kbase;
        f32x16 p;
        { const i32x8q kf = g8::cat8(*reinterpret_cast<const bf16x8*>(lds + KSWZ64(r0 + r32, hi * 32)), *reinterpret_cast<const bf16x8*>(lds + KSWZ64(r0 + r32, hi * 32 + 16)));
          asm volatile("v_mfma_f32_32x32x64_f8f6f4 %0, %1, %2, 0\n\ts_nop 15\n\ts_nop 7" : "=&v"(p) : "v"(kf), "v"(qr)); }
        if (k0 < qw - R + 32 || k0 + 31 > qw + R) {
            const float NEG = -__builtin_inff();
#pragma unroll
            for (int r = 0; r < 16; ++r) { int d = qi - (k0 + crow(r, hi)); d = d < 0 ? -d : d; if (d > R) p[r] = NEG; } }
        float pmax = p[0];
#pragma unroll
        for (int r = 1; r < 16; ++r) pmax = fmaxf(pmax, p[r]);
        { auto rr = __builtin_amdgcn_permlane32_swap(__float_as_uint(pmax), __float_as_uint(pmax), false, false); pmax = fmaxf(__uint_as_float(rr[0]), __uint_as_float(rr[1])); }
        const float mn = fmaxf(m_reg, pmax), alpha = __builtin_amdgcn_exp2f((m_reg - mn) * C); m_reg = mn;
        const float mnC = -mn * C; float ps = 0.f;
#pragma unroll
        for (int r = 0; r < 16; ++r) { p[r] = __builtin_amdgcn_exp2f(fmaf(p[r], C, mnC)); ps += p[r]; }
        { auto rr = __builtin_amdgcn_permlane32_swap(__float_as_uint(ps), __float_as_uint(ps), false, false); ps = __uint_as_float(rr[0]) + __uint_as_float(rr[1]); }
        l_reg = l_reg * alpha + ps;
#pragma unroll
        for (int d = 0; d < 2; ++d)
#pragma unroll
            for (int r = 0; r < 16; ++r) o[d][r] *= alpha;
        u32x4 w0 = {cvt2(p[0], p[1]), cvt2(p[2], p[3]), cvt2(p[4], p[5]), cvt2(p[6], p[7])}, w1 = {cvt2(p[8], p[9]), cvt2(p[10], p[11]), cvt2(p[12], p[13]), cvt2(p[14], p[15])};
        const bf16x8 pb0 = *reinterpret_cast<bf16x8*>(&w0), pb1 = *reinterpret_cast<bf16x8*>(&w1);
        const int vbc = vb0 + r0 * 128;
        pv_h<0>(o[0], vbc, pb0, pb1); pv_h<1>(o[1], vbc, pb0, pb1);
    }
    const float rl = (OUT8 ? 8.0f : 1.0f) * __builtin_amdgcn_rcpf(l_reg);
    if constexpr (OUT8) { unsigned char* Oq = (unsigned char*)Ow + (long)r32 * ldo + 4 * hi;
#pragma unroll
        for (int d0 = 0; d0 < 2; ++d0)
#pragma unroll
            for (int g = 0; g < 4; ++g) *(unsigned*)(Oq + d0 * 32 + 8 * g) = pk_fp8x4(o[d0][4 * g] * rl, o[d0][4 * g + 1] * rl, o[d0][4 * g + 2] * rl, o[d0][4 * g + 3] * rl); }
    else { bf16_t* Oq = Ow + (long)r32 * ldo + 4 * hi;
#pragma unroll
        for (int d0 = 0; d0 < 2; ++d0)
#pragma unroll
            for (int g = 0; g < 4; ++g) { u32x2 w; w.x = cvt2(o[d0][4 * g] * rl, o[d0][4 * g + 1] * rl); w.y = cvt2(o[d0][4 * g + 2] * rl, o[d0][4 * g + 3] * rl); *(u32x2*)(Oq + d0 * 32 + 8 * g) = w; } }
    if (WLSE) { if (hi == 0) lsew[(long)r32 * ldl] = m_reg * SCALE_B + __logf(l_reg); }
}
}

__device__ __forceinline__ void norm_row_store(const f32x4 (&v)[4], const float* g, const float* sh, const float* sc, bf16_t* hrow, int lane, bool fp8 = false) {
    float ss = 0.f;
#pragma unroll
    for (int j = 0; j < 4; ++j) ss += (v[j][0] * v[j][0] + v[j][1] * v[j][1]) + (v[j][2] * v[j][2] + v[j][3] * v[j][3]);
    const float rstd = 1.0f / sqrtf(wave_sum(ss) * (1.0f / 1024.0f) + EPS);
#pragma unroll
    for (int j = 0; j < 4; ++j) { const int c = 4 * lane + 256 * j;
        const f32x4 gv = *(const f32x4*)(g + c), shv = *(const f32x4*)(sh + c), scv = *(const f32x4*)(sc + c);
        const f32x4 y = v[j] * rstd * gv * (scv + 1.0f) + shv;
        if (fp8) *(unsigned*)((unsigned char*)hrow + c) = (unsigned)__builtin_amdgcn_cvt_pk_fp8_f32(y[2], y[3], __builtin_amdgcn_cvt_pk_fp8_f32(y[0], y[1], 0, false), true);
        else { u32x2 w; w.x = cvt_pk_bf16(y[0], y[1]); w.y = cvt_pk_bf16(y[2], y[3]); *(u32x2*)(hrow + c) = w; } }
}

__device__ __forceinline__ void conv_item(const float* __restrict__ W, int ldw, int K, int src0, int k0, bf16_t* __restrict__ Wt, int pos0, const float* kscale, LAS float* scr, int lane) {
#pragma unroll 8
    for (int i = 0; i < 32; ++i) { const int kk = 2 * i + (lane >> 5); float v = 0.f;
        if (src0 >= 0) { v = W[(size_t)(k0 + kk) * ldw + src0 + (lane & 31)]; if (kscale) v *= kscale[k0 + kk]; }
        scr[kk * 33 + (lane & 31)] = v; }
    LDS_WAIT(); asm volatile("" ::: "memory");
    const int c = lane & 7;
#pragma unroll
    for (int j = 0; j < 4; ++j) { const int n = (lane >> 3) + 8 * j; const LAS float* s = scr + (8 * c) * 33 + n;
        u32x4 o; o.x = cvt_pk_bf16(s[0 * 33], s[1 * 33]); o.y = cvt_pk_bf16(s[2 * 33], s[3 * 33]); o.z = cvt_pk_bf16(s[4 * 33], s[5 * 33]); o.w = cvt_pk_bf16(s[6 * 33], s[7 * 33]);
        *(u32x4*)(Wt + (size_t)(pos0 + n) * K + k0 + 8 * c) = o; }
    LDS_WAIT(); asm volatile("" ::: "memory");
}
__device__ __forceinline__ int src_inab(int pg) { const int pn = pg >> 3, bj = (pg >> 2) & 1, w = pg & 3;
    if (pn < 4) return 704 + (4 * pn + w) * 64 + 32 * bj;
    if (pn == 4) return w < 2 ? 1728 + w * 64 + 32 * bj : (w == 2 ? 640 + 32 * bj : -1);
    if (pn == 5) return 128 * bj + 32 * w;
    if (pn == 6) return bj == 0 ? 256 + 32 * w : 1856 + 32 * w;
    return 384 + 128 * bj + 32 * w; }
__device__ __forceinline__ int src_qb(int pg) { const int pn = pg >> 3, bj = (pg >> 2) & 1, w = pg & 3;
    if (pn < 2) return (4 * pn + w) * 192 + 128 + 32 * bj;
    return (2 * (pn - 2) + bj) * 192 + 32 * w; }
__device__ __forceinline__ int src_inc(int pg) { const int pn = pg >> 3, bj = (pg >> 2) & 1, w = pg & 3, gs = pn >> 2;
    if (gs % 3 < 2) return gs * 1024 + (4 * (pn & 3) + w) * 64 + 32 * bj;
    return pg * 32; }
__device__ __forceinline__ int src_gu(int pg) { const int pn = pg >> 3, bj = (pg >> 2) & 1, w = pg & 3; return 1024 * bj + 128 * pn + 32 * w; }

struct MapIdent { __device__ __forceinline__ int operator()(int pg) const { return pg * 32; } __device__ __forceinline__ int at(int nb, int pg4) const { return nb * 32 + pg4 * 4; } __device__ __forceinline__ int pos(int nb, int pg4) const { return nb * 32 + pg4 * 4; } };
struct MapDownPerm { __device__ __forceinline__ int operator()(int pg) const { return pg * 32; }
    __device__ __forceinline__ int pos(int nb, int pg4) const { const int tile = nb >> 3, wc = (nb >> 1) & 3, h = nb & 1; return tile * 256 + 128 * (pg4 >> 2) + 32 * wc + 16 * h + 4 * (pg4 & 3); }
    __device__ __forceinline__ int at(int nb, int pg4) const { const int tile = nb >> 3, wc = (nb >> 1) & 3, h = nb & 1, p = pg4 & 3; return tile * 256 + 64 * wc + 32 * h + 16 * (p >> 1) + 8 * (pg4 >> 2) + 4 * (p & 1); } };
struct MapInAB  { __device__ __forceinline__ int operator()(int pg) const { return src_inab(pg); }  __device__ __forceinline__ int at(int nb, int pg4) const { return (*this)(nb) + pg4 * 4; } __device__ __forceinline__ int pos(int nb, int pg4) const { return nb * 32 + pg4 * 4; } };
struct MapQB    { __device__ __forceinline__ int operator()(int pg) const { return src_qb(pg); } };
struct MapInC   { __device__ __forceinline__ int operator()(int pg) const { return src_inc(pg); }  __device__ __forceinline__ int at(int nb, int pg4) const { return (*this)(nb) + pg4 * 4; } __device__ __forceinline__ int pos(int nb, int pg4) const { return nb * 32 + pg4 * 4; } };
struct MapGU    { __device__ __forceinline__ int operator()(int pg) const { return src_gu(pg); }  __device__ __forceinline__ int at(int nb, int pg4) const { return (*this)(nb) + pg4 * 4; } __device__ __forceinline__ int pos(int nb, int pg4) const { return nb * 32 + pg4 * 4; } };
template <class Map>
__device__ __forceinline__ void conv_group(const float* W, size_t mat_stride, int ldw, int K, int npos, bf16_t* Wt, const float* kscale, int kscale_stride, int nmat, Map map, LAS float* scr, int gw, int NGW, int lane, int woff = 0) {
    const int npg = npos / 32, per = (K / 64) * npg, total = per * nmat;
    for (int it = (gw + NGW - woff % NGW) % NGW; it < total; it += NGW) { const int mat = it / per, r = it - mat * per, kb = r / npg, pg = r - kb * npg;
        conv_item(W + (size_t)mat * mat_stride, ldw, K, map(pg), kb * 64, Wt + (size_t)mat * npos * K, pg * 32, kscale ? kscale + (size_t)mat * kscale_stride : nullptr, scr, lane); }
}


typedef const __attribute__((address_space(4))) Params* KParams;
#define WSL() KParams kp = (KParams)__builtin_amdgcn_kernarg_segment_ptr(); asm volatile("" : "+s"(kp)); unsigned char* wsl = kp->ws; \
    const int tid = tid_now(wave_s_); int vcl = vcu, bxl = bx; asm volatile("" : "+s"(vcl), "+s"(bxl)); const int lane = tid & 63, wave = __builtin_amdgcn_readfirstlane(tid >> 6), gw = vcl * NWAVES + wave; (void)lane; (void)gw
#define MOD ((float*)(wsl + WS_MOD))
#define COS ((float*)(wsl + WS_COS))
#define SIN ((float*)(wsl + WS_SIN))
#define WROUT ((bf16_t*)(wsl + WS_WROUT))
#define WINAB ((bf16_t*)(wsl + WS_WINAB))
#define WQB ((bf16_t*)(wsl + WS_WQB))
#define WKVB ((bf16_t*)(wsl + WS_WKVB))
#define WOUTAB ((bf16_t*)(wsl + WS_WOUTAB))
#define WINC ((bf16_t*)(wsl + WS_WINC))
#define WOUTC ((bf16_t*)(wsl + WS_WOUTC))
#define WGU ((bf16_t*)(wsl + WS_WGU))
#define WDOWN ((bf16_t*)(wsl + WS_WDOWN))
#define X ((float*)(wsl + WS_X))
#define H ((bf16_t*)(wsl + WS_H))
#define QB ((bf16_t*)(wsl + WS_QB))
#define KB ((bf16_t*)(wsl + WS_KB))
#define VB ((bf16_t*)(wsl + WS_VB))
#define KR ((bf16_t*)(wsl + WS_KR))
#define CQ ((bf16_t*)(wsl + WS_CQ))
#define CKV ((bf16_t*)(wsl + WS_CKV))
#define SSQ ((float*)(wsl + WS_SSQ))
#define QA ((bf16_t*)(wsl + WS_QA))
#define V8P ((unsigned char*)(wsl + WS_QA + 48 * MiB))
#define KV ((bf16_t*)(wsl + WS_KV))
#define OB ((bf16_t*)(wsl + WS_O))
#define PC ((bf16_t*)(wsl + WS_PC))
#define OG ((bf16_t*)(wsl + WS_OG))
#define LSE ((float*)(wsl + WS_LSE))
#define OC ((bf16_t*)(wsl + WS_OC))
#define LIST ((int*)(wsl + WS_LIST))
#define TOKE ((int*)(wsl + WS_TOKE))
#define GATE ((float*)(wsl + WS_GATE))
#define ACT ((unsigned char*)(wsl + WS_ACT))
#define H8 ((unsigned char*)(wsl + WS_H8))
#define YB ((bf16_t*)(wsl + WS_YB))

template <class Map>
__device__ __forceinline__ void conv2_group(const float* __restrict__ W, size_t mat_stride, int ldw, int K, int npos, bf16_t* __restrict__ Wt, const float* kscale, int kscale_stride, int nmat, Map map, int gw, int NGW, int lane, int woff = 0) {
    const int npb = npos / 256, per = (K / 64) * npb, total = per * nmat;
    for (int it = (gw + NGW - woff % NGW) % NGW; it < total; it += NGW) { const int mat = it / per, r = it - mat * per, kblk = r / npb, nb = r - kblk * npb;
        const int pos = nb * 256 + lane * 4; const int sg = map(pos >> 5); const int src = sg + (pos & 31);
        const float* wp = W + (size_t)mat * mat_stride + (size_t)(kblk * 64) * ldw + (sg < 0 ? 0 : src);
        const float* ks = kscale ? kscale + (size_t)mat * kscale_stride + kblk * 64 : nullptr;
        bf16_t* op = Wt + ((size_t)mat * npos + pos) * K + kblk * 64;
#pragma unroll 2
        for (int s8 = 0; s8 < 8; ++s8) { f32x4 v[8];
#pragma unroll
            for (int j = 0; j < 8; ++j) { v[j] = *(const f32x4*)(wp + (size_t)(s8 * 8 + j) * ldw); if (ks) v[j] = v[j] * ks[s8 * 8 + j]; }
            if (sg < 0) {
#pragma unroll
                for (int j = 0; j < 8; ++j) v[j] = (f32x4){0.f, 0.f, 0.f, 0.f}; }
#pragma unroll
            for (int i = 0; i < 4; ++i) { u32x4 o; o.x = cvt_pk_bf16(v[0][i], v[1][i]); o.y = cvt_pk_bf16(v[2][i], v[3][i]); o.z = cvt_pk_bf16(v[4][i], v[5][i]); o.w = cvt_pk_bf16(v[6][i], v[7][i]);
                *(u32x4*)(op + (size_t)i * K + s8 * 8) = o; } } }
}

__device__ __forceinline__ void conv8_load(f32x4 (&v)[16], const float* wp, int ldw) {
#pragma unroll
    for (int j = 0; j < 16; ++j) v[j] = __builtin_nontemporal_load((const f32x4*)(wp + (size_t)j * ldw));
}
__device__ __forceinline__ void conv8_store(const f32x4 (&v)[16], unsigned char* op, int K, float scale) {
#pragma unroll
    for (int i = 0; i < 4; ++i) { u32x4 o;
        o.x = (unsigned)__builtin_amdgcn_cvt_pk_fp8_f32(v[2][i] * scale, v[3][i] * scale, __builtin_amdgcn_cvt_pk_fp8_f32(v[0][i] * scale, v[1][i] * scale, 0, false), true);
        o.y = (unsigned)__builtin_amdgcn_cvt_pk_fp8_f32(v[6][i] * scale, v[7][i] * scale, __builtin_amdgcn_cvt_pk_fp8_f32(v[4][i] * scale, v[5][i] * scale, 0, false), true);
        o.z = (unsigned)__builtin_amdgcn_cvt_pk_fp8_f32(v[10][i] * scale, v[11][i] * scale, __builtin_amdgcn_cvt_pk_fp8_f32(v[8][i] * scale, v[9][i] * scale, 0, false), true);
        o.w = (unsigned)__builtin_amdgcn_cvt_pk_fp8_f32(v[14][i] * scale, v[15][i] * scale, __builtin_amdgcn_cvt_pk_fp8_f32(v[12][i] * scale, v[13][i] * scale, 0, false), true);
        *(u32x4*)(op + (size_t)i * K) = o; }
}
template <class Map>
__device__ __forceinline__ void conv8_group(const float* __restrict__ W, size_t mat_stride, int ldw, int K, int npos, unsigned char* __restrict__ Wt, float scale, int nmat, Map map, int gw, int NGW, int lane, int woff = 0) {
    const int npb = npos / 32, per = (K / 128) * npb, total = per * nmat; const int kq = lane >> 3, pg = lane & 7;
#define C8_GEO(it_, wp_, op_, scl_) const int mat_##wp_ = (it_) / per, r_##wp_ = (it_) - mat_##wp_ * per, kblk_##wp_ = r_##wp_ / npb, nb_##wp_ = r_##wp_ - kblk_##wp_ * npb; const int sg_##wp_ = map(nb_##wp_); \
        const float scl_ = sg_##wp_ < 0 ? 0.f : scale; const float* wp_ = W + (size_t)mat_##wp_ * mat_stride + (size_t)(kblk_##wp_ * 128 + kq * 16) * ldw + (sg_##wp_ < 0 ? pg * 4 : map.at(nb_##wp_, pg)); \
        unsigned char* op_ = Wt + ((size_t)mat_##wp_ * npos + map.pos(nb_##wp_, pg)) * K + kblk_##wp_ * 128 + kq * 16
    f32x4 va[16], vb[16];
    int it = (gw + NGW - woff % NGW) % NGW;
    if (it < total) { C8_GEO(it, wp0, op0, sc0); (void)op0; (void)sc0; conv8_load(va, wp0, ldw); }
    for (; it < total; it += 2 * NGW) {
        const bool hb = it + NGW < total, ha = it + 2 * NGW < total;
        if (hb) { C8_GEO(it + NGW, wp1, op1, sc1); (void)op1; (void)sc1; conv8_load(vb, wp1, ldw); }
        { C8_GEO(it, wp2, op2, sc2); (void)wp2; conv8_store(va, op2, K, sc2); }
        if (ha) { C8_GEO(it + 2 * NGW, wp3, op3, sc3); (void)op3; (void)sc3; conv8_load(va, wp3, ldw); }
        if (hb) { C8_GEO(it + NGW, wp4, op4, sc4); (void)wp4; conv8_store(vb, op4, K, sc4); } }
#undef C8_GEO
}
#ifndef INC_FP8
#define INC_FP8 3
#endif
#ifndef STAG
#define STAG 0
#endif
constexpr int NPH = 2 + 9 * DEPTH;
__host__ __device__ constexpr bool phase_empty(int k) { return k >= 2 && ((((k - 2) / 9) % 2 == 0 && (k - 2) % 9 == 3) || (((k - 2) / 9) % 2 == 1 && (k - 2) % 9 == 1)); }

__global__ void __launch_bounds__(NTHR, 2) fwd_kernel(Params p) {
    extern __shared__ __attribute__((aligned(16))) unsigned char lds_raw[];
    LAS unsigned char* lds = (LAS unsigned char*)lds_raw;
    const int G = gridDim.x, bx = blockIdx.x, vcu = (G % 8 == 0) ? (bx % 8) * (G / 8) + bx / 8 : bx;
    const int NGW = G * NWAVES;
    unsigned* const ctl = (unsigned*)(p.ws + WS_CTL);
    int wave_s_ = __builtin_amdgcn_readfirstlane(threadIdx.x >> 6);
    if (threadIdx.x < 32) ((LAS unsigned*)(lds + MISC_OFF))[threadIdx.x] = 0u;
    __syncthreads();
    XcdBarrier bar; bar.bar = ctl + CW_BAR; bar.x = 0; bar.st = nullptr;
    const int lo = p.ph_lo, hi = p.ph_hi;
    if (hi - lo > 1) bar = xcd_barrier_post(ctl + CW_BAR, (volatile LAS unsigned*)(lds + MISC_OFF));
#ifndef PHMASK
#define PHMASK 0xFFFFFFFFu
#endif
#define ON(id) (((PHMASK) >> (id)) & 1u)
#ifndef REPMASK
#define REPMASK 0u
#endif
#define DSH(id) ((size_t)((((REPMASK) >> (id)) & 1u) && rep_ == 0 ? 1600 : 0) * MiB)
#define REP(id) for (int rep_ = 0; rep_ < ((((REPMASK) >> (id)) & 1u) ? 2 : 1); ++rep_)
#define IN(k) (lo <= (k) && (k) < hi)
#define SEAM(k) do { if (hi > (k) + 1) { xcd_barrier(bar, wave_s_); if ((REPMASK >> 23) & 1u) xcd_barrier(bar, wave_s_); } } while (0)

    if (ON(0) && IN(0)) { WSL(); {
        REP(16) {
            LAS float* cact = (LAS float*)lds; LAS float* part = (LAS float*)(lds + 32768);
            for (int i = 0; i < 16; ++i) { const int idx = tid + 512 * i, b = idx >> 10, k = idx & 1023; const float cv = kp->c[idx]; cact[k * 8 + b] = cv / (1.0f + __expf(-cv)); }
            __syncthreads();
            for (int u = bx; u < 4 * 96; u += G) { const int layer = u / 96, n0 = (u % 96) * 64;
                float a0 = 0, a1 = 0, a2 = 0, a3 = 0, a4 = 0, a5 = 0, a6 = 0, a7 = 0;
                const float* wp = kp->w_mod + ((size_t)layer * 1024 + wave * 128) * 6144 + n0 + lane;
#pragma unroll 4
                for (int kk = 0; kk < 128; ++kk) { const float w = wp[(size_t)kk * 6144]; const LAS f32x4* cp = (const LAS f32x4*)(cact + (wave * 128 + kk) * 8); const f32x4 ca = cp[0], cb = cp[1];
                    a0 += ca[0] * w; a1 += ca[1] * w; a2 += ca[2] * w; a3 += ca[3] * w; a4 += cb[0] * w; a5 += cb[1] * w; a6 += cb[2] * w; a7 += cb[3] * w; }
                LAS float* pp = part + wave * 512 + lane;
                pp[0] = a0; pp[64] = a1; pp[128] = a2; pp[192] = a3; pp[256] = a4; pp[320] = a5; pp[384] = a6; pp[448] = a7;
                __syncthreads();
                { const int b = tid >> 6; float s = kp->b_mod[(size_t)layer * 6144 + n0 + lane];
#pragma unroll
                  for (int w = 0; w < 8; ++w) s += part[w * 512 + b * 64 + lane];
                  MOD[((size_t)layer * 8 + b) * 6144 + n0 + lane] = s; }
                __syncthreads(); }
        }
        REP(17) for (int idx = bx * NTHR + tid; idx < T * 4; idx += G * NTHR) { const int t = idx >> 2, fq_ = idx & 3; const float pos = (float)kp->positions[t];
            float cs[8], sn[8];
#pragma unroll
            for (int e = 0; e < 8; ++e) { const float inv = powf(10000.0f, -(float)(8 * fq_ + e) * (1.0f / 32.0f)); const float ang = pos * inv; cs[e] = cosf(ang); sn[e] = sinf(ang); }
            u32x4 cw = {cvt_pk_bf16(cs[0], cs[1]), cvt_pk_bf16(cs[2], cs[3]), cvt_pk_bf16(cs[4], cs[5]), cvt_pk_bf16(cs[6], cs[7])}, sw = {cvt_pk_bf16(sn[0], sn[1]), cvt_pk_bf16(sn[2], sn[3]), cvt_pk_bf16(sn[4], sn[5]), cvt_pk_bf16(sn[6], sn[7])};
            *(u32x4*)((unsigned char*)COS + (size_t)idx * 32) = cw; *(u32x4*)((unsigned char*)COS + (size_t)idx * 32 + 16) = sw; }
        __syncthreads();
        LAS float* scr = (LAS float*)(lds + wave * 8448);
        REP(19) conv_group(kp->w_router, (size_t)1024 * 32, 32, 1024, 32, WROUT, nullptr, 0, 4, MapIdent(), scr, gw, NGW, lane, 0);
        conv8_group(kp->w_in_ab, (size_t)1024 * 1984, 1984, 1024, 2048, (unsigned char*)WINAB, 32.0f, 2, MapInAB(), gw, NGW, lane, 64);
        REP(19) conv2_group(kp->mla_w_qb, (size_t)384 * 1536, 1536, 384, 1536, WQB, kp->mla_g_q, 384, 2, MapQB(), gw, NGW, lane, 192);
        REP(19) conv2_group(kp->mla_w_kvb, (size_t)256 * 2048, 2048, 256, 2048, WKVB, kp->mla_g_kv, 256, 2, MapIdent(), gw, NGW, lane, 400);
        conv8_group(kp->w_out_ab, (size_t)2048 * 1024, 1024, 2048, 1024, (unsigned char*)WOUTAB, 32.0f, 2, MapIdent(), gw, NGW, lane, 464);
        conv8_group(kp->w_in_c, (size_t)1024 * 9216, 9216, 1024, 9216, (unsigned char*)WINC, 32.0f, 2, MapInC(), gw, NGW, lane, 592);
        conv8_group(kp->w_out_c, (size_t)1024 * 1024, 1024, 1024, 1024, (unsigned char*)WOUTC, 32.0f, 2, MapIdent(), gw, NGW, lane, 1168);
        REP(18) conv8_group(kp->w_gu, (size_t)1024 * 2048, 2048, 1024, 2048, (unsigned char*)WGU, 32.0f, 128, MapGU(), gw, NGW, lane);
        REP(18) conv8_group(kp->w_down, (size_t)1024 * 1024, 1024, 1024, 1024, (unsigned char*)WDOWN, 32.0f, 128, MapDownPerm(), gw, NGW, lane);
        __syncthreads(); }
        SEAM(0);
    }
    if (ON(1) && IN(1)) { WSL();
        REP(1) {
            const int chunk = (T + NGW - 1) / NGW, tb = gw * chunk, te = tb + chunk < T ? tb + chunk : T;
#define P1C(j) (8 * lane + 512 * ((j) >> 1) + 4 * ((j) & 1))
            f32x4 gnv[4], shv[4], scv[4], xa[4], xb[4]; int cur_b = -1;
#pragma unroll
            for (int j = 0; j < 4; ++j) { gnv[j] = *(const f32x4*)(kp->g_norm_mix + P1C(j)); shv[j] = gnv[j]; scv[j] = gnv[j]; xa[j] = gnv[j]; xb[j] = gnv[j]; }
            if (tb < te) { const int t1 = tb + 1 < te ? tb + 1 : tb;
#pragma unroll
                for (int j = 0; j < 4; ++j) { xa[j] = *(const f32x4*)(kp->x + (size_t)tb * 1024 + P1C(j)); xb[j] = *(const f32x4*)(kp->x + (size_t)t1 * 1024 + P1C(j)); } }
            for (int t = tb; t < te; t += 2) { const int t1 = t + 1 < te ? t + 1 : t;
                f32x4 va[4], vb[4];
#pragma unroll
                for (int j = 0; j < 4; ++j) { va[j] = xa[j]; vb[j] = xb[j]; }
                { const int tn = t + 2 < te ? t + 2 : t, tn1 = t + 3 < te ? t + 3 : tn;
#pragma unroll
                  for (int j = 0; j < 4; ++j) { xa[j] = *(const f32x4*)(kp->x + (size_t)tn * 1024 + P1C(j)); xb[j] = *(const f32x4*)(kp->x + (size_t)tn1 * 1024 + P1C(j)); } }
#pragma unroll
                for (int q = 0; q < 2; ++q) { const int tq = q ? t1 : t, b = tq >> 12;
                    if (q == 1 && t + 1 >= te) break;
                    if (b != cur_b) { cur_b = b; const float* sh = MOD + (size_t)b * 6144;
#pragma unroll
                        for (int j = 0; j < 4; ++j) { shv[j] = *(const f32x4*)(sh + P1C(j)); scv[j] = *(const f32x4*)(sh + 1024 + P1C(j)) + 1.0f; } }
                    float ss = 0.f; f32x4 v[4];
#pragma unroll
                    for (int j = 0; j < 4; ++j) { v[j] = q ? vb[j] : va[j]; ss += (v[j][0] * v[j][0] + v[j][1] * v[j][1]) + (v[j][2] * v[j][2] + v[j][3] * v[j][3]); }
                    const float rstd = 1.0f / sqrtf(wave_sum(ss) * (1.0f / 1024.0f) + EPS);
                    unsigned w8[4];
#pragma unroll
                    for (int j = 0; j < 4; ++j) { const f32x4 y = v[j] * rstd * gnv[j] * scv[j] + shv[j]; w8[j] = pk_fp8x4(y[0], y[1], y[2], y[3]); }
#pragma unroll
                    for (int j = 0; j < 2; ++j) { u32x2 w; w.x = w8[2 * j]; w.y = w8[2 * j + 1]; *(u32x2*)((unsigned char*)H + (size_t)tq * 1024 + 8 * lane + 512 * j) = w;
                        const u32x4 xw = {cvt_pk_bf16(v[2 * j][0], v[2 * j][1]), cvt_pk_bf16(v[2 * j][2], v[2 * j][3]), cvt_pk_bf16(v[2 * j + 1][0], v[2 * j + 1][1]), cvt_pk_bf16(v[2 * j + 1][2], v[2 * j + 1][3])};
                        *(u32x4*)((unsigned char*)X + (size_t)tq * 2048 + (8 * lane + 512 * j) * 2) = xw; } } }
#undef P1C
        }
        SEAM(1);
    }

    for (int layer = 0; layer < DEPTH; ++layer) {
        const int pb = 2 + 9 * layer, li = layer >> 1; const bool even = (layer & 1) == 0;
        if (IN(pb + 0)) { WSL();
            if (ON(2) && even) REP(2) { g8::DenseSched S; S.init(H, (const unsigned char*)WINAB + (size_t)li * 2048 * 1024, 512, T, 2048, G, bxl);
                EpiInAB E{QB, KB, VB, KR, CQ, CKV, SSQ, COS, SIN, 1.0f / 32.0f};
                g8::gemm_phase<EpiInAB, g8::DenseSched, true, true>(lds, 512, S, E, wave_s_, (vcl & 31) * STAG); }
            else if (ON(3) && !even) REP(3) { g8::DenseSched S; S.init(H, (const unsigned char*)WINC + (size_t)li * 9216 * 1024, 512, T, 9216, G, bxl);
                EpiInC E{PC, COS, SIN, 1.0f / 32.0f};
                g8::gemm_phase<EpiInC, g8::DenseSched, true, true>(lds, 512, S, E, wave_s_, (vcl & 31) * STAG); }
            SEAM(pb + 0);
        }
        if (ON(4) && IN(pb + 1) && even) { WSL();
            if (ON(14)) REP(4) { g8::DenseSched S; S.init(CQ, WQB + (size_t)li * 1536 * 384, 384, T, 1536, G, bxl); EpiQUp E{(unsigned char*)QA, SSQ, COS, SIN};
              g8::gemm_phase<EpiQUp, g8::DenseSched, true>(lds, 384, S, E, wave_s_, (vcl & 31) * STAG); }
            if (ON(15)) REP(4) { g8::DenseSched S; S.init(CKV, WKVB + (size_t)li * 2048 * 256, 256, T, 2048, G, bxl); EpiKVUp E{KV, V8P, SSQ};
              g8::gemm_phase<EpiKVUp, g8::DenseSched, true>(lds, 256, S, E, wave_s_); }
            SEAM(pb + 1);
        }
        if (IN(pb + 2)) { WSL();
            if (even) {
                if (ON(5)) REP(5) for (int i = 0;; ++i) { const int u = i * G + vcl; if (u >= NBATCH * 8 * 16) break; const int qb = u & 15, h = (u >> 4) & 7, b = u >> 7;
                    const size_t r0 = (size_t)b * SEQ;
                    att::dense_unit((const unsigned char*)QA + (r0 + qb * 256) * 1536 + h * 192, (const unsigned char*)KV + r0 * 4096 + h * 512, V8P + (r0 >> 1) * 2048 + h * 256, (const unsigned char*)KR + r0 * 64, (bf16_t*)((unsigned char*)OB + (r0 + qb * 256) * 2048 + h * 128), SEQ, (char*)lds_raw, wave_s_); }
                if (ON(6)) REP(6) {
                    const int tid = tid_now(wave_s_);
                    att::B2Stage st = {}; const int lane_ = tid & 63, wv = tid >> 6; float* al_l = (float*)((char*)lds_raw + att::B2_K + att::B2_V) + wv * 64;
                    int u = vcl; bool have = u < NBATCH * 2 * 32;
#define SWA_GEO(uu, b_, kvh_, q0_, kb_, nr_) const int b_ = (uu) >> 6, kvh_ = ((uu) >> 5) & 1, q0_ = ((uu) & 31) * 128, kb_ = q0_ - 128 > 0 ? q0_ - 128 : 0, nr_ = (q0_ + 256 < SEQ ? q0_ + 256 : SEQ) - kb_
                    if (have) { SWA_GEO(u, b, kvh, q0, kb, nr); (void)q0; att::b2_load(st, (const unsigned char*)KB + (size_t)b * SEQ * 128 + kvh * 64, 128, VB + (size_t)b * SEQ * 128 + kvh * 64, 128, kb, nr, tid); }
                    while (have) { SWA_GEO(u, b, kvh, q0, kb, nr);
                        __syncthreads(); att::b2_write(st, (char*)lds_raw, nr, tid);
                        const int un = u + G; const bool hn = un < NBATCH * 2 * 32;
                        if (hn) { SWA_GEO(un, b2, kvh2, q02, kb2, nr2); (void)q02; att::b2_load(st, (const unsigned char*)KB + (size_t)b2 * SEQ * 128 + kvh2 * 64, 128, VB + (size_t)b2 * SEQ * 128 + kvh2 * 64, 128, kb2, nr2, tid); }
                        __syncthreads();
                        const int hq = kvh * 8 + wv; const size_t r0 = (size_t)b * SEQ; const float sinkv = kp->swa_sink[li * 16 + hq];
                        for (int j = 0; j < 4; ++j) { const int qw = q0 + 32 * j;
                            const unsigned char* Qw = (const unsigned char*)QB + (r0 + qw + (lane_ & 31)) * 1024 + hq * 64 + (lane_ >> 5) * 32;
                            const att::i32x8q qr = g8::cat8(*reinterpret_cast<const bf16x8*>(Qw), *reinterpret_cast<const bf16x8*>(Qw + 16));
                            att::b2_task<true, false, true>(qr, (bf16_t*)((unsigned char*)OB + (r0 + qw) * 2048 + 1024 + hq * 64), 2048, nullptr, 0, sinkv, qw, kb, SEQ, 128, (const char*)lds_raw, al_l, lane_); }
                        u = un; have = hn; }
#undef SWA_GEO
                }
            } else {
                if (ON(7)) REP(7) {
                    att::B2Stage st = {}; const int lane_ = tid & 63, wv = tid >> 6; float* al_l = (float*)((char*)lds_raw + att::B2_K + att::B2_V) + wv * 64;
                    int u = vcl; bool have = u < 3 * 2048; att::i32x8q qn = {};
#define PCB(b_, gs_, head_) ((unsigned char*)PC + (size_t)(((b_) * 9 + (gs_)) * 16 + (head_)) * (4096 * 128))
#define DIL_QLOAD(dst, g_, head_, dil_, q0_, s0_) do { const unsigned char* Qw_ = PCB(bb_##g_, g_ * 3 + 0, head_) + ((size_t)rr_##g_ * (SEQ / dil_) + q0_ + 32 * wv + (lane_ & 31)) * 64 + (lane_ >> 5) * 32; \
        dst = g8::cat8(*reinterpret_cast<const bf16x8*>(Qw_), *reinterpret_cast<const bf16x8*>(Qw_ + 16)); } while (0)
#define DIL_GEO(uu, g_, head_, dil_, L_, q0_, s0_, kb_, nr_) const int g_ = (uu) >> 11, rem_##g_ = (uu) & 2047, head_ = rem_##g_ & 15, rest_##g_ = rem_##g_ >> 4, dil_ = g_ == 0 ? 1 : (g_ == 1 ? 4 : 16), L_ = SEQ / dil_, nqb_##g_ = L_ / 256, \
        q0_ = (rest_##g_ % nqb_##g_) * 256, seqi_##g_ = rest_##g_ / nqb_##g_, bb_##g_ = seqi_##g_ / dil_, rr_##g_ = seqi_##g_ % dil_; const size_t s0_ = (size_t)bb_##g_ * SEQ + rr_##g_; const int kb_ = q0_ - 64 > 0 ? q0_ - 64 : 0, nr_ = (q0_ + 320 < L_ ? q0_ + 320 : L_) - kb_
                    if (have) { DIL_GEO(u, g, head, dil, L, q0, s0, kb, nr); DIL_QLOAD(qn, g, head, dil, q0, s0); att::b2_load(st, PCB(bb_g, g * 3 + 1, head) + (size_t)rr_g * L * 64, 64, (const bf16_t*)(PCB(bb_g, g * 3 + 2, head) + (size_t)rr_g * L * 128), 64, kb, nr, tid); }
                    while (have) { DIL_GEO(u, g, head, dil, L, q0, s0, kb, nr);
                        __syncthreads(); att::b2_write(st, (char*)lds_raw, nr, tid);
                        const att::i32x8q qr = qn;
                        const int un = u + G; const bool hn = un < 3 * 2048;
                        if (hn) { DIL_GEO(un, g2, head2, dil2, L2, q02, s02, kb2, nr2); DIL_QLOAD(qn, g2, head2, dil2, q02, s02); att::b2_load(st, PCB(bb_g2, g2 * 3 + 1, head2) + (size_t)rr_g2 * L2 * 64, 64, (const bf16_t*)(PCB(bb_g2, g2 * 3 + 2, head2) + (size_t)rr_g2 * L2 * 128), 64, kb2, nr2, tid); }
                        __syncthreads();
                        { const int qw = q0 + 32 * wv; const size_t qrow = s0 + (size_t)dil * qw;
                          att::b2_task<false, true, true>(qr, (bf16_t*)((unsigned char*)OG + (qrow * 3 + g) * 1024 + head * 64), (long)dil * 3072, LSE + (qrow * 3 + g) * 16 + head, (long)dil * 48, 0.f, qw, kb, L, 64, (const char*)lds_raw, al_l, lane_); }
                        u = un; have = hn; }
#undef DIL_QLOAD
#undef PCB
#undef DIL_GEO
                }
            }
            SEAM(pb + 2);
        }
        if (ON(8) && IN(pb + 3) && !even) { WSL();
            REP(8) {
                const int chunk = (T + NGW - 1) / NGW, tb = gw * chunk, te = tb + chunk < T ? tb + chunk : T;
                float ls[2][2][3]; u32x2 og[2][2][3];
#define GC_LOAD(tt, q) do { _Pragma("unroll") for (int j = 0; j < 2; ++j) { const int c_ = 8 * lane + 512 * j, head_ = c_ >> 6; _Pragma("unroll") for (int g = 0; g < 3; ++g) { \
        ls[q][j][g] = LSE[((size_t)(tt) * 3 + g) * 16 + head_]; og[q][j][g] = *(const u32x2*)((const unsigned char*)OG + ((size_t)(tt) * 3 + g) * 1024 + c_); } } } while (0)
                { const int t0_ = tb < te ? tb : 0, t1_ = tb + 1 < te ? tb + 1 : t0_; GC_LOAD(t0_, 0); GC_LOAD(t1_, 1); }
                for (int t = tb; t < te; t += 2) { const int t1 = t + 1 < te ? t + 1 : t;
                    float cl[2][2][3]; u32x2 co[2][2][3];
#pragma unroll
                    for (int q = 0; q < 2; ++q)
#pragma unroll
                        for (int j = 0; j < 2; ++j)
#pragma unroll
                            for (int g = 0; g < 3; ++g) { cl[q][j][g] = ls[q][j][g]; co[q][j][g] = og[q][j][g]; }
                    { const int tn = t + 2 < te ? t + 2 : t, tn1 = t + 3 < te ? t + 3 : tn; GC_LOAD(tn, 0); GC_LOAD(tn1, 1); }
#pragma unroll
                    for (int q = 0; q < 2; ++q) { const int tq = q ? t1 : t;
                        if (q == 1 && t + 1 >= te) break;
#pragma unroll
                        for (int j = 0; j < 2; ++j) { const int c = 8 * lane + 512 * j;
                            const float l0 = cl[q][j][0], l1 = cl[q][j][1], l2 = cl[q][j][2];
                            const float m = fmaxf(l0, fmaxf(l1, l2)); float w0 = __expf(l0 - m), w1 = __expf(l1 - m), w2 = __expf(l2 - m); const float inv = 1.0f / (w0 + w1 + w2); w0 *= inv; w1 *= inv; w2 *= inv;
                            typedef float f2_ __attribute__((ext_vector_type(2)));
                            const u32x2 a = co[q][j][0], bq = co[q][j][1], cq = co[q][j][2];
                            unsigned ow[2];
#pragma unroll
                            for (int hh = 0; hh < 2; ++hh) { const int aw = hh ? (int)a.y : (int)a.x, bw = hh ? (int)bq.y : (int)bq.x, cw = hh ? (int)cq.y : (int)cq.x;
                                const f2_ a01 = __builtin_amdgcn_cvt_pk_f32_fp8(aw, false), a23 = __builtin_amdgcn_cvt_pk_f32_fp8(aw, true), b01 = __builtin_amdgcn_cvt_pk_f32_fp8(bw, false), b23 = __builtin_amdgcn_cvt_pk_f32_fp8(bw, true),
                                          c01 = __builtin_amdgcn_cvt_pk_f32_fp8(cw, false), c23 = __builtin_amdgcn_cvt_pk_f32_fp8(cw, true);
                                ow[hh] = pk_fp8x4(w0 * a01[0] + w1 * b01[0] + w2 * c01[0], w0 * a01[1] + w1 * b01[1] + w2 * c01[1], w0 * a23[0] + w1 * b23[0] + w2 * c23[0], w0 * a23[1] + w1 * b23[1] + w2 * c23[1]); }
                            u32x2 o; o.x = ow[0]; o.y = ow[1];
                            *(u32x2*)((unsigned char*)OC + (size_t)tq * 1024 + c) = o; } } }
#undef GC_LOAD
            }
            SEAM(pb + 3);
        }
        if (ON(9) && IN(pb + 4)) { WSL();
            g8::DenseSched S;
            if (even) S.init(OB, (const unsigned char*)WOUTAB + (size_t)li * 1024 * 2048, 1024, T, 1024, G, bxl); else S.init(OC, (const unsigned char*)WOUTC + (size_t)li * 1024 * 1024, 512, T, 1024, G, bxl);
            REP(9) { EpiResid E{(float*)((char*)X + DSH(9)), MOD + (size_t)layer * 8 * 6144 + 2048, 1.0f / 256.0f};
            g8::gemm_phase<EpiResid, g8::DenseSched, true, true>(lds, even ? 1024 : 512, S, E, wave_s_, (vcl & 31) * STAG); }
            SEAM(pb + 4);
        }
        if (ON(10) && IN(pb + 5)) { WSL();
            constexpr int RMAXU = 16;
            LAS bf16_t* HT = (LAS bf16_t*)lds; LAS float* PART = (LAS float*)(lds + 66048); LAS float* LOG = (LAS float*)(lds + 98816);
            LAS int* LCNT = (LAS int*)(lds + 103040); LAS int* LBASE = (LAS int*)(lds + 103168); LAS int* SELE = (LAS int*)(lds + 106496); LAS int* SELR = (LAS int*)(lds + 114688); LAS float* SELG = (LAS float*)(lds + 122880);
            const float* gn = kp->g_norm_ffn + (size_t)layer * 1024;
            const int r32 = lane & 31, hi2 = lane >> 5;
            f32x4 gnv[4]; bf16x8 wb[8];
#pragma unroll
            for (int j = 0; j < 4; ++j) gnv[j] = *(const f32x4*)(gn + 8 * lane + 512 * (j >> 1) + 4 * (j & 1));
#pragma unroll
            for (int s8 = 0; s8 < 8; ++s8) wb[s8] = *(const bf16x8*)(WROUT + ((size_t)layer * 32 + r32) * 1024 + wave * 128 + s8 * 16 + hi2 * 8);
            REP(10) { unsigned* gcnt = (unsigned*)(wsl + WS_CTL) + CW_CNT + layer * 32 + (DSH(10) ? 4096 : 0); const size_t dsh = DSH(10);
            for (int ub = bxl; ub < T / 32; ub += G * RMAXU) {
                if (tid < 32) LCNT[tid] = 0;
                u32x4 xq[4][2]; f32x4 shv[4], scv[4];
#define R_ISSUE(uu) do { const int t0_ = (uu) * 32, b_ = t0_ >> 12; const float* sh_ = MOD + ((size_t)layer * 8 + b_) * 6144 + 3072; \
        _Pragma("unroll") for (int q = 0; q < 4; ++q) _Pragma("unroll") for (int jj = 0; jj < 2; ++jj) xq[q][jj] = *(const u32x4*)((const unsigned char*)X + (size_t)(t0_ + wave * 4 + q) * 2048 + (8 * lane + 512 * jj) * 2); \
        _Pragma("unroll") for (int j = 0; j < 4; ++j) { const int c_ = 8 * lane + 512 * (j >> 1) + 4 * (j & 1); shv[j] = *(const f32x4*)(sh_ + c_); scv[j] = *(const f32x4*)(sh_ + 1024 + c_); } } while (0)
                R_ISSUE(ub);
                int nu = 0;
                for (int u = ub, i = 0; u < T / 32 && i < RMAXU; u += G, ++i) { const int t0 = u * 32;
#pragma unroll
                    for (int q = 0; q < 4; ++q) { const int tl = wave * 4 + q, t = t0 + tl; f32x4 v[4]; float ss = 0.f;
#pragma unroll
                        for (int jj = 0; jj < 2; ++jj) { const u32x4 x4 = xq[q][jj];
                            v[2 * jj] = (f32x4){bf_lo(x4.x), bf_hi(x4.x), bf_lo(x4.y), bf_hi(x4.y)}; v[2 * jj + 1] = (f32x4){bf_lo(x4.z), bf_hi(x4.z), bf_lo(x4.w), bf_hi(x4.w)}; }
#pragma unroll
                        for (int j = 0; j < 4; ++j) ss += (v[j][0] * v[j][0] + v[j][1] * v[j][1]) + (v[j][2] * v[j][2] + v[j][3] * v[j][3]);
                        const float rstd = 1.0f / sqrtf(wave_sum(ss) * (1.0f / 1024.0f) + EPS);
                        f32x4 y[4];
#pragma unroll
                        for (int j = 0; j < 4; ++j) y[j] = v[j] * rstd * gnv[j] * (scv[j] + 1.0f) + shv[j];
#pragma unroll
                        for (int jj = 0; jj < 2; ++jj) { u32x2 w8; w8.x = pk_fp8x4(y[2 * jj][0], y[2 * jj][1], y[2 * jj][2], y[2 * jj][3]); w8.y = pk_fp8x4(y[2 * jj + 1][0], y[2 * jj + 1][1], y[2 * jj + 1][2], y[2 * jj + 1][3]);
                            *(u32x2*)((unsigned char*)H8 + (size_t)t * 1024 + 8 * lane + 512 * jj + dsh) = w8;
                            const u32x4 wh = {cvt_pk_bf16(y[2 * jj][0], y[2 * jj][1]), cvt_pk_bf16(y[2 * jj][2], y[2 * jj][3]), cvt_pk_bf16(y[2 * jj + 1][0], y[2 * jj + 1][1]), cvt_pk_bf16(y[2 * jj + 1][2], y[2 * jj + 1][3])};
                            *(LAS u32x4*)(HT + tl * 1032 + 8 * lane + 512 * jj) = wh; } }
                    if (u + G < T / 32 && i + 1 < RMAXU) R_ISSUE(u + G);
                    __syncthreads();
                    { f32x16 acc = {};
#pragma unroll
                      for (int s8 = 0; s8 < 8; ++s8) { const int kk = wave * 128 + s8 * 16 + hi2 * 8; const bf16x8 av = *(const LAS bf16x8*)(HT + r32 * 1032 + kk);
                          acc = __builtin_amdgcn_mfma_f32_32x32x16_bf16(av, wb[s8], acc, 0, 0, 0); }
#pragma unroll
                      for (int r = 0; r < 16; ++r) PART[wave * 1024 + att::crow(r, hi2) * 32 + r32] = acc[r]; }
                    __syncthreads();
#pragma unroll
                    for (int ii = 0; ii < 2; ++ii) { const int idx = tid + 512 * ii; float sacc = kp->b_router[layer * 32 + (idx & 31)];
#pragma unroll
                        for (int w = 0; w < 8; ++w) sacc += PART[w * 1024 + idx];
                        LOG[(idx >> 5) * 33 + (idx & 31)] = sacc; }
                    __syncthreads();
                    if (tid < 32) { unsigned mask = 0u; float tv[4]; int te[4];
#pragma unroll
                        for (int k = 0; k < 4; ++k) { float best = -__builtin_inff(); int bi = 0;
                            for (int e = 0; e < 32; ++e) { const float vv = LOG[tid * 33 + e]; const bool take = (vv > best) && !((mask >> e) & 1u); best = take ? vv : best; bi = take ? e : bi; }
                            mask |= 1u << bi; tv[k] = best; te[k] = bi; }
                        const float e0 = 1.0f, e1 = __expf(tv[1] - tv[0]), e2 = __expf(tv[2] - tv[0]), e3 = __expf(tv[3] - tv[0]); const float inv = 1.0f / (e0 + e1 + e2 + e3);
                        const float gk[4] = {e0 * inv, e1 * inv, e2 * inv, e3 * inv};
#pragma unroll
                        for (int k = 0; k < 4; ++k) { SELE[i * 128 + tid * 4 + k] = te[k]; SELG[i * 128 + tid * 4 + k] = gk[k]; SELR[i * 128 + tid * 4 + k] = __hip_atomic_fetch_add(LCNT + te[k], 1, __ATOMIC_RELAXED, __HIP_MEMORY_SCOPE_WORKGROUP); } }
                    nu = i + 1; }
#undef R_ISSUE
                __syncthreads();
                if (tid < 32) { const int c = LCNT[tid]; LBASE[tid] = c ? (int)__hip_atomic_fetch_add(gcnt + tid, (unsigned)c, __ATOMIC_RELAXED, __HIP_MEMORY_SCOPE_AGENT) : 0; }
                __syncthreads();
                for (int idx = tid; idx < nu * 128; idx += NTHR) { const int i = idx >> 7, w = idx & 127, t = (ub + i * G) * 32 + (w >> 2); const int e = SELE[idx], slot = LBASE[e] + SELR[idx];
                    if (slot < T) *(int*)((char*)(LIST + (size_t)e * T + slot) + dsh) = t; *(int*)((char*)(TOKE + (size_t)t * 4 + (w & 3)) + dsh) = e | (slot << 8); *(float*)((char*)(GATE + (size_t)t * 4 + (w & 3)) + dsh) = SELG[idx]; }
                __syncthreads(); } }
            SEAM(pb + 5);
        }
        if (ON(11) && IN(pb + 6)) { WSL();
            build_moe_tables(lds, (unsigned*)(wsl + WS_CTL) + CW_CNT + layer * 32, wave_s_);
            const int ntiles = ((const LAS int*)(lds + TAB_NT))[0];
            LAS int* ltok = (LAS int*)(lds + LTOK_OFF);
            { const LAS int* tinfo_ = (const LAS int*)(lds + TAB_TINFO); const LAS int* ecnt_ = (const LAS int*)(lds + TAB_ECNT);
              for (int i = tid >> 8;; i += 2) { const int L = i * G + vcl; if (L >= ntiles * 8 || i >= 24) break; const int info = tinfo_[L >> 3], e = info >> 16, slot = (info & 0xffff) * 256 + (tid & 255);
                  ltok[i * 256 + (tid & 255)] = slot < ecnt_[e] ? (LIST[(size_t)e * T + slot] & (T - 1)) : 0; }
              __syncthreads(); }
            MoeSchedUp S{(const char*)H8, (const char*)WGU + (size_t)layer * 32 * 2048 * 1024, (const LAS int*)(lds + TAB_TINFO), ltok, ntiles * 8 < 24 * G ? ntiles * 8 : 24 * G, G, vcl};
            EpiSwiGLU E{ACT, kp->b_gu + (size_t)layer * 32 * 2048};
            REP(11) g8::gemm_phase<EpiSwiGLU, MoeSchedUp, true, true>(lds, 512, S, E, wave_s_, (vcl & 31) * STAG);
            SEAM(pb + 6);
        }
        if (ON(12) && IN(pb + 7)) { WSL();
            if (lo > pb + 6) build_moe_tables(lds, (unsigned*)(wsl + WS_CTL) + CW_CNT + layer * 32, wave_s_);
            const int ntiles = ((const LAS int*)(lds + TAB_NT))[0];
            MoeSchedDown S{(const char*)ACT, (const char*)WDOWN + (size_t)layer * 32 * 1024 * 1024, (const LAS int*)(lds + TAB_TINFO), ntiles * 4, G, vcl};
            EpiDown E{(unsigned char*)YB, kp->b_down + (size_t)layer * 32 * 1024};
            if ((REPMASK >> 24) & 1u) { EpiNull EN; MoeSchedDownHot SH; SH.A = S.A; SH.Wt = S.Wt; SH.tinfo = S.tinfo; SH.nunits = S.nunits; SH.G = S.G; SH.c = S.c; g8::gemm_phase<EpiNull, MoeSchedDownHot, true, true>(lds, 512, SH, EN, wave_s_); }
            if ((REPMASK >> 20) & 1u) { EpiNull EN; g8::gemm_phase<EpiNull, MoeSchedDown, true, true>(lds, 512, S, EN, wave_s_); }
            if ((REPMASK >> 21) & 1u) { EpiP1 EN{(bf16_t*)((char*)YB + 1600 * MiB)}; g8::gemm_phase<EpiP1, MoeSchedDown, true, true>(lds, 512, S, EN, wave_s_); }
            if ((REPMASK >> 22) & 1u) { EpiP2 EN{(bf16_t*)((char*)YB + 1600 * MiB), kp->b_down + (size_t)layer * 32 * 1024}; g8::gemm_phase<EpiP2, MoeSchedDown, true, true>(lds, 512, S, EN, wave_s_); }
            REP(12) g8::gemm_phase<EpiDown, MoeSchedDown, true, true>(lds, 512, S, E, wave_s_, (vcl & 31) * STAG);
            SEAM(pb + 7);
        }
        if (ON(13) && IN(pb + 8)) { WSL();
            if (lo > pb + 6) build_moe_tables(lds, (unsigned*)(wsl + WS_CTL) + CW_CNT + layer * 32, wave_s_);
            const LAS int* tstart = (const LAS int*)(lds + TAB_TSTART);
#define CCOL(idx) (8 * lane + 512 * ((idx) >> 1) + 4 * ((idx) & 1))
            const bool lastl = layer + 1 >= DEPTH;
            const float* gnp = lastl ? kp->g_final : kp->g_norm_mix + (size_t)(layer + 1) * 1024;
            REP(13) { const size_t dsh = DSH(13);
                const int chunk = (T + NGW - 1) / NGW, tb = gw * chunk, te = tb + chunk < T ? tb + chunk : T;
                f32x4 gnv[4], g2v[4], scv[4], shv[4]; int cur_b = -1;
#pragma unroll
                for (int j = 0; j < 4; ++j) { gnv[j] = *(const f32x4*)(gnp + CCOL(j)); g2v[j] = gnv[j]; scv[j] = gnv[j]; shv[j] = gnv[j]; }
                i32x4v inf0 = {}, inf1 = {}; f32x4 gkq0 = {}, gkq1 = {};
                if (tb < te) { const int t1 = tb + 1 < te ? tb + 1 : tb; inf0 = *(const i32x4v*)(TOKE + (size_t)tb * 4); gkq0 = *(const f32x4*)(GATE + (size_t)tb * 4); inf1 = *(const i32x4v*)(TOKE + (size_t)t1 * 4); gkq1 = *(const f32x4*)(GATE + (size_t)t1 * 4); }
                for (int t = tb; t < te; t += 2) { const int t1 = t + 1 < te ? t + 1 : t;
                    u32x4 xq[2][2]; u32x2 yv[2][4][2];
#pragma unroll
                    for (int q = 0; q < 2; ++q)
#pragma unroll
                        for (int jj = 0; jj < 2; ++jj) xq[q][jj] = *(const u32x4*)((const unsigned char*)X + (size_t)(q ? t1 : t) * 2048 + (8 * lane + 512 * jj) * 2);
#pragma unroll
                    for (int q = 0; q < 2; ++q)
#pragma unroll
                        for (int k = 0; k < 4; ++k) { const int info = q ? inf1[k] : inf0[k]; const size_t row = (size_t)tstart[info & 31] * 256 + (info >> 8);
#pragma unroll
                            for (int j = 0; j < 2; ++j) yv[q][k][j] = *(const u32x2*)((const unsigned char*)YB + row * 1024 + 8 * lane + 512 * j); }
                    const f32x4 gc0 = gkq0, gc1 = gkq1;
                    { const int tn = t + 2 < te ? t + 2 : t, tn1 = t + 3 < te ? t + 3 : tn;
                      inf0 = *(const i32x4v*)(TOKE + (size_t)tn * 4); gkq0 = *(const f32x4*)(GATE + (size_t)tn * 4); inf1 = *(const i32x4v*)(TOKE + (size_t)tn1 * 4); gkq1 = *(const f32x4*)(GATE + (size_t)tn1 * 4); }
#pragma unroll
                    for (int q = 0; q < 2; ++q) { const int tq = q ? t1 : t, b = tq >> 12;
                        if (q == 1 && t + 1 >= te) break;
                        if (b != cur_b) { cur_b = b;
                            const float* g2 = MOD + ((size_t)layer * 8 + b) * 6144 + 5120; const float* sh = MOD + ((size_t)(lastl ? layer : layer + 1) * 8 + b) * 6144; const float* sc = sh + 1024;
#pragma unroll
                            for (int j = 0; j < 4; ++j) { g2v[j] = *(const f32x4*)(g2 + CCOL(j)); if (!lastl) { scv[j] = *(const f32x4*)(sc + CCOL(j)) + 1.0f; shv[j] = *(const f32x4*)(sh + CCOL(j)); } } }
                        f32x4 a[4];
#pragma unroll
                        for (int j = 0; j < 4; ++j) a[j] = (f32x4){0.f, 0.f, 0.f, 0.f};
#pragma unroll
                        for (int k = 0; k < 4; ++k) { const float gk = q ? gc1[k] : gc0[k];
#pragma unroll
                            for (int j = 0; j < 2; ++j) { const u32x2 y = yv[q][k][j];
                                typedef float f2_ __attribute__((ext_vector_type(2)));
                                const f2_ y01 = __builtin_amdgcn_cvt_pk_f32_fp8((int)y.x, false), y23 = __builtin_amdgcn_cvt_pk_f32_fp8((int)y.x, true), y45 = __builtin_amdgcn_cvt_pk_f32_fp8((int)y.y, false), y67 = __builtin_amdgcn_cvt_pk_f32_fp8((int)y.y, true);
                                a[2 * j][0] += gk * y01[0]; a[2 * j][1] += gk * y01[1]; a[2 * j][2] += gk * y23[0]; a[2 * j][3] += gk * y23[1];
                                a[2 * j + 1][0] += gk * y45[0]; a[2 * j + 1][1] += gk * y45[1]; a[2 * j + 1][2] += gk * y67[0]; a[2 * j + 1][3] += gk * y67[1]; } }
                        f32x4 v[4]; float ss = 0.f;
#pragma unroll
                        for (int jj = 0; jj < 2; ++jj) { const u32x4 x4 = xq[q][jj];
                            v[2 * jj] = (f32x4){bf_lo(x4.x), bf_hi(x4.x), bf_lo(x4.y), bf_hi(x4.y)}; v[2 * jj + 1] = (f32x4){bf_lo(x4.z), bf_hi(x4.z), bf_lo(x4.w), bf_hi(x4.w)}; }
#pragma unroll
                        for (int j = 0; j < 4; ++j) { v[j] = v[j] + g2v[j] * a[j]; ss += (v[j][0] * v[j][0] + v[j][1] * v[j][1]) + (v[j][2] * v[j][2] + v[j][3] * v[j][3]); }
                        const float rstd = 1.0f / sqrtf(wave_sum(ss) * (1.0f / 1024.0f) + EPS);
                        if (!lastl) {
                            unsigned w8[4];
#pragma unroll
                            for (int j = 0; j < 4; ++j) { const f32x4 y = v[j] * rstd * gnv[j] * scv[j] + shv[j]; w8[j] = pk_fp8x4(y[0], y[1], y[2], y[3]); }
#pragma unroll
                            for (int j = 0; j < 2; ++j) { u32x2 w; w.x = w8[2 * j]; w.y = w8[2 * j + 1]; *(u32x2*)((unsigned char*)H + (size_t)tq * 1024 + 8 * lane + 512 * j + dsh) = w;
                                const u32x4 xw = {cvt_pk_bf16(v[2 * j][0], v[2 * j][1]), cvt_pk_bf16(v[2 * j][2], v[2 * j][3]), cvt_pk_bf16(v[2 * j + 1][0], v[2 * j + 1][1]), cvt_pk_bf16(v[2 * j + 1][2], v[2 * j + 1][3])};
                                *(u32x4*)((unsigned char*)X + (size_t)tq * 2048 + (8 * lane + 512 * j) * 2 + dsh) = xw; }
                        } else {
#pragma unroll
                            for (int j = 0; j < 4; ++j) { const int c = CCOL(j); *(f32x4*)(dsh ? (float*)((char*)(X + (size_t)tq * 1024 + c) + dsh) : kp->out + (size_t)tq * 1024 + c) = v[j] * rstd * gnv[j]; } } } } }
#undef CCOL
            SEAM(pb + 8);
        }
    }
#undef IN
#undef SEAM
}

extern "C" void kernel_launch(void* const* d_in, const int* in_sizes, int n_in, void* d_out, int out_size, void* d_ws, size_t ws_size, hipStream_t stream) {
    static int grid = 0;
    if (grid == 0) {
        if (n_in != 23 || out_size != T * D || ws_size < WS_END) { fprintf(stderr, "kernel_launch: unexpected shapes n_in %d out %d ws %zu (need %zu)\n", n_in, out_size, ws_size, (size_t)WS_END); grid = -1; return; }
        int dev = 0, cus = 0, per_cu = 0;
        if (hipGetDevice(&dev) != hipSuccess || hipDeviceGetAttribute(&cus, hipDeviceAttributeMultiprocessorCount, dev) != hipSuccess) { grid = -1; return; }
        if (hipFuncSetAttribute((const void*)fwd_kernel, hipFuncAttributeMaxDynamicSharedMemorySize, LDS_BYTES) != hipSuccess) { fprintf(stderr, "kernel_launch: hipFuncSetAttribute failed\n"); grid = -1; return; }
        if (hipOccupancyMaxActiveBlocksPerMultiprocessor(&per_cu, (const void*)fwd_kernel, NTHR, LDS_BYTES) != hipSuccess || per_cu < 1) { fprintf(stderr, "kernel_launch: occupancy query says %d\n", per_cu); (void)hipGetLastError(); grid = -1; return; }
        grid = cus;
    }
    if (grid < 0) return;
    (void)hipMemsetAsync((char*)d_ws + WS_CTL, 0, CTL_ZERO_BYTES, stream);
    Params p{};
    p.x = (const float*)d_in[0]; p.c = (const float*)d_in[1]; p.positions = (const int*)d_in[2]; p.w_mod = (const float*)d_in[3]; p.b_mod = (const float*)d_in[4];
    p.g_norm_mix = (const float*)d_in[5]; p.g_norm_ffn = (const float*)d_in[6]; p.w_in_ab = (const float*)d_in[7]; p.mla_g_q = (const float*)d_in[8]; p.mla_w_qb = (const float*)d_in[9];
    p.mla_g_kv = (const float*)d_in[10]; p.mla_w_kvb = (const float*)d_in[11]; p.swa_sink = (const float*)d_in[12]; p.w_out_ab = (const float*)d_in[13]; p.w_in_c = (const float*)d_in[14];
    p.w_out_c = (const float*)d_in[15]; p.w_router = (const float*)d_in[16]; p.b_router = (const float*)d_in[17]; p.w_gu = (const float*)d_in[18]; p.b_gu = (const float*)d_in[19];
    p.w_down = (const float*)d_in[20]; p.b_down = (const float*)d_in[21]; p.g_final = (const float*)d_in[22];
    p.out = (float*)d_out; p.ws = (unsigned char*)d_ws;
#if MK_MULTI
    for (int k = 0; k < NPH; ++k) { if (phase_empty(k)) continue; p.ph_lo = k; p.ph_hi = k + 1;
        hipLaunchKernelGGL(fwd_kernel, dim3(grid), dim3(NTHR), LDS_BYTES, stream, p); }
#else
    p.ph_lo = 0; p.ph_hi = NPH;
    hipLaunchKernelGGL(fwd_kernel, dim3(grid), dim3(NTHR), LDS_BYTES, stream, p);
#endif
    const hipError_t le = hipPeekAtLastError();
    if (le != hipSuccess) fprintf(stderr, "kernel_launch: launch failed: %s\n", hipGetErrorName(le));
}
```

```cpp
#include <hip/hip_runtime.h>
#include <cstdio>
#include <cstdint>

#ifndef MK_MULTI
#define MK_MULTI 0
#endif

#define GAS __attribute__((address_space(1)))
#define LAS __attribute__((address_space(3)))
typedef unsigned short bf16_t;
typedef short bf16x8 __attribute__((ext_vector_type(8)));
typedef short s16x4 __attribute__((ext_vector_type(4)));
typedef float f32x2 __attribute__((ext_vector_type(2)));
typedef float f32x4 __attribute__((ext_vector_type(4)));
typedef float f32x16 __attribute__((ext_vector_type(16)));
typedef unsigned u32x2 __attribute__((ext_vector_type(2)));
typedef unsigned u32x4 __attribute__((ext_vector_type(4)));
typedef int i32x4v __attribute__((ext_vector_type(4)));

constexpr int T = 32768, D = 1024, NBATCH = 8, SEQ = 4096, DEPTH = 4, NE = 32, TOPK = 4;
constexpr float EPS = 1e-6f;
constexpr int AB_IN = 1984, AB_MIX = 2048, C_IN = 9216;
constexpr int NWAVES = 8, NTHR = 512;

constexpr size_t MiB = 1u << 20;
constexpr size_t WS_CTL = 0, CTL_ZERO_BYTES = 1 * MiB;
constexpr size_t WS_MOD = 1 * MiB;
constexpr size_t WS_COS = 2 * MiB, WS_SIN = 6 * MiB;
constexpr size_t WS_WROUT = 10 * MiB;
constexpr size_t WS_WINAB = 11 * MiB;
constexpr size_t WS_WQB = 19 * MiB;
constexpr size_t WS_WKVB = 22 * MiB;
constexpr size_t WS_WOUTAB = 24 * MiB;
constexpr size_t WS_WINC = 32 * MiB;
constexpr size_t WS_WOUTC = 68 * MiB;
constexpr size_t WS_WGU = 72 * MiB;
constexpr size_t WS_WDOWN = 584 * MiB;
constexpr size_t WS_X = 840 * MiB;
constexpr size_t WS_H = 968 * MiB;
constexpr size_t WS_A0 = 1032 * MiB;
constexpr size_t WS_QB = WS_A0;
constexpr size_t WS_KB = WS_A0 + 64 * MiB;
constexpr size_t WS_VB = WS_A0 + 72 * MiB;
constexpr size_t WS_KR = WS_A0 + 80 * MiB;
constexpr size_t WS_CQ = WS_A0 + 84 * MiB;
constexpr size_t WS_CKV = WS_A0 + 108 * MiB;
constexpr size_t WS_SSQ = WS_A0 + 124 * MiB;
constexpr size_t WS_QA = WS_A0 + 126 * MiB;
constexpr size_t WS_KV = WS_A0 + 222 * MiB;
constexpr size_t WS_O = WS_A0 + 350 * MiB;
constexpr size_t WS_PC = WS_A0;
constexpr size_t WS_OG = WS_A0 + 576 * MiB;
constexpr size_t WS_LSE = WS_A0 + 768 * MiB;
constexpr size_t WS_OC = WS_A0 + 774 * MiB;
constexpr size_t WS_MOE = WS_A0 + 840 * MiB;
constexpr size_t WS_LIST = WS_MOE;
constexpr size_t WS_TOKE = WS_MOE + 4 * MiB;
constexpr size_t WS_GATE = WS_MOE + 5 * MiB;
constexpr int ACT_ROWS = T * TOPK + NE * 256;
constexpr size_t WS_ACT = WS_MOE + 6 * MiB;
constexpr size_t WS_H8 = WS_ACT + 136 * MiB;
constexpr size_t WS_YB = WS_ACT + 272 * MiB;
constexpr size_t WS_END = WS_YB + 272 * MiB;

constexpr int CW_BAR = 4096;
constexpr int CW_CNT = 8192;

constexpr int RING_BYTES = 131072;
constexpr int TAB_OFF = RING_BYTES;
constexpr int TAB_TINFO = TAB_OFF, TAB_ECNT = TAB_OFF + 576 * 4, TAB_TSTART = TAB_ECNT + 32 * 4, TAB_NT = TAB_TSTART + 36 * 4;
constexpr int MISC_OFF = TAB_OFF + 4096;
constexpr int LTOK_OFF = MISC_OFF + 256;
constexpr int LDS_BYTES = 163840;
static_assert(LTOK_OFF + 24 * 1024 <= LDS_BYTES, "lds map");
static_assert(TAB_NT + 16 <= MISC_OFF && MISC_OFF + 128 <= LDS_BYTES, "lds map");

#define LDS_WAIT() asm volatile("s_waitcnt lgkmcnt(0)" ::: "memory")
#define VM_WAIT() asm volatile("s_waitcnt vmcnt(0)" ::: "memory")
#define SBAR() __builtin_amdgcn_sched_barrier(0)

__device__ __forceinline__ unsigned cvt_pk_bf16(float lo, float hi) { unsigned r; asm volatile("v_cvt_pk_bf16_f32 %0, %1, %2" : "=v"(r) : "v"(lo), "v"(hi)); return r; }
__device__ __forceinline__ float bf_lo(unsigned u) { return __uint_as_float(u << 16); }
__device__ __forceinline__ float bf_hi(unsigned u) { return __uint_as_float(u & 0xffff0000u); }
__device__ __forceinline__ float xor16_sum(float v) { const auto r = __builtin_amdgcn_permlane16_swap(__float_as_uint(v), __float_as_uint(v), false, false); return __uint_as_float(r[0]) + __uint_as_float(r[1]); }
__device__ __forceinline__ float xor32_sum(float v) { const auto r = __builtin_amdgcn_permlane32_swap(__float_as_uint(v), __float_as_uint(v), false, false); return __uint_as_float(r[0]) + __uint_as_float(r[1]); }
__device__ __forceinline__ float wave_sum(float v) {
    v += __int_as_float(__builtin_amdgcn_mov_dpp(__float_as_int(v), 0xB1, 0xF, 0xF, true));
    v += __int_as_float(__builtin_amdgcn_mov_dpp(__float_as_int(v), 0x4E, 0xF, 0xF, true));
    v += __int_as_float(__builtin_amdgcn_mov_dpp(__float_as_int(v), 0x124, 0xF, 0xF, true));
    v += __int_as_float(__builtin_amdgcn_mov_dpp(__float_as_int(v), 0x128, 0xF, 0xF, true));
    return xor32_sum(xor16_sum(v));
}

__device__ __forceinline__ int tid_now(int wave_s) { int l; asm volatile("v_mbcnt_lo_u32_b32 %0, -1, 0\n\tv_mbcnt_hi_u32_b32 %0, -1, %0" : "=&v"(l)); return (wave_s << 6) | l; }
#define XB_TMO      128
#define XB_XCNT(j)  (256  + 64 * (j))
#define XB_XSUB(j)  (1280 + 64 * (j))
#define XB_XGEN(j)  (2304 + 64 * (j))
#define XB_TOP      3328
#define XB_TOPGEN   3392
#define XCD_BAR_WORDS 3456
#define XB_SPIN_CAP (1u << 20)
__device__ __forceinline__ unsigned xb_ld(unsigned* p)              { return __hip_atomic_load(p, __ATOMIC_RELAXED, __HIP_MEMORY_SCOPE_AGENT); }
__device__ __forceinline__ unsigned xb_add(unsigned* p, unsigned v) { return __hip_atomic_fetch_add(p, v, __ATOMIC_RELAXED, __HIP_MEMORY_SCOPE_AGENT); }
__device__ __forceinline__ unsigned xb_xcc_id() { return (unsigned)__builtin_amdgcn_s_getreg((3 << 11) | 20) & 0xFu; }
#define XB_SPIN(cond, bar) do { unsigned _sp = 0; while (cond) { __builtin_amdgcn_s_sleep(1); \
    if ((++_sp & 255u) == 0u) { if (xb_ld(&(bar)[XB_TMO])) break; if (_sp > XB_SPIN_CAP) { atomicAdd(&(bar)[XB_TMO], 1u); break; } } } } while (0)
struct XcdBarrier { unsigned* bar; unsigned x; volatile LAS unsigned* st; };
__device__ __forceinline__ XcdBarrier xcd_barrier_post(unsigned* bar, volatile LAS unsigned* st) {
    XcdBarrier b; b.bar = bar; b.x = xb_xcc_id(); b.st = st;
    if (threadIdx.x == 0) (void)xb_add(&bar[XB_XCNT(b.x)], 1u);
    return b;
}
__device__ __forceinline__ void xcd_barrier_complete(unsigned* bar, unsigned x, unsigned& nloc, unsigned& nx) {
    const unsigned G = gridDim.x * gridDim.y * gridDim.z;
    unsigned sum, cnt, mine, sp = 0u;
    for (;;) {
        sum = 0u; cnt = 0u; mine = 0u;
#pragma unroll
        for (unsigned j = 0; j < 16; ++j) { const unsigned c = xb_ld(&bar[XB_XCNT(j)]); sum += c; cnt += (c > 0u) ? 1u : 0u; mine = (j == x) ? c : mine; }
        if (sum == G) break;
        __builtin_amdgcn_s_sleep(1);
        if ((++sp & 255u) == 0u) { if (xb_ld(&bar[XB_TMO])) break; if (sp > XB_SPIN_CAP) { atomicAdd(&bar[XB_TMO], 1u); break; } }
    }
    nloc = mine > 0u ? mine : 1u; nx = cnt > 0u ? cnt : 1u;
}
__device__ __forceinline__ void xcd_barrier(const XcdBarrier& b, const int wave_s_) {
    asm volatile("s_waitcnt vmcnt(0)" ::: "memory");
    __syncthreads();
    if (tid_now(wave_s_) == 0) {
        unsigned* bar = b.bar;
        __builtin_amdgcn_s_waitcnt(0);
        unsigned nloc = b.st[0], nx = b.st[1];
        if (nloc == 0u) { xcd_barrier_complete(bar, b.x, nloc, nx); b.st[0] = nloc; b.st[1] = nx; }
        const unsigned old = xb_add(&bar[XB_XSUB(b.x)], 1u);
        const unsigned gen = old / nloc;
        if (old + 1u == (gen + 1u) * nloc) {
            __builtin_amdgcn_fence(__ATOMIC_RELEASE, "agent");
            asm volatile("s_waitcnt vmcnt(0)" ::: "memory");
            const unsigned og = xb_add(&bar[XB_TOP], 1u);
            const unsigned tg = og / nx;
            if (og + 1u == (tg + 1u) * nx) xb_add(&bar[XB_TOPGEN], 1u);
            else XB_SPIN(xb_ld(&bar[XB_TOPGEN]) == tg, bar);
            __builtin_amdgcn_fence(__ATOMIC_ACQUIRE, "agent");
            xb_add(&bar[XB_XGEN(b.x)], 1u);
            asm volatile("s_waitcnt vmcnt(0)" ::: "memory");
        } else {
            XB_SPIN(xb_ld(&bar[XB_XGEN(b.x)]) == gen, bar);
            __builtin_amdgcn_fence(__ATOMIC_ACQUIRE, "agent");
            asm volatile("s_waitcnt vmcnt(0)" ::: "memory");
        }
    }
    __syncthreads();
}

struct Params {
    const float* x; const float* c; const int* positions; const float* w_mod; const float* b_mod; const float* g_norm_mix; const float* g_norm_ffn;
    const float* w_in_ab; const float* mla_g_q; const float* mla_w_qb; const float* mla_g_kv; const float* mla_w_kvb; const float* swa_sink; const float* w_out_ab;
    const float* w_in_c; const float* w_out_c; const float* w_router; const float* b_router; const float* w_gu; const float* b_gu; const float* w_down; const float* b_down; const float* g_final;
    float* out; unsigned char* ws;
    int ph_lo, ph_hi;
};

namespace g8 {
constexpr int BM = 256, BK = 64, HALF = 128, HTB = HALF * BK * 2, STAGE_BYTES = 8 * HTB, NXCD = 8, WGM = 8;
__device__ __forceinline__ int lds_byte(int r, int c) { const int st = (r >> 4) * 2 + (c >> 5), rr = r & 15, cc = c & 31, ob = rr * 64 + cc * 2; return st * 1024 + (ob ^ (((ob >> 9) & 1) << 5)); }
__device__ __forceinline__ void stage_rc(int b, int& R, int& C) { const int st = b / 1024, sb = b % 1024, swz = sb ^ (((sb >> 9) & 1) << 5); R = (st >> 1) * 16 + swz / 64; C = (st & 1) * 32 + (swz % 64) / 2; }
__device__ __forceinline__ int perm32(int rho) { const int n = rho >> 4, i = rho & 15; return 8 * (i >> 2) + 4 * n + (i & 3); }

struct Unit { int pm, pn, aux, ord; };
typedef int i32x4 __attribute__((ext_vector_type(4)));
typedef int i32x8 __attribute__((ext_vector_type(8)));
__device__ __forceinline__ bf16x8 lo8(i32x8 v) { return __builtin_bit_cast(bf16x8, __builtin_shufflevector(v, v, 0, 1, 2, 3)); }
__device__ __forceinline__ bf16x8 hi8(i32x8 v) { return __builtin_bit_cast(bf16x8, __builtin_shufflevector(v, v, 4, 5, 6, 7)); }
__device__ __forceinline__ i32x8 cat8(bf16x8 a, bf16x8 b) { const i32x4 x = __builtin_bit_cast(i32x4, a), y = __builtin_bit_cast(i32x4, b); return __builtin_shufflevector(x, y, 0, 1, 2, 3, 4, 5, 6, 7); }

struct DenseSched {
    const char* A; const char* Bt; int K; int nM, nN, nwg, G, c;
    __device__ __forceinline__ void init(const void* A_, const void* Bt_, int K_, int M, int N, int G_, int c_) { A = (const char*)A_; Bt = (const char*)Bt_; asm volatile("" : "+s"(A), "+s"(Bt));     K = K_; nM = M / BM; nN = N / BM; nwg = nM * nN; G = G_; c = c_; }
    __device__ __forceinline__ bool next(int i, Unit& u) const {
        const long L = (long)i * G + c; if (L >= nwg) return false;
        int wgid = (int)L; { const int q = nwg / NXCD, r = nwg % NXCD, xcd = wgid % NXCD, off = wgid / NXCD; wgid = (xcd < r ? xcd * (q + 1) : r * (q + 1) + (xcd - r) * q) + off; }
        const int nig = WGM * nN, gid = wgid / nig, fm = gid * WGM, gsz = (nM - fm) < WGM ? (nM - fm) : WGM;
        u.pm = fm + ((wgid % nig) % gsz); u.pn = (wgid % nig) / gsz; u.aux = 0; u.ord = i; return true;
    }
    static constexpr bool GATHER = false;
    __device__ __forceinline__ const char* a_base() const { return A; }
    __device__ __forceinline__ const char* a_tile(const Unit& u) const { return A + (size_t)u.pm * BM * K * 2; }
    __device__ __forceinline__ unsigned a_off(const Unit& u, int r) const { return 0u; }
    __device__ __forceinline__ const char* b_tile(const Unit& u) const { return Bt + (size_t)u.pn * BM * K * 2; }
};

template <class Epi, class Sched, bool ALIGN_EPI, bool FP8 = false>
__device__ __forceinline__ void gemm_phase(LAS unsigned char* lds, const int K, const Sched& S, const Epi& E, const int wave_s_, const int stagger = 0) {
    if (stagger > 0) { const unsigned long long t0_ = __builtin_amdgcn_s_memrealtime(); while (__builtin_amdgcn_s_memrealtime() - t0_ < (unsigned long long)stagger) __builtin_amdgcn_s_sleep(8); }
    const int tid = tid_now(wave_s_);
    const int wid = __builtin_amdgcn_readfirstlane(tid >> 6), lane = tid & 63, wr = wid >> 2, wc = wid & 3, fr = lane & 15, fq = lane >> 4;
    const int nt = K / BK;
    constexpr bool GATHER = Sched::GATHER;
    int Ra[2]; unsigned Ca2[2], voffB[2], voffA[2];
#pragma unroll
    for (int i = 0; i < 2; ++i) { int R, C; stage_rc(tid * 16 + i * 8192, R, C); const int Rb = (R & ~31) + perm32(R & 31);
        Ra[i] = R; Ca2[i] = (unsigned)C * 2u; voffB[i] = (unsigned)(Rb * K + C) * 2u; voffA[i] = (unsigned)(R * K + C) * 2u; }
    const size_t kstep = (size_t)(BK * 2);
    const size_t hstep = (size_t)HALF * K * 2;
    const unsigned ldsw = (unsigned)wid * 1024u;
    const int aoff = lds_byte(wr * 64 + fr, fq * 8), boff = lds_byte(wc * 32 + fr, fq * 8);
#define G8_SA(b, h) (((b) * 2 + (h)) * HTB)
#define G8_SB(b, h) ((4 + (b) * 2 + (h)) * HTB)
#define G8_STAGE(bufoff, gbase, voff) do { _Pragma("unroll") for (int _i = 0; _i < 2; ++_i) \
        __builtin_amdgcn_global_load_lds((const unsigned*)((const char*)(gbase) + (voff)[_i]), (LAS unsigned*)(lds + (bufoff) + ldsw + _i * 8192), 16, 0, 0); } while (0)
#define G8_LDA(dst, b, h) do { _Pragma("unroll") for (int m = 0; m < 4; ++m) dst[m] = cat8(*(const LAS bf16x8*)(lds + G8_SA(b, h) + aoff + m * 2048), *(const LAS bf16x8*)(lds + G8_SA(b, h) + aoff + m * 2048 + 1024)); } while (0)
#define G8_LDB(dst, b, h) do { _Pragma("unroll") for (int n = 0; n < 2; ++n) dst[n] = cat8(*(const LAS bf16x8*)(lds + G8_SB(b, h) + boff + n * 2048), *(const LAS bf16x8*)(lds + G8_SB(b, h) + boff + n * 2048 + 1024)); } while (0)
#define G8_MMA(ai, bj, At, Bt) do { __builtin_amdgcn_s_setprio(1); _Pragma("unroll") for (int m = 0; m < 4; ++m) _Pragma("unroll") for (int n = 0; n < 2; ++n) { \
        if constexpr (FP8) asm volatile("v_mfma_f32_16x16x128_f8f6f4 %0, %1, %2, %0" : "+v"(acc[ai][bj][m][n]) : "v"(Bt[n]), "v"(At[m]));     \
        else { acc[ai][bj][m][n] = __builtin_amdgcn_mfma_f32_16x16x32_bf16(lo8(Bt[n]), lo8(At[m]), acc[ai][bj][m][n], 0, 0, 0); acc[ai][bj][m][n] = __builtin_amdgcn_mfma_f32_16x16x32_bf16(hi8(Bt[n]), hi8(At[m]), acc[ai][bj][m][n], 0, 0, 0); } } __builtin_amdgcn_s_setprio(0); } while (0)
#define G8_WAIT_V(n) asm volatile("s_waitcnt vmcnt(" #n ")" ::: "memory")
#define G8_WAIT_L(n) asm volatile("s_waitcnt lgkmcnt(" #n ")" ::: "memory")
#define G8_BAR __builtin_amdgcn_s_barrier()
#define G8_SCHED __builtin_amdgcn_sched_barrier(0)
    Unit cur, nxt; int ui = 0;
    if (!S.next(0, cur)) return;
    f32x4 acc[2][2][4][2];
#pragma unroll
    for (int a = 0; a < 2; ++a)
#pragma unroll
        for (int b = 0; b < 2; ++b)
#pragma unroll
            for (int m = 0; m < 4; ++m)
#pragma unroll
                for (int n = 0; n < 2; ++n) acc[a][b][m][n] = (f32x4){0.f, 0.f, 0.f, 0.f};
    i32x8 At[4], B0[2], B1[2];
    const char* Ab = GATHER ? S.a_base() : S.a_tile(cur);
    unsigned cA0[2], cA1[2], nA0[2], nA1[2];
#pragma unroll
    for (int i = 0; i < 2; ++i) { if constexpr (GATHER) { cA0[i] = S.a_off(cur, Ra[i]) + Ca2[i]; cA1[i] = S.a_off(cur, HALF + Ra[i]) + Ca2[i]; } else { cA0[i] = voffA[i]; cA1[i] = voffA[i] + (unsigned)hstep; } }
    const char* cB = S.b_tile(cur);
    G8_STAGE(G8_SB(0, 0), cB, voffB); G8_STAGE(G8_SA(0, 0), Ab, cA0); G8_STAGE(G8_SB(0, 1), cB + hstep, voffB); G8_STAGE(G8_SA(0, 1), Ab, cA1);
    if (wr == 1) G8_BAR;
    G8_WAIT_V(4); G8_BAR;
    G8_STAGE(G8_SB(1, 0), cB + kstep, voffB); G8_STAGE(G8_SA(1, 0), Ab + kstep, cA0); G8_STAGE(G8_SB(1, 1), cB + hstep + kstep, voffB);
    G8_WAIT_V(6); G8_BAR;
    for (;;) {
        const bool has_next = S.next(ui + 1, nxt);
        const char* nB = cB; const char* nAb = Ab;
        if constexpr (GATHER) {
#pragma unroll
            for (int i = 0; i < 2; ++i) { nA0[i] = cA0[i]; nA1[i] = cA1[i]; } }
        if (has_next) { nB = S.b_tile(nxt);
            if constexpr (GATHER) {
#pragma unroll
                for (int i = 0; i < 2; ++i) { nA0[i] = S.a_off(nxt, Ra[i]) + Ca2[i]; nA1[i] = S.a_off(nxt, HALF + Ra[i]) + Ca2[i]; } }
            else nAb = S.a_tile(nxt); }
#pragma clang loop unroll(disable)
        for (int t = 0; t < nt; t += 2) {
            const bool last = (t == nt - 2);
            const char* a1 = Ab + (size_t)(t + 1) * kstep;
            const char* a2 = last ? nAb : Ab + (size_t)(t + 2) * kstep; const char* b2 = last ? nB : cB + (size_t)(t + 2) * kstep;
            const char* a3 = a2 + kstep; const char* b3 = b2 + kstep;
            unsigned o20[2], o21[2];
#pragma unroll
            for (int i = 0; i < 2; ++i) { if constexpr (GATHER) { o20[i] = last ? nA0[i] : cA0[i]; o21[i] = last ? nA1[i] : cA1[i]; } else { o20[i] = cA0[i]; o21[i] = cA1[i]; } }
            G8_LDB(B0, 0, 0); G8_SCHED; G8_LDA(At, 0, 0); G8_STAGE(G8_SA(1, 1), a1, cA1);
            G8_WAIT_L(8); G8_BAR; G8_WAIT_L(0); G8_MMA(0, 0, At, B0); G8_BAR; G8_SCHED;
            G8_LDB(B1, 0, 1); G8_STAGE(G8_SB(0, 0), b2, voffB);
            G8_BAR; G8_WAIT_L(0); G8_MMA(0, 1, At, B1); G8_BAR;
            G8_LDA(At, 0, 1); G8_STAGE(G8_SA(0, 0), a2, o20);
            G8_BAR; G8_WAIT_L(0); G8_MMA(1, 0, At, B0); G8_BAR; G8_SCHED;
            G8_STAGE(G8_SB(0, 1), b2 + hstep, voffB);
            G8_WAIT_V(6); G8_BAR; G8_MMA(1, 1, At, B1); G8_BAR;
            G8_LDB(B0, 1, 0); G8_SCHED; G8_LDA(At, 1, 0); G8_STAGE(G8_SA(0, 1), a2, o21);
            G8_WAIT_L(8); G8_BAR; G8_WAIT_L(0); G8_MMA(0, 0, At, B0); G8_BAR; G8_SCHED;
            G8_LDB(B1, 1, 1); G8_STAGE(G8_SB(1, 0), b3, voffB);
            G8_BAR; G8_WAIT_L(0); G8_MMA(0, 1, At, B1); G8_BAR;
            G8_LDA(At, 1, 1); G8_STAGE(G8_SA(1, 0), a3, o20);
            G8_BAR; G8_WAIT_L(0); G8_MMA(1, 0, At, B0); G8_BAR; G8_SCHED;
            G8_STAGE(G8_SB(1, 1), b3 + hstep, voffB);
            G8_WAIT_V(6); G8_BAR; G8_MMA(1, 1, At, B1); G8_BAR;
        }
        if constexpr (FP8) asm volatile("s_nop 15\n\ts_nop 15" ::: "memory");
        if constexpr (ALIGN_EPI) { if (wr == 0) G8_BAR; }
        E(acc, cur, wr, wc, fr, fq);
        if (!has_next) break;
#pragma unroll
        for (int a = 0; a < 2; ++a)
#pragma unroll
            for (int b = 0; b < 2; ++b)
#pragma unroll
                for (int m = 0; m < 4; ++m)
#pragma unroll
                    for (int n = 0; n < 2; ++n) acc[a][b][m][n] = (f32x4){0.f, 0.f, 0.f, 0.f};
        cur = nxt; cB = nB; ++ui;
        if constexpr (GATHER) {
#pragma unroll
            for (int i = 0; i < 2; ++i) { cA0[i] = nA0[i]; cA1[i] = nA1[i]; } }
        else Ab = nAb;
        if constexpr (ALIGN_EPI) { if (wr == 1) G8_BAR; }
    }
    G8_WAIT_V(0);
    if constexpr (!ALIGN_EPI) { if (wr == 0) G8_BAR; }
    G8_BAR;
#undef G8_SA
#undef G8_SB
#undef G8_STAGE
#undef G8_LDA
#undef G8_LDB
#undef G8_MMA
#undef G8_WAIT_V
#undef G8_WAIT_L
#undef G8_BAR
#undef G8_SCHED
}
}

typedef f32x4 Acc[2][2][4][2];
__device__ __forceinline__ u32x4 pack8(const f32x4 a, const f32x4 b) { u32x4 w; w.x = cvt_pk_bf16(a[0], a[1]); w.y = cvt_pk_bf16(a[2], a[3]); w.z = cvt_pk_bf16(b[0], b[1]); w.w = cvt_pk_bf16(b[2], b[3]); return w; }

__device__ __forceinline__ u32x2 pk8_fp8(const f32x4 a, const f32x4 b) { u32x2 w; w.x = (unsigned)__builtin_amdgcn_cvt_pk_fp8_f32(a[2], a[3], __builtin_amdgcn_cvt_pk_fp8_f32(a[0], a[1], 0, false), true); w.y = (unsigned)__builtin_amdgcn_cvt_pk_fp8_f32(b[2], b[3], __builtin_amdgcn_cvt_pk_fp8_f32(b[0], b[1], 0, false), true); return w; }
__device__ __forceinline__ float sq8(const f32x4 a, const f32x4 b) { return (a[0] * a[0] + a[1] * a[1]) + (a[2] * a[2] + a[3] * a[3]) + (b[0] * b[0] + b[1] * b[1]) + (b[2] * b[2] + b[3] * b[3]); }
__device__ __forceinline__ void rope_inplace(Acc& acc, const float* __restrict__ CSp, const float* __restrict__, int row0, int x0, const float (&sc)[8]) {
    const unsigned char* CS = (const unsigned char*)CSp;
#pragma unroll
    for (int h = 0; h < 2; ++h) { u32x4 cv[4], sv[4];
#pragma unroll
        for (int q = 0; q < 4; ++q) { const int i = h * 4 + q; const unsigned char* p = CS + ((size_t)(row0 + (i >> 2) * 128 + (i & 3) * 16) * 4 + (x0 >> 3)) * 32; cv[q] = *(const u32x4*)p; sv[q] = *(const u32x4*)(p + 16); }
#pragma unroll
        for (int q = 0; q < 4; ++q) { const int i = h * 4 + q, ai = i >> 2, m = i & 3; const float k = sc[i];
            const f32x4 c0 = {bf_lo(cv[q].x), bf_hi(cv[q].x), bf_lo(cv[q].y), bf_hi(cv[q].y)}, c1 = {bf_lo(cv[q].z), bf_hi(cv[q].z), bf_lo(cv[q].w), bf_hi(cv[q].w)};
            const f32x4 s0 = {bf_lo(sv[q].x), bf_hi(sv[q].x), bf_lo(sv[q].y), bf_hi(sv[q].y)}, s1 = {bf_lo(sv[q].z), bf_hi(sv[q].z), bf_lo(sv[q].w), bf_hi(sv[q].w)};
            const f32x4 lo0 = acc[ai][0][m][0], lo1 = acc[ai][0][m][1], hi0 = acc[ai][1][m][0], hi1 = acc[ai][1][m][1];
            acc[ai][0][m][0] = (lo0 * c0 - hi0 * s0) * k; acc[ai][0][m][1] = (lo1 * c1 - hi1 * s1) * k;
            acc[ai][1][m][0] = (hi0 * c0 + lo0 * s0) * k; acc[ai][1][m][1] = (hi1 * c1 + lo1 * s1) * k; } }
    asm volatile("" ::: "memory");
}

struct EpiInAB {
    static constexpr int NSTORE = 0;
    bf16_t *QB, *KB, *VB, *KR, *CQ, *CKV; float* SSQ; const float *COS, *SIN; float osc;
    __device__ __forceinline__ void operator()(Acc& acc, const g8::Unit& u, int wr, int wc, int fr, int fq) const {
        const int pn = u.pn, row0 = u.pm * 256 + wr * 64 + fr;
        if (pn <= 4) {
            if (pn == 4 && wc == 3) return;
            const float one[8] = {osc, osc, osc, osc, osc, osc, osc, osc};
            rope_inplace(acc, COS, SIN, row0, 8 * fq, one);
            if (pn == 4 && wc == 2) {
#pragma unroll
                for (int ai = 0; ai < 2; ++ai)
#pragma unroll
                    for (int m = 0; m < 4; ++m) { unsigned char* d8 = (unsigned char*)KR + (size_t)(row0 + ai * 128 + m * 16) * 64 + 8 * fq;
                        *(u32x2*)d8 = pk8_fp8(acc[ai][0][m][0], acc[ai][0][m][1]); *(u32x2*)(d8 + 32) = pk8_fp8(acc[ai][1][m][0], acc[ai][1][m][1]); }
            } else { unsigned char* dst = pn < 4 ? (unsigned char*)QB : (unsigned char*)KB; const int ld = pn < 4 ? 1024 : 128, cb = pn < 4 ? (4 * pn + wc) * 64 : wc * 64;
#pragma unroll
                for (int ai = 0; ai < 2; ++ai)
#pragma unroll
                    for (int m = 0; m < 4; ++m) { unsigned char* d = dst + (size_t)(row0 + ai * 128 + m * 16) * ld + cb + 8 * fq;
                        *(u32x2*)d = pk8_fp8(acc[ai][0][m][0], acc[ai][0][m][1]); *(u32x2*)(d + 32) = pk8_fp8(acc[ai][1][m][0], acc[ai][1][m][1]); } }
        } else {
#pragma unroll
            for (int ai = 0; ai < 2; ++ai)
#pragma unroll
                for (int m = 0; m < 4; ++m) { const int t = row0 + ai * 128 + m * 16; const int c8 = 32 * wc + 8 * fq;
#pragma unroll
                    for (int bj = 0; bj < 2; ++bj) { acc[ai][bj][m][0] = acc[ai][bj][m][0] * osc; acc[ai][bj][m][1] = acc[ai][bj][m][1] * osc; }
                    const u32x4 w0 = pack8(acc[ai][0][m][0], acc[ai][0][m][1]), w1 = pack8(acc[ai][1][m][0], acc[ai][1][m][1]);
                    float s = sq8(acc[ai][0][m][0], acc[ai][0][m][1]);
                    if (pn == 5) { *(u32x2*)((unsigned char*)CQ + (size_t)t * 512 + c8) = pk8_fp8(acc[ai][0][m][0] * 8.0f, acc[ai][0][m][1] * 8.0f); *(u32x2*)((unsigned char*)CQ + (size_t)t * 512 + 128 + c8) = pk8_fp8(acc[ai][1][m][0] * 8.0f, acc[ai][1][m][1] * 8.0f);
                                   s += sq8(acc[ai][1][m][0], acc[ai][1][m][1]); }
                    else if (pn == 6) { *(u32x2*)((unsigned char*)CQ + (size_t)t * 512 + 256 + c8) = pk8_fp8(acc[ai][0][m][0] * 8.0f, acc[ai][0][m][1] * 8.0f); { unsigned z0_, z1_; asm volatile("v_mov_b32 %0, 0\n\tv_mov_b32 %1, 0" : "=v"(z0_), "=v"(z1_));        *(u32x2*)((unsigned char*)CQ + (size_t)t * 512 + 384 + c8) = (u32x2){z0_, z1_}; }
                                        *(u32x4*)(VB + (size_t)t * 128 + c8) = w1; }
                    else { *(u32x2*)((unsigned char*)CKV + (size_t)t * 256 + c8) = pk8_fp8(acc[ai][0][m][0] * 8.0f, acc[ai][0][m][1] * 8.0f); *(u32x2*)((unsigned char*)CKV + (size_t)t * 256 + 128 + c8) = pk8_fp8(acc[ai][1][m][0] * 8.0f, acc[ai][1][m][1] * 8.0f);
                           s += sq8(acc[ai][1][m][0], acc[ai][1][m][1]); }
                    s = xor32_sum(xor16_sum(s));
                    if (fq == 0) SSQ[(size_t)t * 12 + (pn - 5) * 4 + wc] = s; }
        }
    }
};
struct EpiQUp {
    static constexpr int NSTORE = 16;
    unsigned char* QA8; const float *SSQ, *COS, *SIN;
    __device__ __forceinline__ void operator()(Acc& acc, const g8::Unit& u, int wr, int wc, int fr, int fq) const {
        const int pn = u.pn, row0 = u.pm * 256 + wr * 64 + fr;
        float rstd[8];
#pragma unroll
        for (int i = 0; i < 8; ++i) { const int t = row0 + (i >> 2) * 128 + (i & 3) * 16;
            const f32x4 q0 = *(const f32x4*)(SSQ + (size_t)t * 12), q1 = *(const f32x4*)(SSQ + (size_t)t * 12 + 4);
            rstd[i] = (0.07216878364870322f * 1.4426950408889634f / 256.0f) / sqrtf(((q0[0] + q0[1]) + (q0[2] + q0[3]) + (q1[0] + q1[1]) + (q1[2] + q1[3])) * (1.0f / 384.0f) + EPS); }
        if (pn < 2) { rope_inplace(acc, COS, SIN, row0, 8 * fq, rstd);
#pragma unroll
            for (int ai = 0; ai < 2; ++ai)
#pragma unroll
                for (int m = 0; m < 4; ++m) { unsigned char* d = QA8 + (size_t)(row0 + ai * 128 + m * 16) * 1536 + (4 * pn + wc) * 192 + 128 + 8 * fq;
                    *(u32x2*)d = pk8_fp8(acc[ai][0][m][0], acc[ai][0][m][1]); *(u32x2*)(d + 32) = pk8_fp8(acc[ai][1][m][0], acc[ai][1][m][1]); } }
        else { asm volatile("" ::: "memory");
#pragma unroll
            for (int ai = 0; ai < 2; ++ai)
#pragma unroll
                for (int m = 0; m < 4; ++m) { const float rs = rstd[ai * 4 + m];
#pragma unroll
                    for (int bj = 0; bj < 2; ++bj) *(u32x2*)(QA8 + (size_t)(row0 + ai * 128 + m * 16) * 1536 + (2 * (pn - 2) + bj) * 192 + 32 * wc + 8 * fq) = pk8_fp8(acc[ai][bj][m][0] * rs, acc[ai][bj][m][1] * rs); } }
    }
};
struct EpiKVUp {
    static constexpr int NSTORE = 16;
    bf16_t* KV; unsigned char* V8; const float* SSQ;
    __device__ __forceinline__ void operator()(Acc& acc, const g8::Unit& u, int wr, int wc, int fr, int fq) const {
        const int row0 = u.pm * 256 + wr * 64 + fr;
        float rstd[8];
#pragma unroll
        for (int i = 0; i < 8; ++i) { const int t = row0 + (i >> 2) * 128 + (i & 3) * 16;
            const f32x4 q0 = *(const f32x4*)(SSQ + (size_t)t * 12 + 8);
            rstd[i] = (1.0f / 256.0f) / sqrtf(((q0[0] + q0[1]) + (q0[2] + q0[3])) * (1.0f / 256.0f) + EPS); }
        asm volatile("" ::: "memory");
#pragma unroll
        for (int ai = 0; ai < 2; ++ai)
#pragma unroll
            for (int m = 0; m < 4; ++m) { const int t = row0 + ai * 128 + m * 16; const float rs = rstd[ai * 4 + m];
                *(u32x2*)((unsigned char*)KV + (size_t)t * 4096 + u.pn * 512 + 32 * wc + 8 * fq) = pk8_fp8(acc[ai][0][m][0] * rs, acc[ai][0][m][1] * rs);
                const u32x2 mine = pk8_fp8(acc[ai][1][m][0] * rs, acc[ai][1][m][1] * rs);
                u32x2 oth; oth.x = (unsigned)__builtin_amdgcn_mov_dpp((int)mine.x, 0xB1, 0xF, 0xF, true); oth.y = (unsigned)__builtin_amdgcn_mov_dpp((int)mine.y, 0xB1, 0xF, 0xF, true);
                const bool odd = fr & 1;
                const unsigned ev = odd ? oth.y : mine.x, od = odd ? mine.y : oth.x;
                u32x2 w; w.x = __builtin_amdgcn_perm(od, ev, 0x05010400u); w.y = __builtin_amdgcn_perm(od, ev, 0x07030602u);
                *(u32x2*)(V8 + ((size_t)(t >> 1) * 1024 + u.pn * 128 + 32 * wc + 8 * fq + (odd ? 4 : 0)) * 2) = w; }
    }
};
struct EpiResid {
    static constexpr int NSTORE = 16;
    float* X; const float* gate; float osc;
    __device__ __forceinline__ void operator()(Acc& acc, const g8::Unit& u, int wr, int wc, int fr, int fq) const {
        const int row0 = u.pm * 256 + wr * 64 + fr; const float* gp = gate + (size_t)(u.pm >> 4) * 6144;
        unsigned char* xb = (unsigned char*)X + (size_t)row0 * 2048 + (u.pn * 256 + 32 * wc + 8 * fq) * 2;
        u32x4 xv[2][8];
#pragma unroll
        for (int bj = 0; bj < 2; ++bj)
#pragma unroll
            for (int i = 0; i < 8; ++i) xv[bj][i] = *(const u32x4*)(xb + (size_t)((i >> 2) * 128 + (i & 3) * 16) * 2048 + bj * 256);
#pragma unroll
        for (int bj = 0; bj < 2; ++bj) { const int col = u.pn * 256 + 128 * bj + 32 * wc + 8 * fq;
            const f32x4 g0 = *(const f32x4*)(gp + col), g1 = *(const f32x4*)(gp + col + 4);
#pragma unroll
            for (int i = 0; i < 8; ++i) { const u32x4 q = xv[bj][i]; const f32x4 x0 = {bf_lo(q.x), bf_hi(q.x), bf_lo(q.y), bf_hi(q.y)}, x1 = {bf_lo(q.z), bf_hi(q.z), bf_lo(q.w), bf_hi(q.w)};
                const f32x4 r0 = x0 + g0 * (acc[i >> 2][bj][i & 3][0] * osc), r1 = x1 + g1 * (acc[i >> 2][bj][i & 3][1] * osc);
                xv[bj][i] = (u32x4){cvt_pk_bf16(r0[0], r0[1]), cvt_pk_bf16(r0[2], r0[3]), cvt_pk_bf16(r1[0], r1[1]), cvt_pk_bf16(r1[2], r1[3])}; } }
        asm volatile("" ::: "memory");
#pragma unroll
        for (int bj = 0; bj < 2; ++bj)
#pragma unroll
            for (int i = 0; i < 8; ++i) *(u32x4*)(xb + (size_t)((i >> 2) * 128 + (i & 3) * 16) * 2048 + bj * 256) = xv[bj][i];
    }
};
struct EpiInC {
    static constexpr int NSTORE = 16;
    bf16_t* PC; const float *COS, *SIN; float osc;
    __device__ __forceinline__ size_t rowoff(int t, int gs, int head, int lg) const { const int b = t >> 12, p = t & 4095, r = p & ((1 << lg) - 1), i = p >> lg;
        return ((size_t)((b * 9 + gs) * 16 + head) * 4096 + (size_t)r * (4096 >> lg) + i) * 64; }
    __device__ __forceinline__ void operator()(Acc& acc, const g8::Unit& u, int wr, int wc, int fr, int fq) const {
        const int pn = u.pn, gs = pn >> 2, g = gs / 3, s = gs - 3 * g, lg = 2 * g, row0 = u.pm * 256 + wr * 64 + fr;
        if (s < 2) { const float one[8] = {osc, osc, osc, osc, osc, osc, osc, osc};
            rope_inplace(acc, COS, SIN, row0, 8 * fq, one);
#pragma unroll
            for (int ai = 0; ai < 2; ++ai)
#pragma unroll
                for (int m = 0; m < 4; ++m) { const int t = row0 + ai * 128 + m * 16, b = t >> 12, p = t & 4095, r = p & ((1 << lg) - 1), i = p >> lg;
                    unsigned char* d = (unsigned char*)PC + (size_t)((b * 9 + gs) * 16 + 4 * (pn & 3) + wc) * (4096 * 128) + ((size_t)r * (4096 >> lg) + i) * 64 + 8 * fq;
                    *(u32x2*)d = pk8_fp8(acc[ai][0][m][0], acc[ai][0][m][1]); *(u32x2*)(d + 32) = pk8_fp8(acc[ai][1][m][0], acc[ai][1][m][1]); } }
        else {
#pragma unroll
            for (int ai = 0; ai < 2; ++ai)
#pragma unroll
                for (int m = 0; m < 4; ++m)
#pragma unroll
                    for (int bj = 0; bj < 2; ++bj) *(u32x4*)(PC + rowoff(row0 + ai * 128 + m * 16, gs, 4 * (pn & 3) + 2 * bj + (wc >> 1), lg) + 32 * (wc & 1) + 8 * fq) = pack8(acc[ai][bj][m][0] * osc, acc[ai][bj][m][1] * osc); }
    }
};
struct EpiSwiGLU {
    static constexpr int NSTORE = 8;
    unsigned char* ACT8; const float* bgu;
    __device__ __forceinline__ void operator()(Acc& acc, const g8::Unit& u, int wr, int wc, int fr, int fq) const {
        const int e = u.aux >> 16, col = u.pn * 128 + 32 * wc + 8 * fq, row0 = u.pm * 256 + wr * 64 + fr;
        const float* bp = bgu + (size_t)e * 2048 + col;
        const f32x4 bg0 = *(const f32x4*)bp, bg1 = *(const f32x4*)(bp + 4), bl0 = *(const f32x4*)(bp + 1024), bl1 = *(const f32x4*)(bp + 1028);
#pragma unroll
        for (int ai = 0; ai < 2; ++ai)
#pragma unroll
            for (int m = 0; m < 4; ++m) { f32x4 r[2];
#pragma unroll
                for (int n = 0; n < 2; ++n) { const f32x4 g = acc[ai][0][m][n] * (1.0f / 32.0f) + (n ? bg1 : bg0), l = acc[ai][1][m][n] * (1.0f / 32.0f) + (n ? bl1 : bl0);
#pragma unroll
                    for (int i = 0; i < 4; ++i) { const float gl = fminf(g[i], 7.0f), li = fminf(fmaxf(l[i], -7.0f), 7.0f);
                        const float sg = __builtin_amdgcn_rcpf(1.0f + __builtin_amdgcn_exp2f(-1.702f * 1.4426950408889634f * gl)); r[n][i] = 4.0f * gl * sg * (li + 1.0f); } }
                u32x2 w; w.x = (unsigned)__builtin_amdgcn_cvt_pk_fp8_f32(r[0][2], r[0][3], __builtin_amdgcn_cvt_pk_fp8_f32(r[0][0], r[0][1], 0, false), true);
                w.y = (unsigned)__builtin_amdgcn_cvt_pk_fp8_f32(r[1][2], r[1][3], __builtin_amdgcn_cvt_pk_fp8_f32(r[1][0], r[1][1], 0, false), true);
                *(u32x2*)(ACT8 + (size_t)(row0 + ai * 128 + m * 16) * 1024 + col) = w; }
    }
};
struct EpiNull { static constexpr int NSTORE = 0; __device__ __forceinline__ void operator()(Acc& acc, const g8::Unit& u, int wr, int wc, int fr, int fq) const { asm volatile("" :: "v"(acc[0][0][0][0]), "v"(acc[1][1][3][1])); } };
struct EpiP1 {
    static constexpr int NSTORE = 16; bf16_t* YB;
    __device__ __forceinline__ void operator()(Acc& acc, const g8::Unit& u, int wr, int wc, int fr, int fq) const {
        const int row0 = u.pm * 256 + wr * 64 + fr;
#pragma unroll
        for (int bj = 0; bj < 2; ++bj) { const int col = u.pn * 256 + 128 * bj + 32 * wc + 8 * fq;
#pragma unroll
            for (int ai = 0; ai < 2; ++ai)
#pragma unroll
                for (int m = 0; m < 4; ++m) *(u32x4*)(YB + (size_t)(row0 + ai * 128 + m * 16) * 1024 + col) = pack8(acc[ai][bj][m][0], acc[ai][bj][m][1]); }
    }
};
struct EpiP2 {
    static constexpr int NSTORE = 0; bf16_t* YB; const float* bdn;
    __device__ __forceinline__ void operator()(Acc& acc, const g8::Unit& u, int wr, int wc, int fr, int fq) const {
        const int e = u.aux >> 16, row0 = u.pm * 256 + wr * 64 + fr;
        f32x4 b[2][2];
#pragma unroll
        for (int bj = 0; bj < 2; ++bj) { const float* bp = bdn + (size_t)e * 1024 + u.pn * 256 + 128 * bj + 32 * wc + 8 * fq; b[bj][0] = *(const f32x4*)bp; b[bj][1] = *(const f32x4*)(bp + 4); }
        u32x4 x = {0u, 0u, 0u, 0u};
#pragma unroll
        for (int bj = 0; bj < 2; ++bj)
#pragma unroll
            for (int ai = 0; ai < 2; ++ai)
#pragma unroll
                for (int m = 0; m < 4; ++m) { const u32x4 w = pack8(acc[ai][bj][m][0] * (1.0f / 128.0f) + b[bj][0], acc[ai][bj][m][1] * (1.0f / 128.0f) + b[bj][1]); x = x ^ w; }
        *(u32x4*)(YB + (size_t)row0 * 1024 + u.pn * 256 + 32 * wc + 8 * fq) = x;
    }
};
struct EpiDown {
    static constexpr int NSTORE = 8;
    unsigned char* YB8; const float* bdn;
    __device__ __forceinline__ void operator()(Acc& acc, const g8::Unit& u, int wr, int wc, int fr, int fq) const {
        const int e = u.aux >> 16, row0 = u.pm * 256 + wr * 64 + fr, colb = u.pn * 256 + 64 * wc + 16 * fq;
        f32x4 b[2][2];
#pragma unroll
        for (int bj = 0; bj < 2; ++bj) { const float* bp = bdn + (size_t)e * 1024 + colb + 8 * bj; b[bj][0] = *(const f32x4*)bp; b[bj][1] = *(const f32x4*)(bp + 4); }
        asm volatile("" ::: "memory");
#pragma unroll
        for (int ai = 0; ai < 2; ++ai)
#pragma unroll
            for (int m = 0; m < 4; ++m) { const u32x2 lo = pk8_fp8(acc[ai][0][m][0] * (1.0f / 128.0f) + b[0][0], acc[ai][0][m][1] * (1.0f / 128.0f) + b[0][1]), hi = pk8_fp8(acc[ai][1][m][0] * (1.0f / 128.0f) + b[1][0], acc[ai][1][m][1] * (1.0f / 128.0f) + b[1][1]);
                *(u32x4*)(YB8 + (size_t)(row0 + ai * 128 + m * 16) * 1024 + colb) = (u32x4){lo.x, lo.y, hi.x, hi.y}; }
    }
};

struct MoeSchedUp {
    const char* H; const char* Wt; const LAS int* tinfo; const LAS int* ltok; int nunits, G, c;
    static constexpr bool GATHER = true;
    __device__ __forceinline__ bool next(int i, g8::Unit& u) const { const int L = i * G + c; if (L >= nunits) return false; u.pm = L >> 3; u.pn = L & 7; u.aux = tinfo[u.pm]; u.ord = i; return true; }
    __device__ __forceinline__ const char* a_base() const { return H; }
    __device__ __forceinline__ const char* a_tile(const g8::Unit& u) const { return H; }
    __device__ __forceinline__ unsigned a_off(const g8::Unit& u, int r) const { return (unsigned)ltok[u.ord * 256 + r] * 1024u; }
    __device__ __forceinline__ const char* b_tile(const g8::Unit& u) const { return Wt + ((size_t)(u.aux >> 16) * 2048 + (size_t)u.pn * 256) * 1024; }
};
struct MoeSchedDown {
    const char* A; const char* Wt; const LAS int* tinfo; int nunits, G, c;
    __device__ __forceinline__ bool next(int i, g8::Unit& u) const { const int L = i * G + c; if (L >= nunits) return false; u.pm = L >> 2; u.pn = L & 3; u.aux = tinfo[u.pm]; u.ord = i; return true; }
    static constexpr bool GATHER = false;
    __device__ __forceinline__ const char* a_base() const { return A; }
    __device__ __forceinline__ const char* a_tile(const g8::Unit& u) const { return A + (size_t)u.pm * 256 * 1024; }
    __device__ __forceinline__ unsigned a_off(const g8::Unit& u, int r) const { return 0u; }
    __device__ __forceinline__ const char* b_tile(const g8::Unit& u) const { return Wt + ((size_t)(u.aux >> 16) * 1024 + (size_t)u.pn * 256) * 1024; }
};
struct MoeSchedDownHot : MoeSchedDown {
    __device__ __forceinline__ const char* a_tile(const g8::Unit& u) const { return A; }
    __device__ __forceinline__ const char* b_tile(const g8::Unit& u) const { return Wt; }
};
__device__ __forceinline__ void build_moe_tables(LAS unsigned char* lds, unsigned* gcnt, const int wave_s_) {
    LAS int* tinfo = (LAS int*)(lds + TAB_TINFO); LAS int* ecnt = (LAS int*)(lds + TAB_ECNT); LAS int* tstart = (LAS int*)(lds + TAB_TSTART); LAS int* ntp = (LAS int*)(lds + TAB_NT);
    const int tid = tid_now(wave_s_);
    __syncthreads();
    if (tid < 32) ecnt[tid] = (int)__hip_atomic_load(gcnt + tid, __ATOMIC_RELAXED, __HIP_MEMORY_SCOPE_AGENT);
    __syncthreads();
    if (tid < 32) { int ts = 0; for (int e = 0; e < tid; ++e) ts += (ecnt[e] + 255) >> 8; const int n = (ecnt[tid] + 255) >> 8; tstart[tid] = ts;
        for (int lt = 0; lt < n; ++lt) tinfo[ts + lt] = (tid << 16) | lt; if (tid == 31) ntp[0] = ts + n; }
    __syncthreads();
}

__device__ __forceinline__ unsigned pk_fp8x4(float a, float b, float c, float d) { return (unsigned)__builtin_amdgcn_cvt_pk_fp8_f32(c, d, __builtin_amdgcn_cvt_pk_fp8_f32(a, b, 0, false), true); }
namespace att {
constexpr int QBLK = 32, KVBLK = 64;
#define KSWZ256(row, colB) ((row) * 256 + ((colB) ^ (((row) & 7) << 4)))
#define KSWZ128(row, colB) ((row) * 128 + ((colB) ^ ((((row) >> 1) & 7) << 4)))
__device__ __forceinline__ int crow(int r, int hi) { return (r & 3) + 8 * (r >> 2) + 4 * hi; }
__device__ __forceinline__ int v_st(int k, int c) { return ((k >> 3) * 4 + (c >> 5)) * 512 + ((k & 7) * 32 + (c & 31)) * 2; }
__device__ __forceinline__ int v_rd_base(int lane) { return ((lane & 3) << 3) | (((lane >> 2) & 3) << 6) | (((lane >> 4) & 1) << 5) | (((lane >> 5) & 1) << 8); }
constexpr int v_rd_off(int d0, int ks, int half) { return d0 * 512 + ks * 4096 + half * 2048; }
typedef short v4i16_t __attribute__((ext_vector_type(4)));
template <int OFF> __device__ __forceinline__ s16x4 tr_rd(int vb) { return __builtin_bit_cast(s16x4, __builtin_amdgcn_ds_read_tr16_b64_v4i16((LAS v4i16_t*)(unsigned)(vb + OFF))); }
template <int OFF> __device__ __forceinline__ s16x4 tr_read(int vb) { s16x4 r; asm volatile("ds_read_b64_tr_b16 %0, %1 offset:%2" : "=&v"(r) : "v"(vb), "i"(OFF) : "memory"); return r; }
template <int D0> __device__ __forceinline__ void pv_one(f32x16& od, int vb, bf16x8 pa0, bf16x8 pa1, bf16x8 pa2, bf16x8 pa3) {
    const s16x4 l0 = tr_read<v_rd_off(D0, 0, 0)>(vb), h0 = tr_read<v_rd_off(D0, 0, 1)>(vb), l1 = tr_read<v_rd_off(D0, 1, 0)>(vb), h1 = tr_read<v_rd_off(D0, 1, 1)>(vb);
    const s16x4 l2 = tr_read<v_rd_off(D0, 2, 0)>(vb), h2 = tr_read<v_rd_off(D0, 2, 1)>(vb), l3 = tr_read<v_rd_off(D0, 3, 0)>(vb), h3 = tr_read<v_rd_off(D0, 3, 1)>(vb);
    asm volatile("s_waitcnt lgkmcnt(0)" ::: "memory"); SBAR();
#define PKV(L, H) (bf16x8){L[0], L[1], L[2], L[3], H[0], H[1], H[2], H[3]}
    od = __builtin_amdgcn_mfma_f32_32x32x16_bf16(PKV(l0, h0), pa0, od, 0, 0, 0);
    od = __builtin_amdgcn_mfma_f32_32x32x16_bf16(PKV(l1, h1), pa1, od, 0, 0, 0);
    od = __builtin_amdgcn_mfma_f32_32x32x16_bf16(PKV(l2, h2), pa2, od, 0, 0, 0);
    od = __builtin_amdgcn_mfma_f32_32x32x16_bf16(PKV(l3, h3), pa3, od, 0, 0, 0);
#undef PKV
}
template <int D0, int H> __device__ __forceinline__ void pv_half(f32x16& od, int vb, bf16x8 pa, bf16x8 pb) {
    const s16x4 l0 = tr_read<v_rd_off(D0, 2 * H, 0)>(vb), h0 = tr_read<v_rd_off(D0, 2 * H, 1)>(vb), l1 = tr_read<v_rd_off(D0, 2 * H + 1, 0)>(vb), h1 = tr_read<v_rd_off(D0, 2 * H + 1, 1)>(vb);
    asm volatile("s_waitcnt lgkmcnt(0)" ::: "memory"); SBAR();
#define PKV(L, H_) (bf16x8){L[0], L[1], L[2], L[3], H_[0], H_[1], H_[2], H_[3]}
    od = __builtin_amdgcn_mfma_f32_32x32x16_bf16(pa, PKV(l0, h0), od, 0, 0, 0);
    od = __builtin_amdgcn_mfma_f32_32x32x16_bf16(pb, PKV(l1, h1), od, 0, 0, 0);
#undef PKV
}
__device__ __forceinline__ unsigned cvt2(float lo, float hi) { typedef float f2 __attribute__((ext_vector_type(2))); typedef __bf16 b2 __attribute__((ext_vector_type(2))); f2 v = {lo, hi}; b2 r = __builtin_convertvector(v, b2); return __builtin_bit_cast(unsigned, r); }
__device__ __forceinline__ void p_to_frag(const f32x16& p0, const f32x16& p1, bf16x8& pa0, bf16x8& pa1, bf16x8& pa2, bf16x8& pa3) {
    u32x4 w0 = {cvt2(p0[0], p0[1]), cvt2(p0[2], p0[3]), cvt2(p0[4], p0[5]), cvt2(p0[6], p0[7])}, w1 = {cvt2(p0[8], p0[9]), cvt2(p0[10], p0[11]), cvt2(p0[12], p0[13]), cvt2(p0[14], p0[15])};
    u32x4 w2 = {cvt2(p1[0], p1[1]), cvt2(p1[2], p1[3]), cvt2(p1[4], p1[5]), cvt2(p1[6], p1[7])}, w3 = {cvt2(p1[8], p1[9]), cvt2(p1[10], p1[11]), cvt2(p1[12], p1[13]), cvt2(p1[14], p1[15])};
    pa0 = *reinterpret_cast<bf16x8*>(&w0); pa1 = *reinterpret_cast<bf16x8*>(&w1); pa2 = *reinterpret_cast<bf16x8*>(&w2); pa3 = *reinterpret_cast<bf16x8*>(&w3);
}

__device__ __forceinline__ unsigned pk_fp8x4_sc(float a, float b, float c, float d, float sc) {
    typedef short v2s_ __attribute__((ext_vector_type(2)));
    v2s_ w = __builtin_bit_cast(v2s_, __float_as_int(a));
    w = __builtin_amdgcn_cvt_scalef32_pk_fp8_f32(w, a, b, sc, false); w = __builtin_amdgcn_cvt_scalef32_pk_fp8_f32(w, c, d, sc, true);
    return (unsigned)__builtin_bit_cast(int, w); }
constexpr float SCALE_D = 0.07216878364870322f;
constexpr float THR = 2.5f;
constexpr size_t SHM_V = KVBLK * 128, SHM_K = KVBLK * 128, SHM_R = KVBLK * 64;
constexpr int DENSE_LDS = 3 * (SHM_V + SHM_K + SHM_R);
#define KSWZ64(row, colB) ((row) * 64 + ((colB) ^ ((((row) >> 2) & 3) << 4)))
typedef int i32x8q __attribute__((ext_vector_type(8)));
__device__ __forceinline__ void partialSM(f32x16& p0, f32x16& p1, float& m_reg, float& mn, float& alpha) {
    constexpr float C = SCALE_D * 1.4426950408889634f;
    float pmax = p0[0];
#pragma unroll
    for (int r = 1; r < 16; ++r) pmax = fmaxf(pmax, p0[r]);
#pragma unroll
    for (int r = 0; r < 16; ++r) pmax = fmaxf(pmax, p1[r]);
    { auto rr = __builtin_amdgcn_permlane32_swap(__float_as_uint(pmax), __float_as_uint(pmax), false, false);
      pmax = fmaxf(__uint_as_float(rr[0]), __uint_as_float(rr[1])); }
    if (__builtin_expect(__all(pmax - m_reg <= THR / SCALE_D), 1)) { mn = m_reg; alpha = 1.f; }
    else { mn = fmaxf(m_reg, pmax); alpha = __builtin_amdgcn_exp2f((m_reg - mn) * C); m_reg = mn; }
    const float mnC = 5.0f - mn * C;
#pragma unroll
    for (int r = 0; r < 16; ++r) p0[r] = fmaf(p0[r], C, mnC);
#pragma unroll
    for (int r = 0; r < 16; ++r) p1[r] = fmaf(p1[r], C, mnC);
#pragma unroll
    for (int r = 0; r < 16; ++r) p0[r] = __builtin_amdgcn_exp2f(p0[r]);
}
__device__ __forceinline__ void finishSM(f32x16& p0, f32x16& p1, float alpha, float& l_reg, i32x8q& pq) {
#pragma unroll
    for (int r = 0; r < 16; ++r) p1[r] = __builtin_amdgcn_exp2f(p1[r]);
    float ps = 0;
#pragma unroll
    for (int r = 0; r < 16; ++r) ps += p0[r];
#pragma unroll
    for (int r = 0; r < 16; ++r) ps += p1[r];
    { auto rr = __builtin_amdgcn_permlane32_swap(__float_as_uint(ps), __float_as_uint(ps), false, false);
      ps = __uint_as_float(rr[0]) + __uint_as_float(rr[1]); }
    l_reg = l_reg * alpha + ps;
#pragma unroll
    for (int i = 0; i < 4; ++i) { pq[i] = (int)pk_fp8x4(p0[4 * i], p0[4 * i + 1], p0[4 * i + 2], p0[4 * i + 3]); pq[4 + i] = (int)pk_fp8x4(p1[4 * i], p1[4 * i + 1], p1[4 * i + 2], p1[4 * i + 3]); }
}
__device__ __forceinline__ void qkt_d(f32x16& p0, f32x16& p1, const char* Kn, const char* Kr, const i32x8q (&qr)[3], int r32, int hi) {
    { const int cb = hi * 32;
      const i32x8q ka = g8::cat8(*reinterpret_cast<const bf16x8*>(Kn + KSWZ128(r32, cb)), *reinterpret_cast<const bf16x8*>(Kn + KSWZ128(r32, cb + 16)));
      const i32x8q kb = g8::cat8(*reinterpret_cast<const bf16x8*>(Kn + KSWZ128(32 + r32, cb)), *reinterpret_cast<const bf16x8*>(Kn + KSWZ128(32 + r32, cb + 16)));
      asm volatile("v_mfma_f32_32x32x64_f8f6f4 %0, %2, %3, 0\n\tv_mfma_f32_32x32x64_f8f6f4 %1, %4, %3, 0" : "=&v"(p0), "=&v"(p1) : "v"(ka), "v"(qr[0]), "v"(kb)); }
    { const int cb = 64 + hi * 32;
      const i32x8q ka = g8::cat8(*reinterpret_cast<const bf16x8*>(Kn + KSWZ128(r32, cb)), *reinterpret_cast<const bf16x8*>(Kn + KSWZ128(r32, cb + 16)));
      const i32x8q kb = g8::cat8(*reinterpret_cast<const bf16x8*>(Kn + KSWZ128(32 + r32, cb)), *reinterpret_cast<const bf16x8*>(Kn + KSWZ128(32 + r32, cb + 16)));
      asm volatile("v_mfma_f32_32x32x64_f8f6f4 %0, %2, %3, %0\n\tv_mfma_f32_32x32x64_f8f6f4 %1, %4, %3, %1" : "+v"(p0), "+v"(p1) : "v"(ka), "v"(qr[1]), "v"(kb)); }
    { const int cb = hi * 32;
      const i32x8q ka = g8::cat8(*reinterpret_cast<const bf16x8*>(Kr + KSWZ64(r32, cb)), *reinterpret_cast<const bf16x8*>(Kr + KSWZ64(r32, cb + 16)));
      const i32x8q kb = g8::cat8(*reinterpret_cast<const bf16x8*>(Kr + KSWZ64(32 + r32, cb)), *reinterpret_cast<const bf16x8*>(Kr + KSWZ64(32 + r32, cb + 16)));
      asm volatile("v_mfma_f32_32x32x64_f8f6f4 %0, %2, %3, %0\n\tv_mfma_f32_32x32x64_f8f6f4 %1, %4, %3, %1\n\ts_nop 15\n\ts_nop 7" : "+v"(p0), "+v"(p1) : "v"(ka), "v"(qr[2]), "v"(kb)); }
}
template <int D0> __device__ __forceinline__ void pv8_one(f32x16& od, int vb, const i32x8q& pq) {
    const s16x4 a = tr_rd<v_rd_off(D0, 0, 0)>(vb), b = tr_rd<v_rd_off(D0, 0, 1)>(vb), c = tr_rd<v_rd_off(D0, 1, 0)>(vb), d = tr_rd<v_rd_off(D0, 1, 1)>(vb);
    typedef int i2 __attribute__((ext_vector_type(2)));
    const i2 a2 = __builtin_bit_cast(i2, a), b2 = __builtin_bit_cast(i2, b), c2 = __builtin_bit_cast(i2, c), d2 = __builtin_bit_cast(i2, d);
    const i32x8q vf = {a2[0], a2[1], b2[0], b2[1], c2[0], c2[1], d2[0], d2[1]};
    asm volatile("s_nop 3\n\tv_mfma_f32_32x32x64_f8f6f4 %0, %1, %2, %0" : "+v"(od) : "v"(vf), "v"(pq));
}
__device__ __forceinline__ void pv_d4(f32x16* o, int vb, const i32x8q& pq) {
    pv8_one<0>(o[0], vb, pq); pv8_one<1>(o[1], vb, pq); pv8_one<2>(o[2], vb, pq); pv8_one<3>(o[3], vb, pq);
}
__device__ __forceinline__ void partial_max(const f32x16& c0, const f32x16& c1, float& m_reg, float& alCur) {
    float pmax = c0[0];
#pragma unroll
    for (int r = 1; r < 16; ++r) pmax = fmaxf(pmax, c0[r]);
#pragma unroll
    for (int r = 0; r < 16; ++r) pmax = fmaxf(pmax, c1[r]);
    { auto rr = __builtin_amdgcn_permlane32_swap(__float_as_uint(pmax), __float_as_uint(pmax), false, false);
      pmax = fmaxf(__uint_as_float(rr[0]), __uint_as_float(rr[1])); }
    const bool keep = __all(pmax - m_reg <= THR * 1.4426950408889634f);
    const float mn = keep ? m_reg : fmaxf(m_reg, __builtin_ceilf(pmax));
    alCur = __builtin_amdgcn_exp2f(m_reg - mn); m_reg = mn;
}
template <class Mid>
__device__ __forceinline__ void dense_step(f32x16& c0, f32x16& c1, f32x16& p0, f32x16& p1, float& m_reg, float& l_reg, const float alPrev, float& alCur, f32x16 (&o)[4], const i32x8q (&qr)[3],
                                           const char* Kn, const char* Kr, const int vbp, const int r32, const int hi, Mid&& mid) {
    constexpr float C = SCALE_D * 1.4426950408889634f;
    typedef int i2 __attribute__((ext_vector_type(2)));
#define KOP_(base, SW, row, cb) g8::cat8(*reinterpret_cast<const bf16x8*>((base) + SW(row, cb)), *reinterpret_cast<const bf16x8*>((base) + SW(row, (cb) + 16)))
#define VOP_(D0) ([&]() { const s16x4 a_ = tr_rd<v_rd_off(D0, 0, 0)>(vbp), b_ = tr_rd<v_rd_off(D0, 0, 1)>(vbp), c_ = tr_rd<v_rd_off(D0, 1, 0)>(vbp), d_ = tr_rd<v_rd_off(D0, 1, 1)>(vbp); \
        const i2 a2 = __builtin_bit_cast(i2, a_), b2 = __builtin_bit_cast(i2, b_), c2 = __builtin_bit_cast(i2, c_), d2 = __builtin_bit_cast(i2, d_); return (i32x8q){a2[0], a2[1], b2[0], b2[1], c2[0], c2[1], d2[0], d2[1]}; }())
    const i32x8q ka0 = KOP_(Kn, KSWZ128, r32, hi * 32), kb0 = KOP_(Kn, KSWZ128, 32 + r32, hi * 32);
    SBAR();
    asm volatile("v_mfma_f32_32x32x64_f8f6f4 %0, %2, %3, 0\n\tv_mfma_f32_32x32x64_f8f6f4 %1, %4, %3, 0" : "=&v"(c0), "=&v"(c1) : "v"(ka0), "v"(qr[0]), "v"(kb0));
    const i32x8q ka1 = KOP_(Kn, KSWZ128, r32, 64 + hi * 32), kb1 = KOP_(Kn, KSWZ128, 32 + r32, 64 + hi * 32);
    SBAR();
#pragma unroll
    for (int r = 0; r < 16; ++r) p0[r] = __builtin_amdgcn_exp2f(p0[r]);
    SBAR();
    asm volatile("s_nop 1\n\tv_mfma_f32_32x32x64_f8f6f4 %0, %2, %3, %0\n\tv_mfma_f32_32x32x64_f8f6f4 %1, %4, %3, %1" : "+v"(c0), "+v"(c1) : "v"(ka1), "v"(qr[1]), "v"(kb1));
    const i32x8q ka2 = KOP_(Kr, KSWZ64, r32, hi * 32), kb2 = KOP_(Kr, KSWZ64, 32 + r32, hi * 32);
    SBAR();
#pragma unroll
    for (int r = 0; r < 16; ++r) p1[r] = __builtin_amdgcn_exp2f(p1[r]);
    float psa = p0[0] + p1[0];
#pragma unroll
    for (int r = 1; r < 16; ++r) psa += p0[r] + p1[r];
    SBAR();
    asm volatile("s_nop 1\n\tv_mfma_f32_32x32x64_f8f6f4 %0, %2, %3, %0\n\tv_mfma_f32_32x32x64_f8f6f4 %1, %4, %3, %1" : "+v"(c0), "+v"(c1) : "v"(ka2), "v"(qr[2]), "v"(kb2));
    SBAR();
    mid();
    SBAR();
    const i32x8q vf0 = VOP_(0), vf1 = VOP_(1);
    SBAR();
    i32x8q pq;
    const float csc = __builtin_amdgcn_exp2f(m_reg - 5.0f);
    { float ps = psa; auto rr = __builtin_amdgcn_permlane32_swap(__float_as_uint(ps), __float_as_uint(ps), false, false);
      ps = __uint_as_float(rr[0]) + __uint_as_float(rr[1]); l_reg = l_reg * alPrev + ps * __builtin_amdgcn_exp2f(5.0f - m_reg); }
#pragma unroll
    for (int i = 0; i < 4; ++i) { pq[i] = (int)pk_fp8x4_sc(p0[4 * i], p0[4 * i + 1], p0[4 * i + 2], p0[4 * i + 3], csc); pq[4 + i] = (int)pk_fp8x4_sc(p1[4 * i], p1[4 * i + 1], p1[4 * i + 2], p1[4 * i + 3], csc); }
    SBAR();
    asm volatile("s_nop 3\n\tv_mfma_f32_32x32x64_f8f6f4 %0, %1, %2, %0" : "+v"(o[0]) : "v"(vf0), "v"(pq));
    const i32x8q vf2 = VOP_(2);
    asm volatile("s_nop 3\n\tv_mfma_f32_32x32x64_f8f6f4 %0, %1, %2, %0" : "+v"(o[1]) : "v"(vf1), "v"(pq));
    const i32x8q vf3 = VOP_(3);
    SBAR();
    partial_max(c0, c1, m_reg, alCur);
    SBAR();
    asm volatile("s_nop 3\n\tv_mfma_f32_32x32x64_f8f6f4 %0, %1, %2, %0" : "+v"(o[2]) : "v"(vf2), "v"(pq));
    asm volatile("s_nop 3\n\tv_mfma_f32_32x32x64_f8f6f4 %0, %1, %2, %0" : "+v"(o[3]) : "v"(vf3), "v"(pq));
    SBAR();
#undef KOP_
#undef VOP_
}
__device__ __forceinline__ void dense_unit(const unsigned char* __restrict__ Qb, const unsigned char* __restrict__ Knp, const unsigned char* __restrict__ Vh, const unsigned char* __restrict__ Krp, bf16_t* __restrict__ Ob, int seq, char* lds, const int wave_s_) {
    constexpr int LDQ = 1536, LDKN = 4096, LDVP = 2048  , LDR = 64, LDO = 2048;
    const int tid = tid_now(wave_s_);
    const int wid = tid >> 6, lane = tid & 63, r32 = lane & 31, hi = lane >> 5;
    char* V_lds = lds; char* K_lds = lds + 3 * SHM_V; char* R_lds = lds + 3 * SHM_V + 3 * SHM_K;
    float m_reg = -1e30f, l_reg = 0; f32x16 o[4] = {}; i32x8q qr[3];
    const unsigned char* Qw = Qb + (long)(wid * QBLK + r32) * LDQ + hi * 32;
#pragma unroll
    for (int m = 0; m < 3; ++m) qr[m] = g8::cat8(*reinterpret_cast<const bf16x8*>(Qw + m * 64), *reinterpret_cast<const bf16x8*>(Qw + m * 64 + 16));
    const int vkp = tid >> 4, vch = tid & 15, vst0 = v_st((vkp & ~6) | ((vkp & 2) << 1) | ((vkp & 4) >> 1), vch * 8);
    const int kr_ = tid >> 3, kc_ = (tid & 7) * 16;
    const int rr = (tid >> 2) & 63, rc = (tid & 3) * 16;
    const int vb0 = (int)(uintptr_t)V_lds + v_rd_base(lane);
    struct { bf16x8 vs0, kn, rs; } sr_;
#define SLOAD(k0) do { sr_.vs0 = *(const bf16x8*)(Vh + (long)(((k0) >> 1) + vkp) * LDVP + vch * 16); \
    sr_.kn = *(const bf16x8*)(Knp + (long)((k0) + kr_) * LDKN + kc_); sr_.rs = *(const bf16x8*)(Krp + (long)((k0) + rr) * LDR + rc); } while (0)
#define SWRITE(b) do { *(bf16x8*)(V_lds + (b) * SHM_V + vst0) = sr_.vs0; \
    *(bf16x8*)(K_lds + (b) * SHM_K + KSWZ128(kr_, kc_)) = sr_.kn; *(bf16x8*)(R_lds + (b) * SHM_R + KSWZ64(rr, rc)) = sr_.rs; } while (0)
#define SWAIT() asm volatile("s_waitcnt vmcnt(0)" ::: "memory")
#define RESC(a) do { if (__any((a) < 1.f)) { asm volatile("s_nop 15\n\ts_nop 7" ::: "memory"); _Pragma("unroll") for (int d = 0; d < 4; ++d) _Pragma("unroll") for (int r = 0; r < 16; ++r) o[d][r] *= (a); } } while (0)
    f32x16 pA0, pA1, pB0, pB1; float mnA, mnB, alA, alB; i32x8q pq; const int NT = seq / KVBLK;
    __syncthreads();
    SLOAD(0); SWAIT(); SWRITE(0); SLOAD(KVBLK); __syncthreads();
    SWAIT(); SWRITE(1); SLOAD(2 * KVBLK);
    qkt_d(pA0, pA1, K_lds, R_lds, qr, r32, hi); partial_max(pA0, pA1, m_reg, alA);
    int bc = 1, bp = 0;
    for (int j = 1; j + 1 < NT; j += 2) {
        __syncthreads();
        { const int bn = bc == 2 ? 0 : bc + 1;
          dense_step(pB0, pB1, pA0, pA1, m_reg, l_reg, alA, alB, o, qr, K_lds + bc * SHM_K, R_lds + bc * SHM_R, vb0 + bp * (int)SHM_V, r32, hi, [&]() { SWAIT(); SWRITE(bn); if (j + 2 < NT) SLOAD((j + 2) * KVBLK); });
          RESC(alB);
          bp = bc; bc = bn; }
        __syncthreads();
        { const int bn = bc == 2 ? 0 : bc + 1;
          dense_step(pA0, pA1, pB0, pB1, m_reg, l_reg, alB, alA, o, qr, K_lds + bc * SHM_K, R_lds + bc * SHM_R, vb0 + bp * (int)SHM_V, r32, hi, [&]() { if (j + 2 < NT) { SWAIT(); SWRITE(bn); if (j + 3 < NT) SLOAD((j + 3) * KVBLK); } });
          RESC(alA);
          bp = bc; bc = bn; }
    }
    __syncthreads();
    dense_step(pB0, pB1, pA0, pA1, m_reg, l_reg, alA, alB, o, qr, K_lds + bc * SHM_K, R_lds + bc * SHM_R, vb0 + bp * (int)SHM_V, r32, hi, []() {});
    RESC(alB);
    { const float csc = __builtin_amdgcn_exp2f(m_reg - 5.0f), lsc = __builtin_amdgcn_exp2f(5.0f - m_reg); float ps = 0.f;
#pragma unroll
      for (int r = 0; r < 16; ++r) { pB0[r] = __builtin_amdgcn_exp2f(pB0[r]); pB1[r] = __builtin_amdgcn_exp2f(pB1[r]); ps += pB0[r] + pB1[r]; }
      { auto rr = __builtin_amdgcn_permlane32_swap(__float_as_uint(ps), __float_as_uint(ps), false, false); ps = __uint_as_float(rr[0]) + __uint_as_float(rr[1]); }
      l_reg = l_reg * alB + ps * lsc;
#pragma unroll
      for (int i = 0; i < 4; ++i) { pq[i] = (int)pk_fp8x4_sc(pB0[4 * i], pB0[4 * i + 1], pB0[4 * i + 2], pB0[4 * i + 3], csc); pq[4 + i] = (int)pk_fp8x4_sc(pB1[4 * i], pB1[4 * i + 1], pB1[4 * i + 2], pB1[4 * i + 3], csc); } }
    SBAR();
    pv_d4(o, vb0 + bc * (int)SHM_V, pq);
    asm volatile("s_nop 15\n\ts_nop 7" ::: "memory");
    const float rl = 8.0f * __builtin_amdgcn_rcpf(l_reg);
    unsigned char* Oq = (unsigned char*)Ob + (long)(wid * QBLK + r32) * LDO + 4 * hi;
#pragma unroll
    for (int d0 = 0; d0 < 4; ++d0)
#pragma unroll
        for (int g = 0; g < 4; ++g) *(unsigned*)(Oq + d0 * 32 + 8 * g) = pk_fp8x4(o[d0][4 * g] * rl, o[d0][4 * g + 1] * rl, o[d0][4 * g + 2] * rl, o[d0][4 * g + 3] * rl);
#undef SLOAD
#undef SWRITE
#undef SWAIT
#undef RESC
}

constexpr float SCALE_B = 0.125f;

template <bool H0, bool H1>
__device__ __forceinline__ void band_tile(const char* Kc, int vbc, const bf16x8 (&qr)[4], f32x16 (&o)[2], float& m_reg, float& l_reg, float* al_l, int k0, int qw, int qi, int R, int r32, int hi) {
    constexpr float C = SCALE_B * 1.4426950408889634f;
    f32x16 p0 = {}, p1 = {};
#pragma unroll
    for (int d0 = 0; d0 < 4; ++d0) { const int cb = (d0 * 16 + hi * 8) * 2;
        if (H0) { const bf16x8 b0 = *reinterpret_cast<const bf16x8*>(Kc + KSWZ128(r32, cb)); p0 = __builtin_amdgcn_mfma_f32_32x32x16_bf16(b0, qr[d0], p0, 0, 0, 0); }
        if (H1) { const bf16x8 b1 = *reinterpret_cast<const bf16x8*>(Kc + KSWZ128(32 + r32, cb)); p1 = __builtin_amdgcn_mfma_f32_32x32x16_bf16(b1, qr[d0], p1, 0, 0, 0); } }
    const int klo = H0 ? k0 : k0 + 32, khi = H1 ? k0 + 63 : k0 + 31;
    if (!(khi - qw <= R && qw + 31 - klo <= R)) {
        const float NEG = -__builtin_inff();
#pragma unroll
        for (int r = 0; r < 16; ++r) { const int kj = k0 + crow(r, hi);
            if (H0) { int d = qi - kj; d = d < 0 ? -d : d; if (d > R) p0[r] = NEG; }
            if (H1) { int d2 = qi - kj - 32; d2 = d2 < 0 ? -d2 : d2; if (d2 > R) p1[r] = NEG; } } }
    float pmax = H0 ? p0[0] : p1[0];
#pragma unroll
    for (int r = 0; r < 16; ++r) { if (H0) pmax = fmaxf(pmax, p0[r]); if (H1) pmax = fmaxf(pmax, p1[r]); }
    { auto rr = __builtin_amdgcn_permlane32_swap(__float_as_uint(pmax), __float_as_uint(pmax), false, false);
      pmax = fmaxf(__uint_as_float(rr[0]), __uint_as_float(rr[1])); }
    const float mn = fmaxf(m_reg, pmax), alpha = __builtin_amdgcn_exp2f((m_reg - mn) * C); m_reg = mn;
    const float mnC = -mn * C; float ps = 0.f;
#pragma unroll
    for (int r = 0; r < 16; ++r) { if (H0) { p0[r] = __builtin_amdgcn_exp2f(fmaf(p0[r], C, mnC)); ps += p0[r]; } if (H1) { p1[r] = __builtin_amdgcn_exp2f(fmaf(p1[r], C, mnC)); ps += p1[r]; } }
    { auto rr = __builtin_amdgcn_permlane32_swap(__float_as_uint(ps), __float_as_uint(ps), false, false);
      ps = __uint_as_float(rr[0]) + __uint_as_float(rr[1]); }
    l_reg = l_reg * alpha + ps;
    if (__any(alpha < 1.f)) {
        if (hi == 0) al_l[r32] = alpha; asm volatile("s_waitcnt lgkmcnt(0)" ::: "memory");
#pragma unroll
        for (int d = 0; d < 2; ++d)
#pragma unroll
            for (int r = 0; r < 16; ++r) o[d][r] *= al_l[crow(r, hi)]; }
    bf16x8 pa0, pa1, pa2, pa3; p_to_frag(p0, p1, pa0, pa1, pa2, pa3);
    if (H0 && H1) { pv_one<0>(o[0], vbc, pa0, pa1, pa2, pa3); pv_one<1>(o[1], vbc, pa0, pa1, pa2, pa3); }
    else if (H0) { pv_half<0, 0>(o[0], vbc, pa0, pa1); pv_half<1, 0>(o[1], vbc, pa0, pa1); }
    else { pv_half<0, 1>(o[0], vbc, pa2, pa3); pv_half<1, 1>(o[1], vbc, pa2, pa3); }
}
constexpr int BAND_LDS = 2 * 8192 + 2 * 16384 + NWAVES * 64 * 4;
template <bool SINK, bool WLSE>
__device__ __forceinline__ void banded_unit(const bf16_t* __restrict__ Qb, long ldq, const bf16_t* __restrict__ Kb, const bf16_t* __restrict__ Vb, long ldk, bf16_t* __restrict__ Ob, long ldo,
                                            int L, int q0, int R, float sinkv, float* lse, long ldl, char* lds) {
    constexpr float C = SCALE_B * 1.4426950408889634f;
    int tid = threadIdx.x; asm volatile("" : "+v"(tid));
    const int wid = tid >> 6, lane = tid & 63, r32 = lane & 31, hi = lane >> 5;
    char* K_lds = lds; char* V_lds = lds + 2 * 8192; float* al_l = (float*)(lds + 2 * 8192 + 2 * 16384) + wid * 64;
    const int qw = q0 + wid * QBLK;
    bf16x8 qr[4];
    const bf16_t* Qw = Qb + (long)(wid * QBLK + r32) * ldq + hi * 8;
#pragma unroll
    for (int d0 = 0; d0 < 4; ++d0) qr[d0] = *reinterpret_cast<const bf16x8*>(Qw + d0 * 16);
    float m_reg = SINK ? sinkv * (1.0f / SCALE_B) : -1e30f, l_reg = SINK ? 1.f : 0.f; f32x16 o[2] = {};
    const int srow = tid >> 3, scol = (tid & 7) * 8, vst = v_st(srow, scol), kst = KSWZ128(srow, scol * 2);
    const int vb0 = (int)(uintptr_t)V_lds + v_rd_base(lane);
    const int kt0 = (q0 - R > 0 ? q0 - R : 0) / KVBLK, kt1 = (q0 + 256 + R < L ? q0 + 256 + R : L) / KVBLK;
    const int qi = qw + r32;
    const bf16_t* kp = Kb + (long)(kt0 * KVBLK + srow) * ldk + scol; const bf16_t* vp = Vb + (long)(kt0 * KVBLK + srow) * ldk + scol; const long tstep = (long)KVBLK * ldk;
    bf16x8 kreg = *(const bf16x8*)kp, vreg = *(const bf16x8*)vp;
    __syncthreads();
    for (int kt = kt0; kt < kt1; ++kt) {
        const int k0 = kt * KVBLK, bsel = (kt - kt0) & 1;
        char* Kc = K_lds + bsel * 8192; char* Vc = V_lds + bsel * 16384;
        *(bf16x8*)(Kc + kst) = kreg; *(bf16x8*)(Vc + vst) = vreg;
        if (kt + 1 < kt1) { kp += tstep; vp += tstep; kreg = *(const bf16x8*)kp; vreg = *(const bf16x8*)vp; }
        __syncthreads();
        const bool rel0 = (k0 + 31 >= qw - R) && (k0 <= qw + 31 + R), rel1 = (k0 + 63 >= qw - R) && (k0 + 32 <= qw + 31 + R);
        const int vbc = vb0 + bsel * 16384;
        if (rel0 && rel1) band_tile<true, true>(Kc, vbc, qr, o, m_reg, l_reg, al_l, k0, qw, qi, R, r32, hi);
        else if (rel0) band_tile<true, false>(Kc, vbc, qr, o, m_reg, l_reg, al_l, k0, qw, qi, R, r32, hi);
        else if (rel1) band_tile<false, true>(Kc, vbc, qr, o, m_reg, l_reg, al_l, k0, qw, qi, R, r32, hi);
    }
    asm volatile("s_waitcnt lgkmcnt(0)" ::: "memory");
    if (hi == 0) al_l[r32] = l_reg; asm volatile("s_waitcnt lgkmcnt(0)" ::: "memory");
    bf16_t* Ow = Ob + (long)(wid * QBLK) * ldo;
#pragma unroll
    for (int r = 0; r < 16; ++r) { const int orow = crow(r, hi); const float rl = __builtin_amdgcn_rcpf(al_l[orow]);
#pragma unroll
        for (int d0 = 0; d0 < 2; ++d0) { const float v = o[d0][r] * rl; Ow[(long)orow * ldo + d0 * 32 + r32] = (bf16_t)(cvt_pk_bf16(v, v) & 0xffffu); } }
    if (WLSE) { if (hi == 0) lse[(long)(wid * QBLK + r32) * ldl] = m_reg * SCALE_B + __logf(l_reg); }
    asm volatile("s_waitcnt lgkmcnt(0)" ::: "memory");
}

constexpr int B2_ROWS = 384, B2_K = B2_ROWS * 64, B2_V = B2_ROWS * 128, B2_LDS = B2_K + B2_V + NWAVES * 64 * 4;
__device__ __forceinline__ int v_st64(int k, int c) { return ((k >> 3) * 2 + (c >> 5)) * 512 + ((k & 7) * 32 + (c & 31)) * 2; }
struct B2Stage { bf16x8 k[3], v[6]; };
__device__ __forceinline__ void b2_load(B2Stage& st, const unsigned char* __restrict__ Kb, long ldkb  , const bf16_t* __restrict__ Vb, long ldv  , int kb, int nrows, int tid) {
#pragma unroll
    for (int i = 0; i < 6; ++i) { const int id = tid + 512 * i, row = id >> 3, ch = (id & 7) * 8;
        const int rc = row < nrows ? row : nrows - 1;
        st.v[i] = *(const bf16x8*)(Vb + (long)(kb + rc) * ldv + ch); }
#pragma unroll
    for (int i = 0; i < 3; ++i) { const int id = tid + 512 * i, row = id >> 2, cb = (id & 3) * 16;
        const int rc = row < nrows ? row : nrows - 1;
        st.k[i] = *(const bf16x8*)(Kb + (long)(kb + rc) * ldkb + cb); }
}
__device__ __forceinline__ void b2_write(const B2Stage& st, char* lds, int nrows, int tid) {
#pragma unroll
    for (int i = 0; i < 6; ++i) { const int id = tid + 512 * i, row = id >> 3, ch = (id & 7) * 8;
        if (row < nrows) *(bf16x8*)(lds + B2_K + v_st64(row, ch)) = st.v[i]; }
#pragma unroll
    for (int i = 0; i < 3; ++i) { const int id = tid + 512 * i, row = id >> 2, cb = (id & 3) * 16;
        if (row < nrows) *(bf16x8*)(lds + KSWZ64(row, cb)) = st.k[i]; }
}
template <int D0> __device__ __forceinline__ void pv_h(f32x16& od, int vb, bf16x8 pb0, bf16x8 pb1) {
    const s16x4 l0 = tr_read<D0 * 512>(vb), h0 = tr_read<D0 * 512 + 1024>(vb), l1 = tr_read<D0 * 512 + 2048>(vb), h1 = tr_read<D0 * 512 + 3072>(vb);
    asm volatile("s_waitcnt lgkmcnt(0)" ::: "memory"); SBAR();
#define PKV(L, H_) (bf16x8){L[0], L[1], L[2], L[3], H_[0], H_[1], H_[2], H_[3]}
    od = __builtin_amdgcn_mfma_f32_32x32x16_bf16(PKV(l0, h0), pb0, od, 0, 0, 0);
    od = __builtin_amdgcn_mfma_f32_32x32x16_bf16(PKV(l1, h1), pb1, od, 0, 0, 0);
#undef PKV
}
template <bool SINK, bool WLSE, bool OUT8>
__device__ __forceinline__ void b2_task(const i32x8q& qr, bf16_t* __restrict__ Ow, long ldo, float* lsew, long ldl, float sinkv, int qw, int kbase, int L, int R, const char* lds, float* al_l, int lane) {
    constexpr float C = SCALE_B * 1.4426950408889634f;
    const int r32 = lane & 31, hi = lane >> 5, qi = qw + r32;
    float m_reg = SINK ? sinkv * (1.0f / SCALE_B) : -1e30f, l_reg = SINK ? 1.f : 0.f; f32x16 o[2] = {};
    const int vb0 = (int)(uintptr_t)(lds + B2_K) + v_rd_base(lane);
    const int h0 = (qw - R > 0 ? qw - R : 0), h1 = (qw + R + 32 < L ? qw + R + 32 : L);
    for (int k0 = h0; k0 < h1; k0 += 32) { const int r0 = k0 - kbase;
        f32x16 p;
        { const i32x8q kf = g8::cat8(*reinterpret_cast<const bf16x8*>(lds + KSWZ64(r0 + r32, hi * 32)), *reinterpret_cast<const bf16x8*>(lds + KSWZ64(r0 + r32, hi * 32 + 16)));
          asm volatile("v_mfma_f32_32x32x64_f8f6f4 %0, %1, %2, 0\n\ts_nop 15\n\ts_nop 7" : "=&v"(p) : "v"(kf), "v"(qr)); }
        if (k0 < qw - R + 32 || k0 + 31 > qw + R) {
            const float NEG = -__builtin_inff();
#pragma unroll
            for (int r = 0; r < 16; ++r) { int d = qi - (k0 + crow(r, hi)); d = d < 0 ? -d : d; if (d > R) p[r] = NEG; } }
        float pmax = p[0];
#pragma unroll
        for (int r = 1; r < 16; ++r) pmax = fmaxf(pmax, p[r]);
        { auto rr = __builtin_amdgcn_permlane32_swap(__float_as_uint(pmax), __float_as_uint(pmax), false, false); pmax = fmaxf(__uint_as_float(rr[0]), __uint_as_float(rr[1])); }
        const float mn = fmaxf(m_reg, pmax), alpha = __builtin_amdgcn_exp2f((m_reg - mn) * C); m_reg = mn;
        const float mnC = -mn * C; float ps = 0.f;
#pragma unroll
        for (int r = 0; r < 16; ++r) { p[r] = __builtin_amdgcn_exp2f(fmaf(p[r], C, mnC)); ps += p[r]; }
        { auto rr = __builtin_amdgcn_permlane32_swap(__float_as_uint(ps), __float_as_uint(ps), false, false); ps = __uint_as_float(rr[0]) + __uint_as_float(rr[1]); }
        l_reg = l_reg * alpha + ps;
#pragma unroll
        for (int d = 0; d < 2; ++d)
#pragma unroll
            for (int r = 0; r < 16; ++r) o[d][r] *= alpha;
        u32x4 w0 = {cvt2(p[0], p[1]), cvt2(p[2], p[3]), cvt2(p[4], p[5]), cvt2(p[6], p[7])}, w1 = {cvt2(p[8], p[9]), cvt2(p[10], p[11]), cvt2(p[12], p[13]), cvt2(p[14], p[15])};
        const bf16x8 pb0 = *reinterpret_cast<bf16x8*>(&w0), pb1 = *reinterpret_cast<bf16x8*>(&w1);
        const int vbc = vb0 + r0 * 128;
        pv_h<0>(o[0], vbc, pb0, pb1); pv_h<1>(o[1], vbc, pb0, pb1);
    }
    const float rl = (OUT8 ? 8.0f : 1.0f) * __builtin_amdgcn_rcpf(l_reg);
    if constexpr (OUT8) { unsigned char* Oq = (unsigned char*)Ow + (long)r32 * ldo + 4 * hi;
#pragma unroll
        for (int d0 = 0; d0 < 2; ++d0)
#pragma unroll
            for (int g = 0; g < 4; ++g) *(unsigned*)(Oq + d0 * 32 + 8 * g) = pk_fp8x4(o[d0][4 * g] * rl, o[d0][4 * g + 1] * rl, o[d0][4 * g + 2] * rl, o[d0][4 * g + 3] * rl); }
    else { bf16_t* Oq = Ow + (long)r32 * ldo + 4 * hi;
#pragma unroll
        for (int d0 = 0; d0 < 2; ++d0)
#pragma unroll
            for (int g = 0; g < 4; ++g) { u32x2 w; w.x = cvt2(o[d0][4 * g] * rl, o[d0][4 * g + 1] * rl); w.y = cvt2(o[d0][4 * g + 2] * rl, o[d0][4 * g + 3] * rl); *(u32x2*)(Oq + d0 * 32 + 8 * g) = w; } }
    if (WLSE) { if (hi == 0) lsew[(long)r32 * ldl] = m_reg * SCALE_B + __logf(l_reg); }
}
}

__device__ __forceinline__ void norm_row_store(const f32x4 (&v)[4], const float* g, const float* sh, const float* sc, bf16_t* hrow, int lane, bool fp8 = false) {
    float ss = 0.f;
#pragma unroll
    for (int j = 0; j < 4; ++j) ss += (v[j][0] * v[j][0] + v[j][1] * v[j][1]) + (v[j][2] * v[j][2] + v[j][3] * v[j][3]);
    const float rstd = 1.0f / sqrtf(wave_sum(ss) * (1.0f / 1024.0f) + EPS);
#pragma unroll
    for (int j = 0; j < 4; ++j) { const int c = 4 * lane + 256 * j;
        const f32x4 gv = *(const f32x4*)(g + c), shv = *(const f32x4*)(sh + c), scv = *(const f32x4*)(sc + c);
        const f32x4 y = v[j] * rstd * gv * (scv + 1.0f) + shv;
        if (fp8) *(unsigned*)((unsigned char*)hrow + c) = (unsigned)__builtin_amdgcn_cvt_pk_fp8_f32(y[2], y[3], __builtin_amdgcn_cvt_pk_fp8_f32(y[0], y[1], 0, false), true);
        else { u32x2 w; w.x = cvt_pk_bf16(y[0], y[1]); w.y = cvt_pk_bf16(y[2], y[3]); *(u32x2*)(hrow + c) = w; } }
}

__device__ __forceinline__ void conv_item(const float* __restrict__ W, int ldw, int K, int src0, int k0, bf16_t* __restrict__ Wt, int pos0, const float* kscale, LAS float* scr, int lane) {
#pragma unroll 8
    for (int i = 0; i < 32; ++i) { const int kk = 2 * i + (lane >> 5); float v = 0.f;
        if (src0 >= 0) { v = W[(size_t)(k0 + kk) * ldw + src0 + (lane & 31)]; if (kscale) v *= kscale[k0 + kk]; }
        scr[kk * 33 + (lane & 31)] = v; }
    LDS_WAIT(); asm volatile("" ::: "memory");
    const int c = lane & 7;
#pragma unroll
    for (int j = 0; j < 4; ++j) { const int n = (lane >> 3) + 8 * j; const LAS float* s = scr + (8 * c) * 33 + n;
        u32x4 o; o.x = cvt_pk_bf16(s[0 * 33], s[1 * 33]); o.y = cvt_pk_bf16(s[2 * 33], s[3 * 33]); o.z = cvt_pk_bf16(s[4 * 33], s[5 * 33]); o.w = cvt_pk_bf16(s[6 * 33], s[7 * 33]);
        *(u32x4*)(Wt + (size_t)(pos0 + n) * K + k0 + 8 * c) = o; }
    LDS_WAIT(); asm volatile("" ::: "memory");
}
__device__ __forceinline__ int src_inab(int pg) { const int pn = pg >> 3, bj = (pg >> 2) & 1, w = pg & 3;
    if (pn < 4) return 704 + (4 * pn + w) * 64 + 32 * bj;
    if (pn == 4) return w < 2 ? 1728 + w * 64 + 32 * bj : (w == 2 ? 640 + 32 * bj : -1);
    if (pn == 5) return 128 * bj + 32 * w;
    if (pn == 6) return bj == 0 ? 256 + 32 * w : 1856 + 32 * w;
    return 384 + 128 * bj + 32 * w; }
__device__ __forceinline__ int src_qb(int pg) { const int pn = pg >> 3, bj = (pg >> 2) & 1, w = pg & 3;
    if (pn < 2) return (4 * pn + w) * 192 + 128 + 32 * bj;
    return (2 * (pn - 2) + bj) * 192 + 32 * w; }
__device__ __forceinline__ int src_inc(int pg) { const int pn = pg >> 3, bj = (pg >> 2) & 1, w = pg & 3, gs = pn >> 2;
    if (gs % 3 < 2) return gs * 1024 + (4 * (pn & 3) + w) * 64 + 32 * bj;
    return pg * 32; }
__device__ __forceinline__ int src_gu(int pg) { const int pn = pg >> 3, bj = (pg >> 2) & 1, w = pg & 3; return 1024 * bj + 128 * pn + 32 * w; }

struct MapIdent { __device__ __forceinline__ int operator()(int pg) const { return pg * 32; } __device__ __forceinline__ int at(int nb, int pg4) const { return nb * 32 + pg4 * 4; } __device__ __forceinline__ int pos(int nb, int pg4) const { return nb * 32 + pg4 * 4; } };
struct MapDownPerm { __device__ __forceinline__ int operator()(int pg) const { return pg * 32; }
    __device__ __forceinline__ int pos(int nb, int pg4) const { const int tile = nb >> 3, wc = (nb >> 1) & 3, h = nb & 1; return tile * 256 + 128 * (pg4 >> 2) + 32 * wc + 16 * h + 4 * (pg4 & 3); }
    __device__ __forceinline__ int at(int nb, int pg4) const { const int tile = nb >> 3, wc = (nb >> 1) & 3, h = nb & 1, p = pg4 & 3; return tile * 256 + 64 * wc + 32 * h + 16 * (p >> 1) + 8 * (pg4 >> 2) + 4 * (p & 1); } };
struct MapInAB  { __device__ __forceinline__ int operator()(int pg) const { return src_inab(pg); }  __device__ __forceinline__ int at(int nb, int pg4) const { return (*this)(nb) + pg4 * 4; } __device__ __forceinline__ int pos(int nb, int pg4) const { return nb * 32 + pg4 * 4; } };
struct MapQB    { __device__ __forceinline__ int operator()(int pg) const { return src_qb(pg); } __device__ __forceinline__ int at(int nb, int pg4) const { return (*this)(nb) + pg4 * 4; } __device__ __forceinline__ int pos(int nb, int pg4) const { return nb * 32 + pg4 * 4; } };
struct MapInC   { __device__ __forceinline__ int operator()(int pg) const { return src_inc(pg); }  __device__ __forceinline__ int at(int nb, int pg4) const { return (*this)(nb) + pg4 * 4; } __device__ __forceinline__ int pos(int nb, int pg4) const { return nb * 32 + pg4 * 4; } };
struct MapGU    { __device__ __forceinline__ int operator()(int pg) const { return src_gu(pg); }  __device__ __forceinline__ int at(int nb, int pg4) const { return (*this)(nb) + pg4 * 4; } __device__ __forceinline__ int pos(int nb, int pg4) const { return nb * 32 + pg4 * 4; } };
template <class Map>
__device__ __forceinline__ void conv_group(const float* W, size_t mat_stride, int ldw, int K, int npos, bf16_t* Wt, const float* kscale, int kscale_stride, int nmat, Map map, LAS float* scr, int gw, int NGW, int lane, int woff = 0) {
    const int npg = npos / 32, per = (K / 64) * npg, total = per * nmat;
    for (int it = (gw + NGW - woff % NGW) % NGW; it < total; it += NGW) { const int mat = it / per, r = it - mat * per, kb = r / npg, pg = r - kb * npg;
        conv_item(W + (size_t)mat * mat_stride, ldw, K, map(pg), kb * 64, Wt + (size_t)mat * npos * K, pg * 32, kscale ? kscale + (size_t)mat * kscale_stride : nullptr, scr, lane); }
}


typedef const __attribute__((address_space(4))) Params* KParams;
#define WSL() KParams kp = (KParams)__builtin_amdgcn_kernarg_segment_ptr(); asm volatile("" : "+s"(kp)); unsigned char* wsl = kp->ws; \
    const int tid = tid_now(wave_s_); int vcl = vcu, bxl = bx; asm volatile("" : "+s"(vcl), "+s"(bxl)); const int lane = tid & 63, wave = __builtin_amdgcn_readfirstlane(tid >> 6), gw = vcl * NWAVES + wave; (void)lane; (void)gw
#define MOD ((float*)(wsl + WS_MOD))
#define COS ((float*)(wsl + WS_COS))
#define SIN ((float*)(wsl + WS_SIN))
#define WROUT ((bf16_t*)(wsl + WS_WROUT))
#define WINAB ((bf16_t*)(wsl + WS_WINAB))
#define WQB ((bf16_t*)(wsl + WS_WQB))
#define WKVB ((bf16_t*)(wsl + WS_WKVB))
#define WOUTAB ((bf16_t*)(wsl + WS_WOUTAB))
#define WINC ((bf16_t*)(wsl + WS_WINC))
#define WOUTC ((bf16_t*)(wsl + WS_WOUTC))
#define WGU ((bf16_t*)(wsl + WS_WGU))
#define WDOWN ((bf16_t*)(wsl + WS_WDOWN))
#define X ((float*)(wsl + WS_X))
#define H ((bf16_t*)(wsl + WS_H))
#define QB ((bf16_t*)(wsl + WS_QB))
#define KB ((bf16_t*)(wsl + WS_KB))
#define VB ((bf16_t*)(wsl + WS_VB))
#define KR ((bf16_t*)(wsl + WS_KR))
#define CQ ((bf16_t*)(wsl + WS_CQ))
#define CKV ((bf16_t*)(wsl + WS_CKV))
#define SSQ ((float*)(wsl + WS_SSQ))
#define QA ((bf16_t*)(wsl + WS_QA))
#define V8P ((unsigned char*)(wsl + WS_QA + 48 * MiB))
#define KV ((bf16_t*)(wsl + WS_KV))
#define OB ((bf16_t*)(wsl + WS_O))
#define PC ((bf16_t*)(wsl + WS_PC))
#define OG ((bf16_t*)(wsl + WS_OG))
#define LSE ((float*)(wsl + WS_LSE))
#define OC ((bf16_t*)(wsl + WS_OC))
#define LIST ((int*)(wsl + WS_LIST))
#define TOKE ((int*)(wsl + WS_TOKE))
#define GATE ((float*)(wsl + WS_GATE))
#define ACT ((unsigned char*)(wsl + WS_ACT))
#define H8 ((unsigned char*)(wsl + WS_H8))
#define YB ((bf16_t*)(wsl + WS_YB))

template <class Map>
__device__ __forceinline__ void conv2_group(const float* __restrict__ W, size_t mat_stride, int ldw, int K, int npos, bf16_t* __restrict__ Wt, const float* kscale, int kscale_stride, int nmat, Map map, int gw, int NGW, int lane, int woff = 0) {
    const int npb = npos / 256, per = (K / 64) * npb, total = per * nmat;
    for (int it = (gw + NGW - woff % NGW) % NGW; it < total; it += NGW) { const int mat = it / per, r = it - mat * per, kblk = r / npb, nb = r - kblk * npb;
        const int pos = nb * 256 + lane * 4; const int sg = map(pos >> 5); const int src = sg + (pos & 31);
        const float* wp = W + (size_t)mat * mat_stride + (size_t)(kblk * 64) * ldw + (sg < 0 ? 0 : src);
        const float* ks = kscale ? kscale + (size_t)mat * kscale_stride + kblk * 64 : nullptr;
        bf16_t* op = Wt + ((size_t)mat * npos + pos) * K + kblk * 64;
#pragma unroll 2
        for (int s8 = 0; s8 < 8; ++s8) { f32x4 v[8];
#pragma unroll
            for (int j = 0; j < 8; ++j) { v[j] = *(const f32x4*)(wp + (size_t)(s8 * 8 + j) * ldw); if (ks) v[j] = v[j] * ks[s8 * 8 + j]; }
            if (sg < 0) {
#pragma unroll
                for (int j = 0; j < 8; ++j) v[j] = (f32x4){0.f, 0.f, 0.f, 0.f}; }
#pragma unroll
            for (int i = 0; i < 4; ++i) { u32x4 o; o.x = cvt_pk_bf16(v[0][i], v[1][i]); o.y = cvt_pk_bf16(v[2][i], v[3][i]); o.z = cvt_pk_bf16(v[4][i], v[5][i]); o.w = cvt_pk_bf16(v[6][i], v[7][i]);
                *(u32x4*)(op + (size_t)i * K + s8 * 8) = o; } } }
}

__device__ __forceinline__ void conv8_load(f32x4 (&v)[16], const float* wp, int ldw) {
#pragma unroll
    for (int j = 0; j < 16; ++j) v[j] = __builtin_nontemporal_load((const f32x4*)(wp + (size_t)j * ldw));
}
__device__ __forceinline__ void conv8_scale(f32x4 (&v)[16], const float* ksp) {
#pragma unroll
    for (int j = 0; j < 16; ++j) v[j] = v[j] * ksp[j];
}
__device__ __forceinline__ void conv8_store(const f32x4 (&v)[16], unsigned char* op, int K, float scale) {
#pragma unroll
    for (int i = 0; i < 4; ++i) { u32x4 o;
        o.x = (unsigned)__builtin_amdgcn_cvt_pk_fp8_f32(v[2][i] * scale, v[3][i] * scale, __builtin_amdgcn_cvt_pk_fp8_f32(v[0][i] * scale, v[1][i] * scale, 0, false), true);
        o.y = (unsigned)__builtin_amdgcn_cvt_pk_fp8_f32(v[6][i] * scale, v[7][i] * scale, __builtin_amdgcn_cvt_pk_fp8_f32(v[4][i] * scale, v[5][i] * scale, 0, false), true);
        o.z = (unsigned)__builtin_amdgcn_cvt_pk_fp8_f32(v[10][i] * scale, v[11][i] * scale, __builtin_amdgcn_cvt_pk_fp8_f32(v[8][i] * scale, v[9][i] * scale, 0, false), true);
        o.w = (unsigned)__builtin_amdgcn_cvt_pk_fp8_f32(v[14][i] * scale, v[15][i] * scale, __builtin_amdgcn_cvt_pk_fp8_f32(v[12][i] * scale, v[13][i] * scale, 0, false), true);
        *(u32x4*)(op + (size_t)i * K) = o; }
}
template <class Map>
__device__ __forceinline__ void conv8_group(const float* __restrict__ W, size_t mat_stride, int ldw, int K, int npos, unsigned char* __restrict__ Wt, float scale, int nmat, Map map, int gw, int NGW, int lane, int woff = 0, const float* __restrict__ ks = nullptr, int ksrc = 0) {
    if (ksrc == 0) ksrc = K;
    const int npb = npos / 32, per = (K / 128) * npb, total = per * nmat; const int kq = lane >> 3, pg = lane & 7;
#define C8_GEO(it_, wp_, op_, scl_) const int mat_##wp_ = (it_) / per, r_##wp_ = (it_) - mat_##wp_ * per, kblk_##wp_ = r_##wp_ / npb, nb_##wp_ = r_##wp_ - kblk_##wp_ * npb; const int sg_##wp_ = map(nb_##wp_), ksb_##wp_ = kblk_##wp_ * 128 < ksrc ? kblk_##wp_ : 0; \
        const float scl_ = (sg_##wp_ < 0 || kblk_##wp_ * 128 >= ksrc) ? 0.f : scale; const float* wp_ = W + (size_t)mat_##wp_ * mat_stride + (size_t)(ksb_##wp_ * 128 + kq * 16) * ldw + (sg_##wp_ < 0 ? pg * 4 : map.at(nb_##wp_, pg)); \
        unsigned char* op_ = Wt + ((size_t)mat_##wp_ * npos + map.pos(nb_##wp_, pg)) * K + kblk_##wp_ * 128 + kq * 16
    f32x4 va[16], vb[16];
    int it = (gw + NGW - woff % NGW) % NGW;
    if (it < total) { C8_GEO(it, wp0, op0, sc0); (void)op0; (void)sc0; conv8_load(va, wp0, ldw); }
    for (; it < total; it += 2 * NGW) {
        const bool hb = it + NGW < total, ha = it + 2 * NGW < total;
        if (hb) { C8_GEO(it + NGW, wp1, op1, sc1); (void)op1; (void)sc1; conv8_load(vb, wp1, ldw); }
        { C8_GEO(it, wp2, op2, sc2); (void)wp2; if (ks) conv8_scale(va, ks + (size_t)mat_wp2 * ksrc + ksb_wp2 * 128 + kq * 16); conv8_store(va, op2, K, sc2); }
        if (ha) { C8_GEO(it + 2 * NGW, wp3, op3, sc3); (void)op3; (void)sc3; conv8_load(va, wp3, ldw); }
        if (hb) { C8_GEO(it + NGW, wp4, op4, sc4); (void)wp4; if (ks) conv8_scale(vb, ks + (size_t)mat_wp4 * ksrc + ksb_wp4 * 128 + kq * 16); conv8_store(vb, op4, K, sc4); } }
#undef C8_GEO
}
#ifndef INC_FP8
#define INC_FP8 3
#endif
#ifndef STAG
#define STAG 0
#endif
constexpr int NPH = 2 + 9 * DEPTH;
__host__ __device__ constexpr bool phase_empty(int k) { return k >= 2 && ((((k - 2) / 9) % 2 == 0 && (k - 2) % 9 == 3) || (((k - 2) / 9) % 2 == 1 && (k - 2) % 9 == 1)); }

__global__ void __launch_bounds__(NTHR, 2) fwd_kernel(Params p) {
    extern __shared__ __attribute__((aligned(16))) unsigned char lds_raw[];
    LAS unsigned char* lds = (LAS unsigned char*)lds_raw;
    const int G = gridDim.x, bx = blockIdx.x, vcu = (G % 8 == 0) ? (bx % 8) * (G / 8) + bx / 8 : bx;
    const int NGW = G * NWAVES;
    unsigned* const ctl = (unsigned*)(p.ws + WS_CTL);
    int wave_s_ = __builtin_amdgcn_readfirstlane(threadIdx.x >> 6);
    if (threadIdx.x < 32) ((LAS unsigned*)(lds + MISC_OFF))[threadIdx.x] = 0u;
    __syncthreads();
    XcdBarrier bar; bar.bar = ctl + CW_BAR; bar.x = 0; bar.st = nullptr;
    const int lo = p.ph_lo, hi = p.ph_hi;
    if (hi - lo > 1) bar = xcd_barrier_post(ctl + CW_BAR, (volatile LAS unsigned*)(lds + MISC_OFF));
#ifndef PHMASK
#define PHMASK 0xFFFFFFFFu
#endif
#define ON(id) (((PHMASK) >> (id)) & 1u)
#ifndef REPMASK
#define REPMASK 0u
#endif
#define DSH(id) ((size_t)((((REPMASK) >> (id)) & 1u) && rep_ == 0 ? 1600 : 0) * MiB)
#define REP(id) for (int rep_ = 0; rep_ < ((((REPMASK) >> (id)) & 1u) ? 2 : 1); ++rep_)
#define IN(k) (lo <= (k) && (k) < hi)
#define SEAM(k) do { if (hi > (k) + 1) { xcd_barrier(bar, wave_s_); if ((REPMASK >> 23) & 1u) xcd_barrier(bar, wave_s_); } } while (0)

    if (ON(0) && IN(0)) { WSL(); {
        REP(16) {
            LAS float* cact = (LAS float*)lds; LAS float* part = (LAS float*)(lds + 32768);
            for (int i = 0; i < 16; ++i) { const int idx = tid + 512 * i, b = idx >> 10, k = idx & 1023; const float cv = kp->c[idx]; cact[k * 8 + b] = cv / (1.0f + __expf(-cv)); }
            __syncthreads();
            for (int u = bx; u < 4 * 96; u += G) { const int layer = u / 96, n0 = (u % 96) * 64;
                float a0 = 0, a1 = 0, a2 = 0, a3 = 0, a4 = 0, a5 = 0, a6 = 0, a7 = 0;
                const float* wp = kp->w_mod + ((size_t)layer * 1024 + wave * 128) * 6144 + n0 + lane;
#pragma unroll 4
                for (int kk = 0; kk < 128; ++kk) { const float w = wp[(size_t)kk * 6144]; const LAS f32x4* cp = (const LAS f32x4*)(cact + (wave * 128 + kk) * 8); const f32x4 ca = cp[0], cb = cp[1];
                    a0 += ca[0] * w; a1 += ca[1] * w; a2 += ca[2] * w; a3 += ca[3] * w; a4 += cb[0] * w; a5 += cb[1] * w; a6 += cb[2] * w; a7 += cb[3] * w; }
                LAS float* pp = part + wave * 512 + lane;
                pp[0] = a0; pp[64] = a1; pp[128] = a2; pp[192] = a3; pp[256] = a4; pp[320] = a5; pp[384] = a6; pp[448] = a7;
                __syncthreads();
                { const int b = tid >> 6; float s = kp->b_mod[(size_t)layer * 6144 + n0 + lane];
#pragma unroll
                  for (int w = 0; w < 8; ++w) s += part[w * 512 + b * 64 + lane];
                  MOD[((size_t)layer * 8 + b) * 6144 + n0 + lane] = s; }
                __syncthreads(); }
        }
        REP(17) for (int idx = bx * NTHR + tid; idx < T * 4; idx += G * NTHR) { const int t = idx >> 2, fq_ = idx & 3; const float pos = (float)kp->positions[t];
            float cs[8], sn[8];
#pragma unroll
            for (int e = 0; e < 8; ++e) { const float inv = powf(10000.0f, -(float)(8 * fq_ + e) * (1.0f / 32.0f)); const float ang = pos * inv; cs[e] = cosf(ang); sn[e] = sinf(ang); }
            u32x4 cw = {cvt_pk_bf16(cs[0], cs[1]), cvt_pk_bf16(cs[2], cs[3]), cvt_pk_bf16(cs[4], cs[5]), cvt_pk_bf16(cs[6], cs[7])}, sw = {cvt_pk_bf16(sn[0], sn[1]), cvt_pk_bf16(sn[2], sn[3]), cvt_pk_bf16(sn[4], sn[5]), cvt_pk_bf16(sn[6], sn[7])};
            *(u32x4*)((unsigned char*)COS + (size_t)idx * 32) = cw; *(u32x4*)((unsigned char*)COS + (size_t)idx * 32 + 16) = sw; }
        __syncthreads();
        LAS float* scr = (LAS float*)(lds + wave * 8448);
        REP(19) conv_group(kp->w_router, (size_t)1024 * 32, 32, 1024, 32, WROUT, nullptr, 0, 4, MapIdent(), scr, gw, NGW, lane, 0);
        conv8_group(kp->w_in_ab, (size_t)1024 * 1984, 1984, 1024, 2048, (unsigned char*)WINAB, 32.0f, 2, MapInAB(), gw, NGW, lane, 64);
        conv8_group(kp->mla_w_qb, (size_t)384 * 1536, 1536, 512, 1536, (unsigned char*)WQB, 32.0f, 2, MapQB(), gw, NGW, lane, 192, kp->mla_g_q, 384);
        conv8_group(kp->mla_w_kvb, (size_t)256 * 2048, 2048, 256, 2048, (unsigned char*)WKVB, 32.0f, 2, MapIdent(), gw, NGW, lane, 400, kp->mla_g_kv);
        conv8_group(kp->w_out_ab, (size_t)2048 * 1024, 1024, 2048, 1024, (unsigned char*)WOUTAB, 32.0f, 2, MapIdent(), gw, NGW, lane, 464);
        conv8_group(kp->w_in_c, (size_t)1024 * 9216, 9216, 1024, 9216, (unsigned char*)WINC, 32.0f, 2, MapInC(), gw, NGW, lane, 592);
        conv8_group(kp->w_out_c, (size_t)1024 * 1024, 1024, 1024, 1024, (unsigned char*)WOUTC, 32.0f, 2, MapIdent(), gw, NGW, lane, 1168);
        REP(18) conv8_group(kp->w_gu, (size_t)1024 * 2048, 2048, 1024, 2048, (unsigned char*)WGU, 32.0f, 128, MapGU(), gw, NGW, lane);
        REP(18) conv8_group(kp->w_down, (size_t)1024 * 1024, 1024, 1024, 1024, (unsigned char*)WDOWN, 32.0f, 128, MapDownPerm(), gw, NGW, lane);
        __syncthreads(); }
        SEAM(0);
    }
    if (ON(1) && IN(1)) { WSL();
        REP(1) {
            const int chunk = (T + NGW - 1) / NGW, tb = gw * chunk, te = tb + chunk < T ? tb + chunk : T;
#define P1C(j) (8 * lane + 512 * ((j) >> 1) + 4 * ((j) & 1))
            f32x4 gnv[4], shv[4], scv[4], xa[4], xb[4]; int cur_b = -1;
#pragma unroll
            for (int j = 0; j < 4; ++j) { gnv[j] = *(const f32x4*)(kp->g_norm_mix + P1C(j)); shv[j] = gnv[j]; scv[j] = gnv[j]; xa[j] = gnv[j]; xb[j] = gnv[j]; }
            if (tb < te) { const int t1 = tb + 1 < te ? tb + 1 : tb;
#pragma unroll
                for (int j = 0; j < 4; ++j) { xa[j] = *(const f32x4*)(kp->x + (size_t)tb * 1024 + P1C(j)); xb[j] = *(const f32x4*)(kp->x + (size_t)t1 * 1024 + P1C(j)); } }
            for (int t = tb; t < te; t += 2) { const int t1 = t + 1 < te ? t + 1 : t;
                f32x4 va[4], vb[4];
#pragma unroll
                for (int j = 0; j < 4; ++j) { va[j] = xa[j]; vb[j] = xb[j]; }
                { const int tn = t + 2 < te ? t + 2 : t, tn1 = t + 3 < te ? t + 3 : tn;
#pragma unroll
                  for (int j = 0; j < 4; ++j) { xa[j] = *(const f32x4*)(kp->x + (size_t)tn * 1024 + P1C(j)); xb[j] = *(const f32x4*)(kp->x + (size_t)tn1 * 1024 + P1C(j)); } }
#pragma unroll
                for (int q = 0; q < 2; ++q) { const int tq = q ? t1 : t, b = tq >> 12;
                    if (q == 1 && t + 1 >= te) break;
                    if (b != cur_b) { cur_b = b; const float* sh = MOD + (size_t)b * 6144;
#pragma unroll
                        for (int j = 0; j < 4; ++j) { shv[j] = *(const f32x4*)(sh + P1C(j)); scv[j] = *(const f32x4*)(sh + 1024 + P1C(j)) + 1.0f; } }
                    float ss = 0.f; f32x4 v[4];
#pragma unroll
                    for (int j = 0; j < 4; ++j) { v[j] = q ? vb[j] : va[j]; ss += (v[j][0] * v[j][0] + v[j][1] * v[j][1]) + (v[j][2] * v[j][2] + v[j][3] * v[j][3]); }
                    const float rstd = 1.0f / sqrtf(wave_sum(ss) * (1.0f / 1024.0f) + EPS);
                    unsigned w8[4];
#pragma unroll
                    for (int j = 0; j < 4; ++j) { const f32x4 y = v[j] * rstd * gnv[j] * scv[j] + shv[j]; w8[j] = pk_fp8x4(y[0], y[1], y[2], y[3]); }
#pragma unroll
                    for (int j = 0; j < 2; ++j) { u32x2 w; w.x = w8[2 * j]; w.y = w8[2 * j + 1]; *(u32x2*)((unsigned char*)H + (size_t)tq * 1024 + 8 * lane + 512 * j) = w;
                        const u32x4 xw = {cvt_pk_bf16(v[2 * j][0], v[2 * j][1]), cvt_pk_bf16(v[2 * j][2], v[2 * j][3]), cvt_pk_bf16(v[2 * j + 1][0], v[2 * j + 1][1]), cvt_pk_bf16(v[2 * j + 1][2], v[2 * j + 1][3])};
                        *(u32x4*)((unsigned char*)X + (size_t)tq * 2048 + (8 * lane + 512 * j) * 2) = xw; } } }
#undef P1C
        }
        SEAM(1);
    }

    for (int layer = 0; layer < DEPTH; ++layer) {
        const int pb = 2 + 9 * layer, li = layer >> 1; const bool even = (layer & 1) == 0;
        if (IN(pb + 0)) { WSL();
            if (ON(2) && even) REP(2) { g8::DenseSched S; S.init(H, (const unsigned char*)WINAB + (size_t)li * 2048 * 1024, 512, T, 2048, G, bxl);
                EpiInAB E{QB, KB, VB, KR, CQ, CKV, SSQ, COS, SIN, 1.0f / 32.0f};
                g8::gemm_phase<EpiInAB, g8::DenseSched, true, true>(lds, 512, S, E, wave_s_, (vcl & 31) * STAG); }
            else if (ON(3) && !even) REP(3) { g8::DenseSched S; S.init(H, (const unsigned char*)WINC + (size_t)li * 9216 * 1024, 512, T, 9216, G, bxl);
                EpiInC E{PC, COS, SIN, 1.0f / 32.0f};
                g8::gemm_phase<EpiInC, g8::DenseSched, true, true>(lds, 512, S, E, wave_s_, (vcl & 31) * STAG); }
            SEAM(pb + 0);
        }
        if (ON(4) && IN(pb + 1) && even) { WSL();
            if (ON(14)) REP(4) { g8::DenseSched S; S.init(CQ, (const unsigned char*)WQB + (size_t)li * 1536 * 512, 256, T, 1536, G, bxl); EpiQUp E{(unsigned char*)QA, SSQ, COS, SIN};
              g8::gemm_phase<EpiQUp, g8::DenseSched, true, true>(lds, 256, S, E, wave_s_, (vcl & 31) * STAG); }
            if (ON(15)) REP(4) { g8::DenseSched S; S.init(CKV, (const unsigned char*)WKVB + (size_t)li * 2048 * 256, 128, T, 2048, G, bxl); EpiKVUp E{KV, V8P, SSQ};
              g8::gemm_phase<EpiKVUp, g8::DenseSched, true, true>(lds, 128, S, E, wave_s_); }
            SEAM(pb + 1);
        }
        if (IN(pb + 2)) { WSL();
            if (even) {
                if (ON(5)) REP(5) for (int i = 0;; ++i) { const int u = i * G + vcl; if (u >= NBATCH * 8 * 16) break; const int qb = u & 15, h = (u >> 4) & 7, b = u >> 7;
                    const size_t r0 = (size_t)b * SEQ;
                    att::dense_unit((const unsigned char*)QA + (r0 + qb * 256) * 1536 + h * 192, (const unsigned char*)KV + r0 * 4096 + h * 512, V8P + (r0 >> 1) * 2048 + h * 256, (const unsigned char*)KR + r0 * 64, (bf16_t*)((unsigned char*)OB + (r0 + qb * 256) * 2048 + h * 128), SEQ, (char*)lds_raw, wave_s_); }
                if (ON(6)) REP(6) {
                    const int tid = tid_now(wave_s_);
                    att::B2Stage st = {}; const int lane_ = tid & 63, wv = tid >> 6; float* al_l = (float*)((char*)lds_raw + att::B2_K + att::B2_V) + wv * 64;
                    int u = vcl; bool have = u < NBATCH * 2 * 32;
#define SWA_GEO(uu, b_, kvh_, q0_, kb_, nr_) const int b_ = (uu) >> 6, kvh_ = ((uu) >> 5) & 1, q0_ = ((uu) & 31) * 128, kb_ = q0_ - 128 > 0 ? q0_ - 128 : 0, nr_ = (q0_ + 256 < SEQ ? q0_ + 256 : SEQ) - kb_
                    if (have) { SWA_GEO(u, b, kvh, q0, kb, nr); (void)q0; att::b2_load(st, (const unsigned char*)KB + (size_t)b * SEQ * 128 + kvh * 64, 128, VB + (size_t)b * SEQ * 128 + kvh * 64, 128, kb, nr, tid); }
                    while (have) { SWA_GEO(u, b, kvh, q0, kb, nr);
                        __syncthreads(); att::b2_write(st, (char*)lds_raw, nr, tid);
                        const int un = u + G; const bool hn = un < NBATCH * 2 * 32;
                        if (hn) { SWA_GEO(un, b2, kvh2, q02, kb2, nr2); (void)q02; att::b2_load(st, (const unsigned char*)KB + (size_t)b2 * SEQ * 128 + kvh2 * 64, 128, VB + (size_t)b2 * SEQ * 128 + kvh2 * 64, 128, kb2, nr2, tid); }
                        __syncthreads();
                        const int hq = kvh * 8 + wv; const size_t r0 = (size_t)b * SEQ; const float sinkv = kp->swa_sink[li * 16 + hq];
                        for (int j = 0; j < 4; ++j) { const int qw = q0 + 32 * j;
                            const unsigned char* Qw = (const unsigned char*)QB + (r0 + qw + (lane_ & 31)) * 1024 + hq * 64 + (lane_ >> 5) * 32;
                            const att::i32x8q qr = g8::cat8(*reinterpret_cast<const bf16x8*>(Qw), *reinterpret_cast<const bf16x8*>(Qw + 16));
                            att::b2_task<true, false, true>(qr, (bf16_t*)((unsigned char*)OB + (r0 + qw) * 2048 + 1024 + hq * 64), 2048, nullptr, 0, sinkv, qw, kb, SEQ, 128, (const char*)lds_raw, al_l, lane_); }
                        u = un; have = hn; }
#undef SWA_GEO
                }
            } else {
                if (ON(7)) REP(7) {
                    att::B2Stage st = {}; const int lane_ = tid & 63, wv = tid >> 6; float* al_l = (float*)((char*)lds_raw + att::B2_K + att::B2_V) + wv * 64;
                    int u = vcl; bool have = u < 3 * 2048; att::i32x8q qn = {};
#define PCB(b_, gs_, head_) ((unsigned char*)PC + (size_t)(((b_) * 9 + (gs_)) * 16 + (head_)) * (4096 * 128))
#define DIL_QLOAD(dst, g_, head_, dil_, q0_, s0_) do { const unsigned char* Qw_ = PCB(bb_##g_, g_ * 3 + 0, head_) + ((size_t)rr_##g_ * (SEQ / dil_) + q0_ + 32 * wv + (lane_ & 31)) * 64 + (lane_ >> 5) * 32; \
        dst = g8::cat8(*reinterpret_cast<const bf16x8*>(Qw_), *reinterpret_cast<const bf16x8*>(Qw_ + 16)); } while (0)
#define DIL_GEO(uu, g_, head_, dil_, L_, q0_, s0_, kb_, nr_) const int g_ = (uu) >> 11, rem_##g_ = (uu) & 2047, head_ = rem_##g_ & 15, rest_##g_ = rem_##g_ >> 4, dil_ = g_ == 0 ? 1 : (g_ == 1 ? 4 : 16), L_ = SEQ / dil_, nqb_##g_ = L_ / 256, \
        q0_ = (rest_##g_ % nqb_##g_) * 256, seqi_##g_ = rest_##g_ / nqb_##g_, bb_##g_ = seqi_##g_ / dil_, rr_##g_ = seqi_##g_ % dil_; const size_t s0_ = (size_t)bb_##g_ * SEQ + rr_##g_; const int kb_ = q0_ - 64 > 0 ? q0_ - 64 : 0, nr_ = (q0_ + 320 < L_ ? q0_ + 320 : L_) - kb_
                    if (have) { DIL_GEO(u, g, head, dil, L, q0, s0, kb, nr); DIL_QLOAD(qn, g, head, dil, q0, s0); att::b2_load(st, PCB(bb_g, g * 3 + 1, head) + (size_t)rr_g * L * 64, 64, (const bf16_t*)(PCB(bb_g, g * 3 + 2, head) + (size_t)rr_g * L * 128), 64, kb, nr, tid); }
                    while (have) { DIL_GEO(u, g, head, dil, L, q0, s0, kb, nr);
                        __syncthreads(); att::b2_write(st, (char*)lds_raw, nr, tid);
                        const att::i32x8q qr = qn;
                        const int un = u + G; const bool hn = un < 3 * 2048;
                        if (hn) { DIL_GEO(un, g2, head2, dil2, L2, q02, s02, kb2, nr2); DIL_QLOAD(qn, g2, head2, dil2, q02, s02); att::b2_load(st, PCB(bb_g2, g2 * 3 + 1, head2) + (size_t)rr_g2 * L2 * 64, 64, (const bf16_t*)(PCB(bb_g2, g2 * 3 + 2, head2) + (size_t)rr_g2 * L2 * 128), 64, kb2, nr2, tid); }
                        __syncthreads();
                        { const int qw = q0 + 32 * wv; const size_t qrow = s0 + (size_t)dil * qw;
                          att::b2_task<false, true, true>(qr, (bf16_t*)((unsigned char*)OG + (qrow * 3 + g) * 1024 + head * 64), (long)dil * 3072, LSE + (qrow * 3 + g) * 16 + head, (long)dil * 48, 0.f, qw, kb, L, 64, (const char*)lds_raw, al_l, lane_); }
                        u = un; have = hn; }
#undef DIL_QLOAD
#undef PCB
#undef DIL_GEO
                }
            }
            SEAM(pb + 2);
        }
        if (ON(8) && IN(pb + 3) && !even) { WSL();
            REP(8) {
                const int chunk = (T + NGW - 1) / NGW, tb = gw * chunk, te = tb + chunk < T ? tb + chunk : T;
                float ls[2][2][3]; u32x2 og[2][2][3];
#define GC_LOAD(tt, q) do { _Pragma("unroll") for (int j = 0; j < 2; ++j) { const int c_ = 8 * lane + 512 * j, head_ = c_ >> 6; _Pragma("unroll") for (int g = 0; g < 3; ++g) { \
        ls[q][j][g] = LSE[((size_t)(tt) * 3 + g) * 16 + head_]; og[q][j][g] = *(const u32x2*)((const unsigned char*)OG + ((size_t)(tt) * 3 + g) * 1024 + c_); } } } while (0)
                { const int t0_ = tb < te ? tb : 0, t1_ = tb + 1 < te ? tb + 1 : t0_; GC_LOAD(t0_, 0); GC_LOAD(t1_, 1); }
                for (int t = tb; t < te; t += 2) { const int t1 = t + 1 < te ? t + 1 : t;
                    float cl[2][2][3]; u32x2 co[2][2][3];
#pragma unroll
                    for (int q = 0; q < 2; ++q)
#pragma unroll
                        for (int j = 0; j < 2; ++j)
#pragma unroll
                            for (int g = 0; g < 3; ++g) { cl[q][j][g] = ls[q][j][g]; co[q][j][g] = og[q][j][g]; }
                    { const int tn = t + 2 < te ? t + 2 : t, tn1 = t + 3 < te ? t + 3 : tn; GC_LOAD(tn, 0); GC_LOAD(tn1, 1); }
#pragma unroll
                    for (int q = 0; q < 2; ++q) { const int tq = q ? t1 : t;
                        if (q == 1 && t + 1 >= te) break;
#pragma unroll
                        for (int j = 0; j < 2; ++j) { const int c = 8 * lane + 512 * j;
                            const float l0 = cl[q][j][0], l1 = cl[q][j][1], l2 = cl[q][j][2];
                            const float m = fmaxf(l0, fmaxf(l1, l2)); float w0 = __expf(l0 - m), w1 = __expf(l1 - m), w2 = __expf(l2 - m); const float inv = 1.0f / (w0 + w1 + w2); w0 *= inv; w1 *= inv; w2 *= inv;
                            typedef float f2_ __attribute__((ext_vector_type(2)));
                            const u32x2 a = co[q][j][0], bq = co[q][j][1], cq = co[q][j][2];
                            unsigned ow[2];
#pragma unroll
                            for (int hh = 0; hh < 2; ++hh) { const int aw = hh ? (int)a.y : (int)a.x, bw = hh ? (int)bq.y : (int)bq.x, cw = hh ? (int)cq.y : (int)cq.x;
                                const f2_ a01 = __builtin_amdgcn_cvt_pk_f32_fp8(aw, false), a23 = __builtin_amdgcn_cvt_pk_f32_fp8(aw, true), b01 = __builtin_amdgcn_cvt_pk_f32_fp8(bw, false), b23 = __builtin_amdgcn_cvt_pk_f32_fp8(bw, true),
                                          c01 = __builtin_amdgcn_cvt_pk_f32_fp8(cw, false), c23 = __builtin_amdgcn_cvt_pk_f32_fp8(cw, true);
                                ow[hh] = pk_fp8x4(w0 * a01[0] + w1 * b01[0] + w2 * c01[0], w0 * a01[1] + w1 * b01[1] + w2 * c01[1], w0 * a23[0] + w1 * b23[0] + w2 * c23[0], w0 * a23[1] + w1 * b23[1] + w2 * c23[1]); }
                            u32x2 o; o.x = ow[0]; o.y = ow[1];
                            *(u32x2*)((unsigned char*)OC + (size_t)tq * 1024 + c) = o; } } }
#undef GC_LOAD
            }
            SEAM(pb + 3);
        }
        if (ON(9) && IN(pb + 4)) { WSL();
            g8::DenseSched S;
            if (even) S.init(OB, (const unsigned char*)WOUTAB + (size_t)li * 1024 * 2048, 1024, T, 1024, G, bxl); else S.init(OC, (const unsigned char*)WOUTC + (size_t)li * 1024 * 1024, 512, T, 1024, G, bxl);
            REP(9) { EpiResid E{(float*)((char*)X + DSH(9)), MOD + (size_t)layer * 8 * 6144 + 2048, 1.0f / 256.0f};
            g8::gemm_phase<EpiResid, g8::DenseSched, true, true>(lds, even ? 1024 : 512, S, E, wave_s_, (vcl & 31) * STAG); }
            SEAM(pb + 4);
        }
        if (ON(10) && IN(pb + 5)) { WSL();
            constexpr int RMAXU = 16;
            LAS bf16_t* HT = (LAS bf16_t*)lds; LAS float* PART = (LAS float*)(lds + 66048); LAS float* LOG = (LAS float*)(lds + 98816);
            LAS int* LCNT = (LAS int*)(lds + 103040); LAS int* LBASE = (LAS int*)(lds + 103168); LAS int* SELE = (LAS int*)(lds + 106496); LAS int* SELR = (LAS int*)(lds + 114688); LAS float* SELG = (LAS float*)(lds + 122880);
            const float* gn = kp->g_norm_ffn + (size_t)layer * 1024;
            const int r32 = lane & 31, hi2 = lane >> 5;
            f32x4 gnv[4]; bf16x8 wb[8];
#pragma unroll
            for (int j = 0; j < 4; ++j) gnv[j] = *(const f32x4*)(gn + 8 * lane + 512 * (j >> 1) + 4 * (j & 1));
#pragma unroll
            for (int s8 = 0; s8 < 8; ++s8) wb[s8] = *(const bf16x8*)(WROUT + ((size_t)layer * 32 + r32) * 1024 + wave * 128 + s8 * 16 + hi2 * 8);
            REP(10) { unsigned* gcnt = (unsigned*)(wsl + WS_CTL) + CW_CNT + layer * 32 + (DSH(10) ? 4096 : 0); const size_t dsh = DSH(10);
            for (int ub = bxl; ub < T / 32; ub += G * RMAXU) {
                if (tid < 32) LCNT[tid] = 0;
                u32x4 xq[4][2]; f32x4 shv[4], scv[4];
#define R_ISSUE(uu) do { const int t0_ = (uu) * 32, b_ = t0_ >> 12; const float* sh_ = MOD + ((size_t)layer * 8 + b_) * 6144 + 3072; \
        _Pragma("unroll") for (int q = 0; q < 4; ++q) _Pragma("unroll") for (int jj = 0; jj < 2; ++jj) xq[q][jj] = *(const u32x4*)((const unsigned char*)X + (size_t)(t0_ + wave * 4 + q) * 2048 + (8 * lane + 512 * jj) * 2); \
        _Pragma("unroll") for (int j = 0; j < 4; ++j) { const int c_ = 8 * lane + 512 * (j >> 1) + 4 * (j & 1); shv[j] = *(const f32x4*)(sh_ + c_); scv[j] = *(const f32x4*)(sh_ + 1024 + c_); } } while (0)
                R_ISSUE(ub);
                int nu = 0;
                for (int u = ub, i = 0; u < T / 32 && i < RMAXU; u += G, ++i) { const int t0 = u * 32;
#pragma unroll
                    for (int q = 0; q < 4; ++q) { const int tl = wave * 4 + q, t = t0 + tl; f32x4 v[4]; float ss = 0.f;
#pragma unroll
                        for (int jj = 0; jj < 2; ++jj) { const u32x4 x4 = xq[q][jj];
                            v[2 * jj] = (f32x4){bf_lo(x4.x), bf_hi(x4.x), bf_lo(x4.y), bf_hi(x4.y)}; v[2 * jj + 1] = (f32x4){bf_lo(x4.z), bf_hi(x4.z), bf_lo(x4.w), bf_hi(x4.w)}; }
#pragma unroll
                        for (int j = 0; j < 4; ++j) ss += (v[j][0] * v[j][0] + v[j][1] * v[j][1]) + (v[j][2] * v[j][2] + v[j][3] * v[j][3]);
                        const float rstd = 1.0f / sqrtf(wave_sum(ss) * (1.0f / 1024.0f) + EPS);
                        f32x4 y[4];
#pragma unroll
                        for (int j = 0; j < 4; ++j) y[j] = v[j] * rstd * gnv[j] * (scv[j] + 1.0f) + shv[j];
#pragma unroll
                        for (int jj = 0; jj < 2; ++jj) { u32x2 w8; w8.x = pk_fp8x4(y[2 * jj][0], y[2 * jj][1], y[2 * jj][2], y[2 * jj][3]); w8.y = pk_fp8x4(y[2 * jj + 1][0], y[2 * jj + 1][1], y[2 * jj + 1][2], y[2 * jj + 1][3]);
                            *(u32x2*)((unsigned char*)H8 + (size_t)t * 1024 + 8 * lane + 512 * jj + dsh) = w8;
                            const u32x4 wh = {cvt_pk_bf16(y[2 * jj][0], y[2 * jj][1]), cvt_pk_bf16(y[2 * jj][2], y[2 * jj][3]), cvt_pk_bf16(y[2 * jj + 1][0], y[2 * jj + 1][1]), cvt_pk_bf16(y[2 * jj + 1][2], y[2 * jj + 1][3])};
                            *(LAS u32x4*)(HT + tl * 1032 + 8 * lane + 512 * jj) = wh; } }
                    if (u + G < T / 32 && i + 1 < RMAXU) R_ISSUE(u + G);
                    __syncthreads();
                    { f32x16 acc = {};
#pragma unroll
                      for (int s8 = 0; s8 < 8; ++s8) { const int kk = wave * 128 + s8 * 16 + hi2 * 8; const bf16x8 av = *(const LAS bf16x8*)(HT + r32 * 1032 + kk);
                          acc = __builtin_amdgcn_mfma_f32_32x32x16_bf16(av, wb[s8], acc, 0, 0, 0); }
#pragma unroll
                      for (int r = 0; r < 16; ++r) PART[wave * 1024 + att::crow(r, hi2) * 32 + r32] = acc[r]; }
                    __syncthreads();
#pragma unroll
                    for (int ii = 0; ii < 2; ++ii) { const int idx = tid + 512 * ii; float sacc = kp->b_router[layer * 32 + (idx & 31)];
#pragma unroll
                        for (int w = 0; w < 8; ++w) sacc += PART[w * 1024 + idx];
                        LOG[(idx >> 5) * 33 + (idx & 31)] = sacc; }
                    __syncthreads();
                    if (tid < 32) { unsigned mask = 0u; float tv[4]; int te[4];
#pragma unroll
                        for (int k = 0; k < 4; ++k) { float best = -__builtin_inff(); int bi = 0;
                            for (int e = 0; e < 32; ++e) { const float vv = LOG[tid * 33 + e]; const bool take = (vv > best) && !((mask >> e) & 1u); best = take ? vv : best; bi = take ? e : bi; }
                            mask |= 1u << bi; tv[k] = best; te[k] = bi; }
                        const float e0 = 1.0f, e1 = __expf(tv[1] - tv[0]), e2 = __expf(tv[2] - tv[0]), e3 = __expf(tv[3] - tv[0]); const float inv = 1.0f / (e0 + e1 + e2 + e3);
                        const float gk[4] = {e0 * inv, e1 * inv, e2 * inv, e3 * inv};
#pragma unroll
                        for (int k = 0; k < 4; ++k) { SELE[i * 128 + tid * 4 + k] = te[k]; SELG[i * 128 + tid * 4 + k] = gk[k]; SELR[i * 128 + tid * 4 + k] = __hip_atomic_fetch_add(LCNT + te[k], 1, __ATOMIC_RELAXED, __HIP_MEMORY_SCOPE_WORKGROUP); } }
                    nu = i + 1; }
#undef R_ISSUE
                __syncthreads();
                if (tid < 32) { const int c = LCNT[tid]; LBASE[tid] = c ? (int)__hip_atomic_fetch_add(gcnt + tid, (unsigned)c, __ATOMIC_RELAXED, __HIP_MEMORY_SCOPE_AGENT) : 0; }
                __syncthreads();
                for (int idx = tid; idx < nu * 128; idx += NTHR) { const int i = idx >> 7, w = idx & 127, t = (ub + i * G) * 32 + (w >> 2); const int e = SELE[idx], slot = LBASE[e] + SELR[idx];
                    if (slot < T) *(int*)((char*)(LIST + (size_t)e * T + slot) + dsh) = t; *(int*)((char*)(TOKE + (size_t)t * 4 + (w & 3)) + dsh) = e | (slot << 8); *(float*)((char*)(GATE + (size_t)t * 4 + (w & 3)) + dsh) = SELG[idx]; }
                __syncthreads(); } }
            SEAM(pb + 5);
        }
        if (ON(11) && IN(pb + 6)) { WSL();
            build_moe_tables(lds, (unsigned*)(wsl + WS_CTL) + CW_CNT + layer * 32, wave_s_);
            const int ntiles = ((const LAS int*)(lds + TAB_NT))[0];
            LAS int* ltok = (LAS int*)(lds + LTOK_OFF);
            { const LAS int* tinfo_ = (const LAS int*)(lds + TAB_TINFO); const LAS int* ecnt_ = (const LAS int*)(lds + TAB_ECNT);
              for (int i = tid >> 8;; i += 2) { const int L = i * G + vcl; if (L >= ntiles * 8 || i >= 24) break; const int info = tinfo_[L >> 3], e = info >> 16, slot = (info & 0xffff) * 256 + (tid & 255);
                  ltok[i * 256 + (tid & 255)] = slot < ecnt_[e] ? (LIST[(size_t)e * T + slot] & (T - 1)) : 0; }
              __syncthreads(); }
            MoeSchedUp S{(const char*)H8, (const char*)WGU + (size_t)layer * 32 * 2048 * 1024, (const LAS int*)(lds + TAB_TINFO), ltok, ntiles * 8 < 24 * G ? ntiles * 8 : 24 * G, G, vcl};
            EpiSwiGLU E{ACT, kp->b_gu + (size_t)layer * 32 * 2048};
            REP(11) g8::gemm_phase<EpiSwiGLU, MoeSchedUp, true, true>(lds, 512, S, E, wave_s_, (vcl & 31) * STAG);
            SEAM(pb + 6);
        }
        if (ON(12) && IN(pb + 7)) { WSL();
            if (lo > pb + 6) build_moe_tables(lds, (unsigned*)(wsl + WS_CTL) + CW_CNT + layer * 32, wave_s_);
            const int ntiles = ((const LAS int*)(lds + TAB_NT))[0];
            MoeSchedDown S{(const char*)ACT, (const char*)WDOWN + (size_t)layer * 32 * 1024 * 1024, (const LAS int*)(lds + TAB_TINFO), ntiles * 4, G, vcl};
            EpiDown E{(unsigned char*)YB, kp->b_down + (size_t)layer * 32 * 1024};
            if ((REPMASK >> 24) & 1u) { EpiNull EN; MoeSchedDownHot SH; SH.A = S.A; SH.Wt = S.Wt; SH.tinfo = S.tinfo; SH.nunits = S.nunits; SH.G = S.G; SH.c = S.c; g8::gemm_phase<EpiNull, MoeSchedDownHot, true, true>(lds, 512, SH, EN, wave_s_); }
            if ((REPMASK >> 20) & 1u) { EpiNull EN; g8::gemm_phase<EpiNull, MoeSchedDown, true, true>(lds, 512, S, EN, wave_s_); }
            if ((REPMASK >> 21) & 1u) { EpiP1 EN{(bf16_t*)((char*)YB + 1600 * MiB)}; g8::gemm_phase<EpiP1, MoeSchedDown, true, true>(lds, 512, S, EN, wave_s_); }
            if ((REPMASK >> 22) & 1u) { EpiP2 EN{(bf16_t*)((char*)YB + 1600 * MiB), kp->b_down + (size_t)layer * 32 * 1024}; g8::gemm_phase<EpiP2, MoeSchedDown, true, true>(lds, 512, S, EN, wave_s_); }
            REP(12) g8::gemm_phase<EpiDown, MoeSchedDown, true, true>(lds, 512, S, E, wave_s_, (vcl & 31) * STAG);
            SEAM(pb + 7);
        }
        if (ON(13) && IN(pb + 8)) { WSL();
            if (lo > pb + 6) build_moe_tables(lds, (unsigned*)(wsl + WS_CTL) + CW_CNT + layer * 32, wave_s_);
            const LAS int* tstart = (const LAS int*)(lds + TAB_TSTART);
#define CCOL(idx) (8 * lane + 512 * ((idx) >> 1) + 4 * ((idx) & 1))
            const bool lastl = layer + 1 >= DEPTH;
            const float* gnp = lastl ? kp->g_final : kp->g_norm_mix + (size_t)(layer + 1) * 1024;
            REP(13) { const size_t dsh = DSH(13);
                const int chunk = (T + NGW - 1) / NGW, tb = gw * chunk, te = tb + chunk < T ? tb + chunk : T;
                f32x4 gnv[4], g2v[4], scv[4], shv[4]; int cur_b = -1;
#pragma unroll
                for (int j = 0; j < 4; ++j) { gnv[j] = *(const f32x4*)(gnp + CCOL(j)); g2v[j] = gnv[j]; scv[j] = gnv[j]; shv[j] = gnv[j]; }
                i32x4v inf0 = {}, inf1 = {}; f32x4 gkq0 = {}, gkq1 = {};
                if (tb < te) { const int t1 = tb + 1 < te ? tb + 1 : tb; inf0 = *(const i32x4v*)(TOKE + (size_t)tb * 4); gkq0 = *(const f32x4*)(GATE + (size_t)tb * 4); inf1 = *(const i32x4v*)(TOKE + (size_t)t1 * 4); gkq1 = *(const f32x4*)(GATE + (size_t)t1 * 4); }
                for (int t = tb; t < te; t += 2) { const int t1 = t + 1 < te ? t + 1 : t;
                    u32x4 xq[2][2]; u32x2 yv[2][4][2];
#pragma unroll
                    for (int q = 0; q < 2; ++q)
#pragma unroll
                        for (int jj = 0; jj < 2; ++jj) xq[q][jj] = *(const u32x4*)((const unsigned char*)X + (size_t)(q ? t1 : t) * 2048 + (8 * lane + 512 * jj) * 2);
#pragma unroll
                    for (int q = 0; q < 2; ++q)
#pragma unroll
                        for (int k = 0; k < 4; ++k) { const int info = q ? inf1[k] : inf0[k]; const size_t row = (size_t)tstart[info & 31] * 256 + (info >> 8);
#pragma unroll
                            for (int j = 0; j < 2; ++j) yv[q][k][j] = *(const u32x2*)((const unsigned char*)YB + row * 1024 + 8 * lane + 512 * j); }
                    const f32x4 gc0 = gkq0, gc1 = gkq1;
                    { const int tn = t + 2 < te ? t + 2 : t, tn1 = t + 3 < te ? t + 3 : tn;
                      inf0 = *(const i32x4v*)(TOKE + (size_t)tn * 4); gkq0 = *(const f32x4*)(GATE + (size_t)tn * 4); inf1 = *(const i32x4v*)(TOKE + (size_t)tn1 * 4); gkq1 = *(const f32x4*)(GATE + (size_t)tn1 * 4); }
#pragma unroll
                    for (int q = 0; q < 2; ++q) { const int tq = q ? t1 : t, b = tq >> 12;
                        if (q == 1 && t + 1 >= te) break;
                        if (b != cur_b) { cur_b = b;
                            const float* g2 = MOD + ((size_t)layer * 8 + b) * 6144 + 5120; const float* sh = MOD + ((size_t)(lastl ? layer : layer + 1) * 8 + b) * 6144; const float* sc = sh + 1024;
#pragma unroll
                            for (int j = 0; j < 4; ++j) { g2v[j] = *(const f32x4*)(g2 + CCOL(j)); if (!lastl) { scv[j] = *(const f32x4*)(sc + CCOL(j)) + 1.0f; shv[j] = *(const f32x4*)(sh + CCOL(j)); } } }
                        f32x4 a[4];
#pragma unroll
                        for (int j = 0; j < 4; ++j) a[j] = (f32x4){0.f, 0.f, 0.f, 0.f};
#pragma unroll
                        for (int k = 0; k < 4; ++k) { const float gk = q ? gc1[k] : gc0[k];
#pragma unroll
                            for (int j = 0; j < 2; ++j) { const u32x2 y = yv[q][k][j];
                                typedef float f2_ __attribute__((ext_vector_type(2)));
                                const f2_ y01 = __builtin_amdgcn_cvt_pk_f32_fp8((int)y.x, false), y23 = __builtin_amdgcn_cvt_pk_f32_fp8((int)y.x, true), y45 = __builtin_amdgcn_cvt_pk_f32_fp8((int)y.y, false), y67 = __builtin_amdgcn_cvt_pk_f32_fp8((int)y.y, true);
                                a[2 * j][0] += gk * y01[0]; a[2 * j][1] += gk * y01[1]; a[2 * j][2] += gk * y23[0]; a[2 * j][3] += gk * y23[1];
                                a[2 * j + 1][0] += gk * y45[0]; a[2 * j + 1][1] += gk * y45[1]; a[2 * j + 1][2] += gk * y67[0]; a[2 * j + 1][3] += gk * y67[1]; } }
                        f32x4 v[4]; float ss = 0.f;
#pragma unroll
                        for (int jj = 0; jj < 2; ++jj) { const u32x4 x4 = xq[q][jj];
                            v[2 * jj] = (f32x4){bf_lo(x4.x), bf_hi(x4.x), bf_lo(x4.y), bf_hi(x4.y)}; v[2 * jj + 1] = (f32x4){bf_lo(x4.z), bf_hi(x4.z), bf_lo(x4.w), bf_hi(x4.w)}; }
#pragma unroll
                        for (int j = 0; j < 4; ++j) { v[j] = v[j] + g2v[j] * a[j]; ss += (v[j][0] * v[j][0] + v[j][1] * v[j][1]) + (v[j][2] * v[j][2] + v[j][3] * v[j][3]); }
                        const float rstd = 1.0f / sqrtf(wave_sum(ss) * (1.0f / 1024.0f) + EPS);
                        if (!lastl) {
                            unsigned w8[4];
#pragma unroll
                            for (int j = 0; j < 4; ++j) { const f32x4 y = v[j] * rstd * gnv[j] * scv[j] + shv[j]; w8[j] = pk_fp8x4(y[0], y[1], y[2], y[3]); }
#pragma unroll
                            for (int j = 0; j < 2; ++j) { u32x2 w; w.x = w8[2 * j]; w.y = w8[2 * j + 1]; *(u32x2*)((unsigned char*)H + (size_t)tq * 1024 + 8 * lane + 512 * j + dsh) = w;
                                const u32x4 xw = {cvt_pk_bf16(v[2 * j][0], v[2 * j][1]), cvt_pk_bf16(v[2 * j][2], v[2 * j][3]), cvt_pk_bf16(v[2 * j + 1][0], v[2 * j + 1][1]), cvt_pk_bf16(v[2 * j + 1][2], v[2 * j + 1][3])};
                                *(u32x4*)((unsigned char*)X + (size_t)tq * 2048 + (8 * lane + 512 * j) * 2 + dsh) = xw; }
                        } else {
#pragma unroll
                            for (int j = 0; j < 4; ++j) { const int c = CCOL(j); *(f32x4*)(dsh ? (float*)((char*)(X + (size_t)tq * 1024 + c) + dsh) : kp->out + (size_t)tq * 1024 + c) = v[j] * rstd * gnv[j]; } } } } }
#undef CCOL
            SEAM(pb + 8);
        }
    }
#undef IN
#undef SEAM
}

extern "C" void kernel_launch(void* const* d_in, const int* in_sizes, int n_in, void* d_out, int out_size, void* d_ws, size_t ws_size, hipStream_t stream) {
    static int grid = 0;
    if (grid == 0) {
        if (n_in != 23 || out_size != T * D || ws_size < WS_END) { fprintf(stderr, "kernel_launch: unexpected shapes n_in %d out %d ws %zu (need %zu)\n", n_in, out_size, ws_size, (size_t)WS_END); grid = -1; return; }
        int dev = 0, cus = 0, per_cu = 0;
        if (hipGetDevice(&dev) != hipSuccess || hipDeviceGetAttribute(&cus, hipDeviceAttributeMultiprocessorCount, dev) != hipSuccess) { grid = -1; return; }
        if (hipFuncSetAttribute((const void*)fwd_kernel, hipFuncAttributeMaxDynamicSharedMemorySize, LDS_BYTES) != hipSuccess) { fprintf(stderr, "kernel_launch: hipFuncSetAttribute failed\n"); grid = -1; return; }
        if (hipOccupancyMaxActiveBlocksPerMultiprocessor(&per_cu, (const void*)fwd_kernel, NTHR, LDS_BYTES) != hipSuccess || per_cu < 1) { fprintf(stderr, "kernel_launch: occupancy query says %d\n", per_cu); (void)hipGetLastError(); grid = -1; return; }
        grid = cus;
    }
    if (grid < 0) return;
    (void)hipMemsetAsync((char*)d_ws + WS_CTL, 0, CTL_ZERO_BYTES, stream);
    Params p{};
    p.x = (const float*)d_in[0]; p.c = (const float*)d_in[1]; p.positions = (const int*)d_in[2]; p.w_mod = (const float*)d_in[3]; p.b_mod = (const float*)d_in[4];
    p.g_norm_mix = (const float*)d_in[5]; p.g_norm_ffn = (const float*)d_in[6]; p.w_in_ab = (const float*)d_in[7]; p.mla_g_q = (const float*)d_in[8]; p.mla_w_qb = (const float*)d_in[9];
    p.mla_g_kv = (const float*)d_in[10]; p.mla_w_kvb = (const float*)d_in[11]; p.swa_sink = (const float*)d_in[12]; p.w_out_ab = (const float*)d_in[13]; p.w_in_c = (const float*)d_in[14];
    p.w_out_c = (const float*)d_in[15]; p.w_router = (const float*)d_in[16]; p.b_router = (const float*)d_in[17]; p.w_gu = (const float*)d_in[18]; p.b_gu = (const float*)d_in[19];
    p.w_down = (const float*)d_in[20]; p.b_down = (const float*)d_in[21]; p.g_final = (const float*)d_in[22];
    p.out = (float*)d_out; p.ws = (unsigned char*)d_ws;
#if MK_MULTI
    for (int k = 0; k < NPH; ++k) { if (phase_empty(k)) continue; p.ph_lo = k; p.ph_hi = k + 1;
        hipLaunchKernelGGL(fwd_kernel, dim3(grid), dim3(NTHR), LDS_BYTES, stream, p); }
#else
    p.ph_lo = 0; p.ph_hi = NPH;
    hipLaunchKernelGGL(fwd_kernel, dim3(grid), dim3(NTHR), LDS_BYTES, stream, p);
#endif
    const hipError_t le = hipPeekAtLastError();
    if (le != hipSuccess) fprintf(stderr, "kernel_launch: launch failed: %s\n", hipGetErrorName(le));
}
```
